# Optimizing an MI355X kernel written in HIP

```python
import math
import jax, jax.numpy as jnp
from jax import lax
import numpy as np

D_MODEL = 2048
BATCH = 1
SEQ = 8192
DEPTH = 2

CHUNK = 64
GDN_HEADS = 8
GDN_HEAD_DIM = 128
GDN_DIM = GDN_HEADS * GDN_HEAD_DIM
SHORT_CONV = 4
RET_HEADS = 4
RET_QK_DIM = 128
RET_V_DIM = 256
RET_QK = RET_HEADS * RET_QK_DIM
RET_V = RET_HEADS * RET_V_DIM
RET_DECAY_BASE = 5.0
ROPE_BASE = 10000.0
CONV_DIM = D_MODEL // 2
CONV_WIDTH = 31
N_BRANCH = 3
D_FF = 4 * D_MODEL
NORM_EPS = 1e-6
MAX_STREAM_OFFSET = 4096

IN_SIZES = (GDN_DIM, GDN_DIM, GDN_DIM, GDN_DIM, GDN_HEADS, GDN_HEADS,
            RET_QK, RET_QK, RET_V, RET_V, 2 * CONV_DIM, N_BRANCH * D_MODEL)
IN_WIDTH = 4 * GDN_DIM + 2 * GDN_HEADS + 2 * RET_QK + 2 * RET_V + 2 * CONV_DIM + N_BRANCH * D_MODEL

kernel_name = "hybrid_gdn_retnet_conformer_adaln"


def _split_points(sizes):
    pts, acc = [], 0
    for s in sizes[:-1]:
        acc += s
        pts.append(acc)
    return pts


def rms_norm(x, w, eps=NORM_EPS):
    xf = x.astype(jnp.float32)
    y = xf * lax.rsqrt(jnp.mean(xf * xf, axis=-1, keepdims=True) + eps)
    return (y * w.astype(jnp.float32)).astype(x.dtype)


def layer_norm_f32(x, eps=1e-5):
    mu = jnp.mean(x, axis=-1, keepdims=True)
    var = jnp.mean(jnp.square(x - mu), axis=-1, keepdims=True)
    return (x - mu) * lax.rsqrt(var + eps)


def l2_norm(x, eps=1e-6):
    return x * lax.rsqrt(jnp.sum(x * x, axis=-1, keepdims=True) + eps)


def causal_depthwise_conv(x, w):
    k_width, ch = w.shape
    return lax.conv_general_dilated(
        x, w[:, None, :].astype(x.dtype), window_strides=(1,),
        padding=[(k_width - 1, 0)], dimension_numbers=('NWC', 'WIO', 'NWC'),
        feature_group_count=ch)


def rotary(x, positions):
    half = x.shape[-1] // 2
    inv_freq = ROPE_BASE ** (-jnp.arange(half, dtype=jnp.float32) / half)
    ang = positions.astype(jnp.float32)[..., None] * inv_freq
    cos = jnp.cos(ang)[:, :, None, :]
    sin = jnp.sin(ang)[:, :, None, :]
    x1, x2 = x[..., :half], x[..., half:]
    return jnp.concatenate([x1 * cos - x2 * sin, x1 * sin + x2 * cos], axis=-1)


def _to_chunks(a):
    b, t, h = a.shape[:3]
    a = a.reshape((b, t // CHUNK, CHUNK, h) + a.shape[3:])
    return jnp.moveaxis(a, 3, 1)


def _from_chunks(a):
    b, h, n, c, d = a.shape
    return jnp.transpose(a, (0, 2, 3, 1, 4)).reshape(b, n * c, h, d)


def gated_delta_rule(q, k, v, g, beta):
    bsz, _, h, dk = q.shape
    dv = v.shape[-1]
    q = _to_chunks(q * dk ** -0.5)
    k = _to_chunks(k)
    v = _to_chunks(v)
    g = jnp.cumsum(_to_chunks(g), axis=-1)
    beta = _to_chunks(beta)
    idx = jnp.arange(CHUNK)
    causal = idx[:, None] >= idx[None, :]
    strict = idx[:, None] > idx[None, :]
    decay = jnp.exp(jnp.where(causal, g[..., :, None] - g[..., None, :], -jnp.inf))
    k_beta = k * beta[..., None]
    v_beta = v * beta[..., None]
    lower = jnp.where(strict, jnp.einsum('bhncd,bhnsd->bhncs', k_beta, k) * decay, 0.0)
    eye = jnp.eye(CHUNK, dtype=jnp.float32)
    t_inv = lax.linalg.triangular_solve(eye + lower, jnp.broadcast_to(eye, lower.shape),
                                        left_side=True, lower=True)
    u = jnp.einsum('bhncs,bhnse->bhnce', t_inv, v_beta)
    w = jnp.einsum('bhncs,bhnsd->bhncd', t_inv, k_beta * jnp.exp(g)[..., None])
    attn = jnp.where(causal, jnp.einsum('bhncd,bhnsd->bhncs', q, k) * decay, 0.0)
    q_dec = q * jnp.exp(g)[..., None]
    k_dec = k * jnp.exp(g[..., -1:] - g)[..., None]
    g_last = jnp.exp(g[..., -1])

    def step(state, xs):
        q_i, k_i, u_i, w_i, a_i, gl_i = xs
        v_new = u_i - jnp.einsum('bhcd,bhde->bhce', w_i, state)
        o = jnp.einsum('bhcd,bhde->bhce', q_i, state) + jnp.einsum('bhcs,bhse->bhce', a_i, v_new)
        state = state * gl_i[..., None, None] + jnp.einsum('bhcd,bhce->bhde', k_i, v_new)
        return state, o

    xs = tuple(jnp.moveaxis(a, 2, 0) for a in (q_dec, k_dec, u, w, attn, g_last))
    s0 = jnp.zeros((bsz, h, dk, dv), jnp.float32)
    _, o = lax.scan(step, s0, xs)
    return _from_chunks(jnp.moveaxis(o, 0, 2))


def chunkwise_retention(q, k, v):
    bsz, _, h, dk = q.shape
    dv = v.shape[-1]
    log_gamma = jnp.log(1.0 - jnp.exp2(-RET_DECAY_BASE - jnp.arange(h, dtype=jnp.float32)))
    q = _to_chunks(q)
    k = _to_chunks(k * dk ** -0.5)
    v = _to_chunks(v)
    idx = jnp.arange(CHUNK, dtype=jnp.float32)
    rel = idx[:, None] - idx[None, :]
    dmask = jnp.where(rel >= 0, jnp.exp(jnp.maximum(rel, 0.0) * log_gamma[:, None, None]), 0.0)
    scores = jnp.einsum('bhncd,bhnsd->bhncs', q, k) * dmask[None, :, None]
    o_intra = jnp.einsum('bhncs,bhnse->bhnce', scores, v)
    inner = jnp.exp((idx + 1.0) * log_gamma[:, None])
    tail = jnp.exp((CHUNK - 1.0 - idx) * log_gamma[:, None])
    chunk_decay = jnp.exp(CHUNK * log_gamma)
    q_in = q * inner[None, :, None, :, None]
    k_tail = k * tail[None, :, None, :, None]

    def step(state, xs):
        q_i, k_i, v_i = xs
        o = jnp.einsum('bhcd,bhde->bhce', q_i, state)
        state = state * chunk_decay[None, :, None, None] + jnp.einsum('bhcd,bhce->bhde', k_i, v_i)
        return state, o

    xs = tuple(jnp.moveaxis(a, 2, 0) for a in (q_in, k_tail, v))
    r0 = jnp.zeros((bsz, h, dk, dv), jnp.float32)
    _, o_inter = lax.scan(step, r0, xs)
    return _from_chunks(o_intra + jnp.moveaxis(o_inter, 0, 2))


def hybrid_mixer(h, positions, w_in, conv_qkv_w, a_log, dt_bias, gdn_norm_w,
                 conv_dw_w, conv_dw_b, conv_ln_w, conv_ln_b,
                 w_branch_a, w_branch_b, w_branch_c, w_out):
    bsz, t, _ = h.shape
    dt = h.dtype
    proj = h @ w_in
    (a_q, a_k, a_v, a_z, a_beta, a_alpha,
     b_q, b_k, b_v, b_g, c_glu, gate_raw) = jnp.split(proj, _split_points(IN_SIZES), axis=-1)

    qkv = jax.nn.silu(causal_depthwise_conv(jnp.concatenate([a_q, a_k, a_v], axis=-1), conv_qkv_w))
    a_q, a_k, a_v = jnp.split(qkv.astype(jnp.float32), 3, axis=-1)
    heads = lambda z, n, d: z.reshape(bsz, t, n, d)
    gq = l2_norm(heads(a_q, GDN_HEADS, GDN_HEAD_DIM))
    gk = l2_norm(heads(a_k, GDN_HEADS, GDN_HEAD_DIM))
    gv = heads(a_v, GDN_HEADS, GDN_HEAD_DIM)
    beta = jax.nn.sigmoid(a_beta.astype(jnp.float32))
    g = -jnp.exp(a_log.astype(jnp.float32)) * jax.nn.softplus(a_alpha.astype(jnp.float32) + dt_bias.astype(jnp.float32))
    o_a = gated_delta_rule(gq, gk, gv, g, beta)
    o_a = o_a * lax.rsqrt(jnp.mean(o_a * o_a, axis=-1, keepdims=True) + NORM_EPS) * gdn_norm_w.astype(jnp.float32)
    o_a = o_a * jax.nn.silu(heads(a_z.astype(jnp.float32), GDN_HEADS, GDN_HEAD_DIM))
    y_a = o_a.reshape(bsz, t, GDN_DIM).astype(dt) @ w_branch_a

    rq = rotary(heads(b_q.astype(jnp.float32), RET_HEADS, RET_QK_DIM), positions)
    rk = rotary(heads(b_k.astype(jnp.float32), RET_HEADS, RET_QK_DIM), positions)
    rv = heads(b_v.astype(jnp.float32), RET_HEADS, RET_V_DIM)
    o_b = layer_norm_f32(chunkwise_retention(rq, rk, rv))
    o_b = o_b.reshape(bsz, t, RET_V) * jax.nn.silu(b_g.astype(jnp.float32))
    y_b = o_b.astype(dt) @ w_branch_b

    c_a, c_b = jnp.split(c_glu, 2, axis=-1)
    u = c_a * jax.nn.sigmoid(c_b)
    u = causal_depthwise_conv(u, conv_dw_w) + conv_dw_b.astype(dt)
    u = layer_norm_f32(u.astype(jnp.float32)) * conv_ln_w.astype(jnp.float32) + conv_ln_b.astype(jnp.float32)
    y_c = jax.nn.silu(u).astype(dt) @ w_branch_c

    gates = jax.nn.sigmoid(gate_raw.reshape(bsz, t, N_BRANCH, D_MODEL))
    merged = gates[:, :, 0] * y_a + gates[:, :, 1] * y_b + gates[:, :, 2] * y_c
    return merged @ w_out


def setup_inputs(seed: int = 0) -> dict:
    key = jax.random.key(seed)
    ks = jax.random.split(key, 24)
    nrm = lambda k, shape, std: jax.random.normal(k, shape, jnp.float32) * std
    x = nrm(ks[0], (BATCH, SEQ, D_MODEL), 1.0)
    c = nrm(ks[1], (BATCH, D_MODEL), 1.0)
    start = jax.random.randint(ks[2], (BATCH, 1), 0, MAX_STREAM_OFFSET, dtype=jnp.int32)
    positions = (start + jnp.arange(SEQ, dtype=jnp.int32)[None, :]).astype(jnp.int32)
    w_ada = nrm(ks[3], (DEPTH, D_MODEL, 6 * D_MODEL), 0.5 * D_MODEL ** -0.5)
    b_ada = nrm(ks[4], (DEPTH, 6 * D_MODEL), 0.01)
    norm_mix_w = 1.0 + nrm(ks[5], (DEPTH, D_MODEL), 0.02)
    norm_mlp_w = 1.0 + nrm(ks[6], (DEPTH, D_MODEL), 0.02)
    w_in = nrm(ks[7], (DEPTH, D_MODEL, IN_WIDTH), D_MODEL ** -0.5)
    conv_qkv_w = nrm(ks[8], (DEPTH, SHORT_CONV, 3 * GDN_DIM), SHORT_CONV ** -0.5)
    gdn_a_log = jnp.log(jax.random.uniform(ks[9], (DEPTH, GDN_HEADS), jnp.float32, 1.0, 16.0))
    dt0 = jnp.exp(jax.random.uniform(ks[10], (DEPTH, GDN_HEADS), jnp.float32, math.log(1e-3), math.log(1e-1)))
    gdn_dt_bias = dt0 + jnp.log(-jnp.expm1(-dt0))
    gdn_norm_w = 1.0 + nrm(ks[11], (DEPTH, GDN_HEAD_DIM), 0.02)
    conv_dw_w = nrm(ks[12], (DEPTH, CONV_WIDTH, CONV_DIM), CONV_WIDTH ** -0.5)
    conv_dw_b = nrm(ks[13], (DEPTH, CONV_DIM), 0.01)
    conv_ln_w = 1.0 + nrm(ks[14], (DEPTH, CONV_DIM), 0.02)
    conv_ln_b = nrm(ks[15], (DEPTH, CONV_DIM), 0.01)
    w_branch_a = nrm(ks[16], (DEPTH, GDN_DIM, D_MODEL), GDN_DIM ** -0.5)
    w_branch_b = nrm(ks[17], (DEPTH, RET_V, D_MODEL), RET_V ** -0.5)
    w_branch_c = nrm(ks[18], (DEPTH, CONV_DIM, D_MODEL), CONV_DIM ** -0.5)
    w_out = nrm(ks[19], (DEPTH, D_MODEL, D_MODEL), D_MODEL ** -0.5)
    w_mlp_in = nrm(ks[20], (DEPTH, D_MODEL, D_FF), D_MODEL ** -0.5)
    w_mlp_out = nrm(ks[21], (DEPTH, D_FF, D_MODEL), D_FF ** -0.5)
    final_norm_w = 1.0 + nrm(ks[22], (D_MODEL,), 0.02)
    return {"x": x, "c": c, "positions": positions, "w_ada": w_ada, "b_ada": b_ada,
            "norm_mix_w": norm_mix_w, "norm_mlp_w": norm_mlp_w, "w_in": w_in,
            "conv_qkv_w": conv_qkv_w, "gdn_a_log": gdn_a_log, "gdn_dt_bias": gdn_dt_bias,
            "gdn_norm_w": gdn_norm_w, "conv_dw_w": conv_dw_w, "conv_dw_b": conv_dw_b,
            "conv_ln_w": conv_ln_w, "conv_ln_b": conv_ln_b, "w_branch_a": w_branch_a,
            "w_branch_b": w_branch_b, "w_branch_c": w_branch_c, "w_out": w_out,
            "w_mlp_in": w_mlp_in, "w_mlp_out": w_mlp_out, "final_norm_w": final_norm_w}


def reference(x, c, positions, w_ada, b_ada, norm_mix_w, norm_mlp_w, w_in, conv_qkv_w,
              gdn_a_log, gdn_dt_bias, gdn_norm_w, conv_dw_w, conv_dw_b, conv_ln_w, conv_ln_b,
              w_branch_a, w_branch_b, w_branch_c, w_out, w_mlp_in, w_mlp_out, final_norm_w):
    c_act = jax.nn.silu(c)
    for l in range(DEPTH):
        mod = c_act @ w_ada[l] + b_ada[l]
        shift1, scale1, gate1, shift2, scale2, gate2 = [m[:, None, :] for m in jnp.split(mod, 6, axis=-1)]
        h = rms_norm(x, norm_mix_w[l]) * (1.0 + scale1) + shift1
        x = x + gate1 * hybrid_mixer(h, positions, w_in[l], conv_qkv_w[l], gdn_a_log[l], gdn_dt_bias[l],
                                     gdn_norm_w[l], conv_dw_w[l], conv_dw_b[l], conv_ln_w[l], conv_ln_b[l],
                                     w_branch_a[l], w_branch_b[l], w_branch_c[l], w_out[l])
        h = rms_norm(x, norm_mlp_w[l]) * (1.0 + scale2) + shift2
        x = x + gate2 * (jnp.square(jax.nn.relu(h @ w_mlp_in[l])) @ w_mlp_out[l])
    return rms_norm(x, final_norm_w)
```

```cpp
#include <hip/hip_runtime.h>
#include <hip/hip_cooperative_groups.h>
#include <cstdio>
namespace pg8 {
#define PG8_LAS __attribute__((address_space(3)))
typedef unsigned short bf16_t;
typedef short bf16x8 __attribute__((ext_vector_type(8)));
typedef float f32x4 __attribute__((ext_vector_type(4)));
typedef unsigned u32x4 __attribute__((ext_vector_type(4)));
constexpr int BM = 256, BK = 64, HALF = 128, HTB = HALF * BK * 2  , STAGE_BYTES = 8 * HTB, NXCD = 8, WGM = 8;

__host__ __device__ __forceinline__ int lds_byte(int r, int c) { const int st = (r >> 4) * 2 + (c >> 5), rr = r & 15, cc = c & 31, ob = rr * 64 + cc * 2; return st * 1024 + (ob ^ (((ob >> 9) & 1) << 5)); }
__host__ __device__ __forceinline__ void stage_rc(int b, int& R, int& C) { const int st = b / 1024, sb = b % 1024, swz = sb ^ (((sb >> 9) & 1) << 5); R = (st >> 1) * 16 + swz / 64; C = (st & 1) * 32 + (swz % 64) / 2; }
__host__ __device__ __forceinline__ int perm32(int rho) { const int n = rho >> 4, i = rho & 15; return 8 * (i >> 2) + 4 * n + (i & 3); }

struct Unit { int pm, pn; };
struct Gemm { const bf16_t* A; const bf16_t* Bt; int M, N, K; };

struct StaticOrder {
    int nM, nN, nwg, G, c;
    __host__ __device__ void init(int M, int N, int G_, int c_) { nM = M / BM; nN = N / BM; nwg = nM * nN; G = G_; c = c_; }
    __host__ __device__ bool next(int i, Unit& u) const {
        const long L = (long)i * G + c; if (L >= nwg) return false;
        int wgid = (int)L; { const int q = nwg / NXCD, r = nwg % NXCD, xcd = wgid % NXCD, off = wgid / NXCD; wgid = (xcd < r ? xcd * (q + 1) : r * (q + 1) + (xcd - r) * q) + off; }
        const int nig = WGM * nN, gid = wgid / nig, fm = gid * WGM, gsz = (nM - fm) < WGM ? (nM - fm) : WGM;
        u.pm = fm + ((wgid % nig) % gsz); u.pn = (wgid % nig) / gsz; return true;
    }
    __device__ __forceinline__ void a_ready(const Unit&) const {}
    __device__ __forceinline__ void done(const Unit&) const {}
};
typedef float f32x2c_ __attribute__((ext_vector_type(2)));
typedef __bf16 bf16x2c_ __attribute__((ext_vector_type(2)));
__device__ __forceinline__ unsigned cvt_pk_bf16(float lo, float hi) { const f32x2c_ v = {lo, hi}; const bf16x2c_ b = __builtin_convertvector(v, bf16x2c_); return __builtin_bit_cast(unsigned, b); }
typedef unsigned u32x2 __attribute__((ext_vector_type(2)));
__device__ __forceinline__ float bf_lo(unsigned w) { return __uint_as_float(w << 16); }
__device__ __forceinline__ float bf_hi(unsigned w) { return __uint_as_float(w & 0xffff0000u); }
__device__ __forceinline__ float sigmoidf_(float x) { return 1.0f / (1.0f + __expf(-x)); }

constexpr int PROJ_LD = 15360;

struct EpiProj {
    static constexpr bool PERM = true, AFTER_DRAIN = false;
    bf16_t* O; float* BA;
    __device__ __forceinline__ void operator()(const f32x4 (&acc)[2][2][4][2], const Unit& u, int wr, int wc, int fr, int fq) const {
        const int row0 = u.pm * BM + wr * 64 + fr;
        if (u.pn < 60) {
            const int col0 = u.pn * BM + wc * 32 + 8 * fq;
#pragma unroll
            for (int ai = 0; ai < 2; ++ai)
#pragma unroll
                for (int m = 0; m < 4; ++m) { bf16_t* rowp = O + (size_t)(row0 + ai * HALF + m * 16) * PROJ_LD + col0;
#pragma unroll
                    for (int bj = 0; bj < 2; ++bj) { const f32x4 v0 = acc[ai][bj][m][0], v1 = acc[ai][bj][m][1];
                        u32x4 w; w.x = cvt_pk_bf16(v0[0], v0[1]); w.y = cvt_pk_bf16(v0[2], v0[3]); w.z = cvt_pk_bf16(v1[0], v1[1]); w.w = cvt_pk_bf16(v1[2], v1[3]);
                        *(u32x4*)(rowp + bj * HALF) = w; } }
        } else {
            if (wc == 0 && fq < 2) {
#pragma unroll
                for (int ai = 0; ai < 2; ++ai)
#pragma unroll
                    for (int m = 0; m < 4; ++m) { float* rowp = BA + (size_t)(row0 + ai * HALF + m * 16) * 16 + 8 * fq;
#pragma unroll
                        for (int n = 0; n < 2; ++n) *(f32x4*)(rowp + 4 * n) = acc[ai][0][m][n]; }
            }
        }
    }
};
template <int PASS> struct EpiBranch {
    static constexpr bool PERM = false, AFTER_DRAIN = false;
    const bf16_t* PROJ; float* MF; bf16_t* MB;
    __device__ __forceinline__ void operator()(const f32x4 (&acc)[2][2][4][2], const Unit& u, int wr, int wc, int fr, int fq) const {
        const int row0 = u.pm * BM + wr * 64 + fr, col0 = u.pn * BM + wc * 32 + 4 * fq;
#pragma unroll
        for (int ai = 0; ai < 2; ++ai)
#pragma unroll
            for (int m = 0; m < 4; ++m) { const size_t row = (size_t)(row0 + ai * HALF + m * 16);
#pragma unroll
                for (int bj = 0; bj < 2; ++bj)
#pragma unroll
                    for (int n = 0; n < 2; ++n) { const int col = col0 + bj * HALF + n * 16;
                        const u32x2 gw = *(const u32x2*)(PROJ + row * PROJ_LD + 9216 + PASS * 2048 + col);
                        f32x4 g; g[0] = sigmoidf_(bf_lo(gw.x)); g[1] = sigmoidf_(bf_hi(gw.x)); g[2] = sigmoidf_(bf_lo(gw.y)); g[3] = sigmoidf_(bf_hi(gw.y));
                        f32x4 v = g * acc[ai][bj][m][n];
                        float* mp = MF + row * 2048 + col;
                        if (PASS > 0) v += *(const f32x4*)mp;
                        if (PASS < 2) *(f32x4*)mp = v;
                        else { u32x2 w; w.x = cvt_pk_bf16(v[0], v[1]); w.y = cvt_pk_bf16(v[2], v[3]); *(u32x2*)(MB + row * 2048 + col) = w; } }
                asm volatile("" ::: "memory"); }
    }
};
struct EpiResid {
    static constexpr bool PERM = false, AFTER_DRAIN = false;
    const float* xin; float* xout; const float* gate;
    __device__ __forceinline__ void operator()(const f32x4 (&acc)[2][2][4][2], const Unit& u, int wr, int wc, int fr, int fq) const {
        const int row0 = u.pm * BM + wr * 64 + fr, col0 = u.pn * BM + wc * 32 + 4 * fq;
        f32x4 gv[2][2];
#pragma unroll
        for (int bj = 0; bj < 2; ++bj)
#pragma unroll
            for (int n = 0; n < 2; ++n) gv[bj][n] = *(const f32x4*)(gate + col0 + bj * HALF + n * 16);
#pragma unroll
        for (int ai = 0; ai < 2; ++ai)
#pragma unroll
            for (int m = 0; m < 4; ++m) { const size_t off = (size_t)(row0 + ai * HALF + m * 16) * 2048 + col0;
#pragma unroll
                for (int bj = 0; bj < 2; ++bj)
#pragma unroll
                    for (int n = 0; n < 2; ++n) { const f32x4 b = *(const f32x4*)(xin + off + bj * HALF + n * 16);
                        *(f32x4*)(xout + off + bj * HALF + n * 16) = b + gv[bj][n] * acc[ai][bj][m][n]; }
                asm volatile("" ::: "memory"); }
    }
};
struct EpiRelu2 {
    static constexpr bool PERM = true, AFTER_DRAIN = false;
    bf16_t* O;
    __device__ __forceinline__ void operator()(const f32x4 (&acc)[2][2][4][2], const Unit& u, int wr, int wc, int fr, int fq) const {
        const int row0 = u.pm * BM + wr * 64 + fr, col0 = u.pn * BM + wc * 32 + 8 * fq;
#pragma unroll
        for (int ai = 0; ai < 2; ++ai)
#pragma unroll
            for (int m = 0; m < 4; ++m) { bf16_t* rowp = O + (size_t)(row0 + ai * HALF + m * 16) * 8192 + col0;
#pragma unroll
                for (int bj = 0; bj < 2; ++bj) { f32x4 v0 = acc[ai][bj][m][0], v1 = acc[ai][bj][m][1];
#pragma unroll
                    for (int j = 0; j < 4; ++j) { const float a = fmaxf(v0[j], 0.f), b = fmaxf(v1[j], 0.f); v0[j] = a * a; v1[j] = b * b; }
                    u32x4 w; w.x = cvt_pk_bf16(v0[0], v0[1]); w.y = cvt_pk_bf16(v0[2], v0[3]); w.z = cvt_pk_bf16(v1[0], v1[1]); w.w = cvt_pk_bf16(v1[2], v1[3]);
                    *(u32x4*)(rowp + bj * HALF) = w; } }
    }
};

template <class Epi, class Sched, bool STAMP = false>
__device__ __forceinline__ void gemm_phase(PG8_LAS unsigned char* lds, const Gemm g, const Sched& S, const Epi& E, unsigned long long* stamps) {
    int tid = threadIdx.x; asm volatile("" : "+v"(tid));
    const int wid = __builtin_amdgcn_readfirstlane(tid >> 6), lane = tid & 63, wr = wid >> 2, wc = wid & 3, fr = lane & 15, fq = lane >> 4;
    const int K = g.K, nt = K / BK;
    int ts_lo = 0, ts_hi = 0, nts = 0; const unsigned long long rt_entry = STAMP ? (unsigned long long)wall_clock64() : 0ull;
#define PG8_STAMP() do { if (STAMP && wid == 0 && nts < 64) { const unsigned long long _c = (unsigned long long)clock64(); \
        ts_lo = (lane == nts) ? (int)(unsigned)_c : ts_lo; ts_hi = (lane == nts) ? (int)(unsigned)(_c >> 32) : ts_hi; ++nts; } } while (0)
    PG8_STAMP();
    unsigned voffA[2], voffB[2];
#pragma unroll
    for (int i = 0; i < 2; ++i) { int R, C; stage_rc(tid * 16 + i * 8192, R, C); const int Rb = Epi::PERM ? ((R & ~31) + perm32(R & 31)) : R;
        voffA[i] = (unsigned)(R * K + C) * 2u; voffB[i] = (unsigned)(Rb * K + C) * 2u; }
    const size_t kstep = (size_t)(BK * 2);
    const size_t hstep = (size_t)HALF * K * 2;
    const size_t tstep = 2 * hstep;
    const unsigned ldsw = (unsigned)wid * 1024u;
    const int aoff = lds_byte(wr * 64 + fr, fq * 8), boff = lds_byte(wc * 32 + fr, fq * 8);
#define PG8_SA(b, h) (((b) * 2 + (h)) * HTB)
#define PG8_SB(b, h) ((4 + (b) * 2 + (h)) * HTB)
#define PG8_STAGE(bufoff, gbase, voff) do { _Pragma("unroll") for (int _i = 0; _i < 2; ++_i) \
        __builtin_amdgcn_global_load_lds((const unsigned*)((const char*)(gbase) + (voff)[_i]), (PG8_LAS unsigned*)(lds + (bufoff) + ldsw + _i * 8192), 16, 0, 0); } while (0)
#define PG8_LDA(dst, b, h) do { _Pragma("unroll") for (int m = 0; m < 4; ++m) _Pragma("unroll") for (int k = 0; k < 2; ++k) dst[m][k] = *(const PG8_LAS bf16x8*)(lds + PG8_SA(b, h) + aoff + m * 2048 + k * 1024); } while (0)
#define PG8_LDB(dst, b, h) do { _Pragma("unroll") for (int n = 0; n < 2; ++n) _Pragma("unroll") for (int k = 0; k < 2; ++k) dst[n][k] = *(const PG8_LAS bf16x8*)(lds + PG8_SB(b, h) + boff + n * 2048 + k * 1024); } while (0)
#define PG8_MMA(ai, bj, At, Bt) do { __builtin_amdgcn_s_setprio(1); _Pragma("unroll") for (int m = 0; m < 4; ++m) _Pragma("unroll") for (int n = 0; n < 2; ++n) _Pragma("unroll") for (int k = 0; k < 2; ++k) \
        acc[ai][bj][m][n] = __builtin_amdgcn_mfma_f32_16x16x32_bf16(Bt[n][k], At[m][k], acc[ai][bj][m][n], 0, 0, 0); __builtin_amdgcn_s_setprio(0); } while (0)
#define PG8_WAIT_V(n) asm volatile("s_waitcnt vmcnt(" #n ")" ::: "memory")
#define PG8_WAIT_L(n) asm volatile("s_waitcnt lgkmcnt(" #n ")" ::: "memory")
#define PG8_BAR __builtin_amdgcn_s_barrier()
#define PG8_SCHED __builtin_amdgcn_sched_barrier(0)
    Unit cur, nxt; int ui = 0;
    if (!S.next(0, cur)) return;
    f32x4 acc[2][2][4][2];
#pragma unroll
    for (int a = 0; a < 2; ++a)
#pragma unroll
        for (int b = 0; b < 2; ++b)
#pragma unroll
            for (int m = 0; m < 4; ++m)
#pragma unroll
                for (int n = 0; n < 2; ++n) acc[a][b][m][n] = (f32x4){0.f, 0.f, 0.f, 0.f};
    bf16x8 At[4][2], B0[2][2], B1[2][2];
    const char* cA = (const char*)g.A + (size_t)cur.pm * tstep; const char* cB = (const char*)g.Bt + (size_t)cur.pn * tstep;
    S.a_ready(cur);
    PG8_STAGE(PG8_SB(0, 0), cB, voffB); PG8_STAGE(PG8_SA(0, 0), cA, voffA); PG8_STAGE(PG8_SB(0, 1), cB + hstep, voffB); PG8_STAGE(PG8_SA(0, 1), cA + hstep, voffA);
    if (wr == 1) PG8_BAR;
    PG8_WAIT_V(4); PG8_BAR;
    PG8_STAGE(PG8_SB(1, 0), cB + kstep, voffB); PG8_STAGE(PG8_SA(1, 0), cA + kstep, voffA); PG8_STAGE(PG8_SB(1, 1), cB + hstep + kstep, voffB);
    PG8_WAIT_V(6); PG8_BAR;
    PG8_STAMP();
    for (;;) {
        const bool has_next = S.next(ui + 1, nxt);
        const char* nA = has_next ? (const char*)g.A + (size_t)nxt.pm * tstep : cA; const char* nB = has_next ? (const char*)g.Bt + (size_t)nxt.pn * tstep : cB;
        for (int t = 0; t < nt; t += 2) {
            const bool last = (t == nt - 2);
            const char* a1 = cA + (size_t)(t + 1) * kstep;
            const char* a2 = last ? nA : cA + (size_t)(t + 2) * kstep; const char* b2 = last ? nB : cB + (size_t)(t + 2) * kstep;
            const char* a3 = a2 + kstep; const char* b3 = b2 + kstep;
            if (last && has_next) S.a_ready(nxt);
            PG8_LDB(B0, 0, 0); PG8_SCHED; PG8_LDA(At, 0, 0); PG8_STAGE(PG8_SA(1, 1), a1 + hstep, voffA);
            PG8_WAIT_L(8); PG8_BAR; PG8_WAIT_L(0); PG8_MMA(0, 0, At, B0); PG8_BAR; PG8_SCHED;
            PG8_LDB(B1, 0, 1); PG8_STAGE(PG8_SB(0, 0), b2, voffB);
            PG8_BAR; PG8_WAIT_L(0); PG8_MMA(0, 1, At, B1); PG8_BAR;
            PG8_LDA(At, 0, 1); PG8_STAGE(PG8_SA(0, 0), a2, voffA);
            PG8_BAR; PG8_WAIT_L(0); PG8_MMA(1, 0, At, B0); PG8_BAR; PG8_SCHED;
            PG8_STAGE(PG8_SB(0, 1), b2 + hstep, voffB);
            PG8_WAIT_V(6); PG8_BAR; PG8_MMA(1, 1, At, B1); PG8_BAR;
            PG8_LDB(B0, 1, 0); PG8_SCHED; PG8_LDA(At, 1, 0); PG8_STAGE(PG8_SA(0, 1), a2 + hstep, voffA);
            PG8_WAIT_L(8); PG8_BAR; PG8_WAIT_L(0); PG8_MMA(0, 0, At, B0); PG8_BAR; PG8_SCHED;
            PG8_LDB(B1, 1, 1); PG8_STAGE(PG8_SB(1, 0), b3, voffB);
            PG8_BAR; PG8_WAIT_L(0); PG8_MMA(0, 1, At, B1); PG8_BAR;
            PG8_LDA(At, 1, 1); PG8_STAGE(PG8_SA(1, 0), a3, voffA);
            PG8_BAR; PG8_WAIT_L(0); PG8_MMA(1, 0, At, B0); PG8_BAR; PG8_SCHED;
            PG8_STAGE(PG8_SB(1, 1), b3 + hstep, voffB);
            PG8_WAIT_V(6); PG8_BAR; PG8_MMA(1, 1, At, B1); PG8_BAR;
        }
        PG8_STAMP();
        if constexpr (!Epi::AFTER_DRAIN) { E(acc, cur, wr, wc, fr, fq); S.done(cur); }
        PG8_STAMP();
        if (!has_next) break;
#pragma unroll
        for (int a = 0; a < 2; ++a)
#pragma unroll
            for (int b = 0; b < 2; ++b)
#pragma unroll
                for (int m = 0; m < 4; ++m)
#pragma unroll
                    for (int n = 0; n < 2; ++n) acc[a][b][m][n] = (f32x4){0.f, 0.f, 0.f, 0.f};
        cur = nxt; cA = nA; cB = nB; ++ui;
    }
    PG8_WAIT_V(0);
    if (wr == 0) PG8_BAR;
    PG8_BAR;
    if constexpr (Epi::AFTER_DRAIN) { E.fused(acc, cur, wr, wc, fr, fq, lds, wid, lane); S.done(cur); }
    PG8_STAMP();
    if (STAMP && wid == 0) { stamps[lane] = lane < nts ? (((unsigned long long)(unsigned)ts_hi << 32) | (unsigned)ts_lo) : 0ull;
        if (lane == 62) stamps[62] = rt_entry; if (lane == 63) stamps[63] = (unsigned long long)wall_clock64(); }
#undef PG8_STAMP
#undef PG8_SA
#undef PG8_SB
#undef PG8_STAGE
#undef PG8_LDA
#undef PG8_LDB
#undef PG8_MMA
#undef PG8_WAIT_V
#undef PG8_WAIT_L
#undef PG8_BAR
#undef PG8_SCHED
}
}
using namespace pg8;
namespace cg = cooperative_groups;
#define LAS PG8_LAS
#define DI __device__ __forceinline__

constexpr int T_ = 8192, D_ = 2048, INW = 15376, NP1 = 15616, DFF = 8192;
constexpr int LDS_BYTES = 147456;
constexpr int NTHR = 512;
constexpr float EPS = 1e-6f;

constexpr size_t SZ_WT_IN = (size_t)NP1 * 2048 * 2, SZ_WT_BR = (size_t)2048 * 1024 * 2, SZ_WT_O = (size_t)2048 * 2048 * 2, SZ_WT_M = (size_t)8192 * 2048 * 2;
constexpr size_t SZ_WL = SZ_WT_IN + 3 * SZ_WT_BR + SZ_WT_O + 2 * SZ_WT_M;
constexpr size_t WS_W = 0;
constexpr size_t WS_MOD = WS_W + 2 * SZ_WL;
constexpr size_t WS_XC = WS_MOD + 2 * 12288 * 4;
constexpr size_t WS_H = WS_XC + (size_t)T_ * D_ * 4;
constexpr size_t WS_PROJ = WS_H + (size_t)T_ * D_ * 2;
constexpr size_t WS_BA = WS_PROJ + (size_t)T_ * 15360 * 2;
constexpr size_t WS_R2 = WS_BA + (size_t)T_ * 16 * 4;
constexpr size_t G_U = WS_R2;
constexpr size_t G_W = G_U + (size_t)T_ * 1024 * 4;
constexpr size_t G_QD = G_W + (size_t)T_ * 1024 * 2;
constexpr size_t G_KDT = G_QD + (size_t)T_ * 1024 * 2;
constexpr size_t G_ATT = G_KDT + (size_t)T_ * 1024 * 2;
constexpr size_t G_GL = G_ATT + (size_t)T_ * 512 * 2;
constexpr size_t R_SC = G_GL + 4096;
constexpr size_t R_QI = R_SC + (size_t)T_ * 256 * 2;
constexpr size_t R_KTT = R_QI + (size_t)T_ * 512 * 2;
constexpr size_t R_VT = R_KTT + (size_t)T_ * 512 * 2;
constexpr size_t WS_R3 = R_VT + (size_t)T_ * 1024 * 2;
constexpr size_t WS_OA = WS_R3;
constexpr size_t WS_OB = WS_OA + (size_t)T_ * 1024 * 4;
constexpr size_t WS_CV = WS_OB + (size_t)T_ * 1024 * 4;
constexpr size_t WS_ACT = WS_CV + (size_t)T_ * 1024 * 4;
constexpr size_t WS_MB = WS_ACT + 3 * (size_t)T_ * 1024 * 2;
constexpr size_t WS_END = WS_MB + (size_t)T_ * D_ * 2;
constexpr size_t WS_MF = WS_R2;
static_assert(WS_MF + (size_t)T_ * D_ * 4 <= WS_R3, "merged f32 alias");

struct Params {
    const float* x; const float* c; const int* pos; const float* w_ada; const float* b_ada; const float* norm_mix_w; const float* norm_mlp_w; const float* w_in;
    const float* conv_qkv_w; const float* a_log; const float* dt_bias; const float* gdn_norm_w; const float* conv_dw_w; const float* conv_dw_b; const float* conv_ln_w; const float* conv_ln_b;
    const float* w_a; const float* w_b; const float* w_c; const float* w_out; const float* w_mi; const float* w_mo; const float* final_w;
    float* out; unsigned char* ws; int ph_lo, ph_hi;
};

DI unsigned pk2(float lo, float hi) { return cvt_pk_bf16(lo, hi); }
DI bf16_t f2bf(float f) { return (bf16_t)(cvt_pk_bf16(f, 0.f) & 0xffffu); }
DI float siluf_(float x) { return x / (1.0f + __expf(-x)); }
DI float wave_sum(float v) {
#pragma unroll
    for (int o = 1; o < 64; o <<= 1) v += __shfl_xor(v, o);
    return v;
}
DI void lds_barrier() { asm volatile("s_waitcnt lgkmcnt(0)" ::: "memory"); __builtin_amdgcn_s_barrier(); asm volatile("" ::: "memory"); }
DI void full_barrier() { asm volatile("s_waitcnt vmcnt(0) lgkmcnt(0)" ::: "memory"); __builtin_amdgcn_s_barrier(); asm volatile("" ::: "memory"); }
DI f32x4 mfma16(bf16x8 a, bf16x8 b, f32x4 c) { return __builtin_amdgcn_mfma_f32_16x16x32_bf16(a, b, c, 0, 0, 0); }
DI bf16x8 lds_frag(LAS unsigned char* base, int row, int stride_el, int k0) { return *(const LAS bf16x8*)(base + ((size_t)row * stride_el + k0) * 2); }
DI void unpack8(const u32x4 w, float (&f)[8]) { f[0] = bf_lo(w.x); f[1] = bf_hi(w.x); f[2] = bf_lo(w.y); f[3] = bf_hi(w.y); f[4] = bf_lo(w.z); f[5] = bf_hi(w.z); f[6] = bf_lo(w.w); f[7] = bf_hi(w.w); }
DI u32x4 pack8(const float* f) { u32x4 w; w.x = pk2(f[0], f[1]); w.y = pk2(f[2], f[3]); w.z = pk2(f[4], f[5]); w.w = pk2(f[6], f[7]); return w; }

DI void transpose_item(const float* W, int ldw, int K, int src_col0, int valid, bf16_t* WT, int dst_row0, int k0, LAS float* scr, int lane) {
    const int nn = lane & 31;
#pragma unroll 8
    for (int i = 0; i < 32; ++i) { const int kk = 2 * i + (lane >> 5);
        float v = 0.f; if (nn < valid) v = W[(size_t)(k0 + kk) * ldw + src_col0 + nn];
        scr[kk * 33 + nn] = v; }
    asm volatile("s_waitcnt lgkmcnt(0)" ::: "memory");
    const int c = lane & 7;
#pragma unroll
    for (int j = 0; j < 4; ++j) { const int n = (lane >> 3) + 8 * j; const LAS float* s = scr + (8 * c) * 33 + n;
        u32x4 o; o.x = pk2(s[0 * 33], s[1 * 33]); o.y = pk2(s[2 * 33], s[3 * 33]); o.z = pk2(s[4 * 33], s[5 * 33]); o.w = pk2(s[6 * 33], s[7 * 33]);
        *(u32x4*)(WT + (size_t)(dst_row0 + n) * K + k0 + 8 * c) = o; }
    asm volatile("s_waitcnt lgkmcnt(0)" ::: "memory");
}

DI void phase_prep(const Params& p, LAS unsigned char* lds, int tid) {
    const int lane = tid & 63, wave = tid >> 6, G = gridDim.x, b = blockIdx.x;
    float* mod = (float*)(p.ws + WS_MOD);
    for (int u = b; u < 192; u += G) {
        const int l = u / 96, strip = u % 96, kg = tid >> 5, cl = tid & 31, col = 128 * strip + 4 * cl;
        f32x4 acc = {0.f, 0.f, 0.f, 0.f};
        const float* wp = p.w_ada + (size_t)l * 2048 * 12288 + col;
#pragma unroll 8
        for (int k = kg; k < 2048; k += 16) { const float s = siluf_(p.c[k]); const f32x4 w = *(const f32x4*)(wp + (size_t)k * 12288); acc += s * w; }
        LAS f32x4* red = (LAS f32x4*)lds;
        red[kg * 32 + cl] = acc;
        lds_barrier();
        if (tid < 128) { float s = 0.f; const LAS float* rf = (const LAS float*)lds;
#pragma unroll
            for (int g = 0; g < 16; ++g) s += rf[g * 128 + tid];
            mod[l * 12288 + 128 * strip + tid] = s + p.b_ada[l * 12288 + 128 * strip + tid]; }
        lds_barrier();
    }
    LAS float* scr = (LAS float*)(lds + wave * 16384);
    const int gw = b * 8 + wave, NGW = G * 8;
    constexpr int I_IN = 488 * 32, I_BR = 64 * 16, I_O = 64 * 32, I_MI = 256 * 32, I_MO = 64 * 128, I_L = I_IN + 3 * I_BR + I_O + I_MI + I_MO;
    for (int it = gw; it < 2 * I_L; it += NGW) {
        const int l = it / I_L; int r = it % I_L;
        unsigned char* wl = p.ws + WS_W + (size_t)l * SZ_WL;
        if (r < I_IN) { const int kb = r / 488, nb = r % 488, d0 = 32 * nb; int src, valid;
            if (d0 < 4096) { src = d0; valid = 32; } else if (d0 < 15360) { src = d0 + 16; valid = 32; } else if (d0 == 15360) { src = 4096; valid = 16; } else { src = 0; valid = 0; }
            transpose_item(p.w_in + (size_t)l * 2048 * INW, INW, 2048, src, valid, (bf16_t*)wl, d0, 64 * kb, scr, lane); continue; }
        r -= I_IN;
        if (r < 3 * I_BR) { const int which = r / I_BR, q = r % I_BR, kb = q / 64, nb = q % 64;
            const float* W = (which == 0 ? p.w_a : which == 1 ? p.w_b : p.w_c) + (size_t)l * 1024 * 2048;
            transpose_item(W, 2048, 1024, 32 * nb, 32, (bf16_t*)(wl + SZ_WT_IN + which * SZ_WT_BR), 32 * nb, 64 * kb, scr, lane); continue; }
        r -= 3 * I_BR;
        if (r < I_O) { const int kb = r / 64, nb = r % 64;
            transpose_item(p.w_out + (size_t)l * 2048 * 2048, 2048, 2048, 32 * nb, 32, (bf16_t*)(wl + SZ_WT_IN + 3 * SZ_WT_BR), 32 * nb, 64 * kb, scr, lane); continue; }
        r -= I_O;
        if (r < I_MI) { const int kb = r / 256, nb = r % 256;
            transpose_item(p.w_mi + (size_t)l * 2048 * 8192, 8192, 2048, 32 * nb, 32, (bf16_t*)(wl + SZ_WT_IN + 3 * SZ_WT_BR + SZ_WT_O), 32 * nb, 64 * kb, scr, lane); continue; }
        r -= I_MI;
        { const int kb = r / 64, nb = r % 64;
            transpose_item(p.w_mo + (size_t)l * 8192 * 2048, 2048, 8192, 32 * nb, 32, (bf16_t*)(wl + SZ_WT_IN + 3 * SZ_WT_BR + SZ_WT_O + SZ_WT_M), 32 * nb, 64 * kb, scr, lane); }
    }
}

DI void phase_norm(const float* xin, const float* nw, const float* scale, const float* shift, bf16_t* H, float* outf, int tid) {
    const int lane = tid & 63, wave = tid >> 6, gw = blockIdx.x * 8 + wave, NGW = gridDim.x * 8;
    for (int row = gw; row < T_; row += NGW) {
        const float* xr = xin + (size_t)row * D_;
        f32x4 v[8]; float ss = 0.f;
#pragma unroll
        for (int j = 0; j < 8; ++j) { v[j] = *(const f32x4*)(xr + (j * 64 + lane) * 4); ss += (v[j][0] * v[j][0] + v[j][1] * v[j][1]) + (v[j][2] * v[j][2] + v[j][3] * v[j][3]); }
        ss = wave_sum(ss);
        const float rstd = 1.0f / sqrtf(ss * (1.0f / D_) + EPS);
#pragma unroll
        for (int j = 0; j < 8; ++j) { const int c = (j * 64 + lane) * 4; const f32x4 w = *(const f32x4*)(nw + c);
            f32x4 y = v[j] * rstd * w;
            if (H) { const f32x4 sc = *(const f32x4*)(scale + c), sh = *(const f32x4*)(shift + c); y = y * (1.0f + sc) + sh;
                u32x2 o; o.x = pk2(y[0], y[1]); o.y = pk2(y[2], y[3]); *(u32x2*)(H + (size_t)row * D_ + c) = o; }
            else *(f32x4*)(outf + (size_t)row * D_ + c) = y; }
    }
}

DI void gdn_prep_unit(const Params& p, int l, int hh, int n, LAS unsigned char* lds, int tid) {
    asm volatile("" : "+v"(tid));
    const int lane = tid & 63, wave = tid >> 6, quad = lane >> 4, l15 = lane & 15;
    const int r = tid >> 3, cgp = tid & 7, t = 64 * n + r;
    constexpr int K_OFF = 0, KB_OFF = 17408, Q_OFF = 34816, VBT_OFF = 52224, KBGT_OFF = 70656, KDT_OFF = 89088, T_OFF = 107520, L_OFF = 116736, SG_OFF = 134144, SB_OFF = SG_OFF + 256, GC_OFF = SB_OFF + 256;
    static_assert(GC_OFF + 256 <= LDS_BYTES, "lds");
    const bf16_t* PROJ = (const bf16_t*)(p.ws + WS_PROJ); const float* BA = (const float*)(p.ws + WS_BA);
    const size_t ub = (size_t)hh * 128 + n;
    float val[3][16];
#pragma unroll
    for (int X = 0; X < 3; ++X) {
        const int ch = X * 1024 + hh * 128 + 16 * cgp;
#pragma unroll
        for (int i = 0; i < 16; ++i) val[X][i] = 0.f;
#pragma unroll
        for (int j = 0; j < 4; ++j) { const int tt = t - 3 + j;
            if (tt >= 0) { const u32x4 a = *(const u32x4*)(PROJ + (size_t)tt * PROJ_LD + ch), bq = *(const u32x4*)(PROJ + (size_t)tt * PROJ_LD + ch + 8);
                float xa[8], xb[8]; unpack8(a, xa); unpack8(bq, xb);
                const float* cw = p.conv_qkv_w + ((size_t)l * 4 + j) * 3072 + ch;
#pragma unroll
                for (int q4 = 0; q4 < 4; ++q4) { const f32x4 w = *(const f32x4*)(cw + 4 * q4);
#pragma unroll
                    for (int e = 0; e < 4; ++e) { const int i = 4 * q4 + e; val[X][i] += w[e] * (i < 8 ? xa[i] : xb[i - 8]); } } } }
#pragma unroll
        for (int i = 0; i < 16; ++i) val[X][i] = siluf_(val[X][i]);
        asm volatile("" ::: "memory");
    }
    {   float sq = 0.f, sk = 0.f;
#pragma unroll
        for (int i = 0; i < 16; ++i) { sq += val[0][i] * val[0][i]; sk += val[1][i] * val[1][i]; }
        sq += __shfl_xor(sq, 1); sq += __shfl_xor(sq, 2); sq += __shfl_xor(sq, 4);
        sk += __shfl_xor(sk, 1); sk += __shfl_xor(sk, 2); sk += __shfl_xor(sk, 4);
        const float rq = (1.0f / sqrtf(sq + 1e-6f)) * 0.08838834764831845f, rk = 1.0f / sqrtf(sk + 1e-6f);
#pragma unroll
        for (int i = 0; i < 16; ++i) { val[0][i] *= rq; val[1][i] *= rk; }
    }
    LAS float* SG = (LAS float*)(lds + SG_OFF); LAS float* SB = (LAS float*)(lds + SB_OFF); LAS float* GC = (LAS float*)(lds + GC_OFF);
    if (cgp == 0) { const float ab = BA[(size_t)t * 16 + hh], aa = BA[(size_t)t * 16 + 8 + hh];
        const float xx = aa + p.dt_bias[l * 8 + hh]; const float sp = xx > 20.f ? xx : log1pf(expf(xx));
        SG[r] = -expf(p.a_log[l * 8 + hh]) * sp; SB[r] = 1.0f / (1.0f + expf(-ab)); }
    lds_barrier();
    if (wave == 0) { float xg = SG[lane];
#pragma unroll
        for (int o = 1; o < 64; o <<= 1) { const float y = __shfl_up(xg, o); if (lane >= o) xg += y; }
        GC[lane] = xg; }
    lds_barrier();
    {   const float bta = SB[r], gcr = GC[r], glast = GC[63], eg = expf(gcr), ekd = expf(glast - gcr);
        float tq[16], tk[16], tkb[16];
#pragma unroll
        for (int i = 0; i < 16; ++i) { tq[i] = val[0][i]; tk[i] = val[1][i]; tkb[i] = val[1][i] * bta; }
        *(LAS u32x4*)(lds + K_OFF + (r * 136 + 16 * cgp) * 2) = pack8(tk); *(LAS u32x4*)(lds + K_OFF + (r * 136 + 16 * cgp + 8) * 2) = pack8(tk + 8);
        *(LAS u32x4*)(lds + KB_OFF + (r * 136 + 16 * cgp) * 2) = pack8(tkb); *(LAS u32x4*)(lds + KB_OFF + (r * 136 + 16 * cgp + 8) * 2) = pack8(tkb + 8);
        *(LAS u32x4*)(lds + Q_OFF + (r * 136 + 16 * cgp) * 2) = pack8(tq); *(LAS u32x4*)(lds + Q_OFF + (r * 136 + 16 * cgp + 8) * 2) = pack8(tq + 8);
#pragma unroll
        for (int i = 0; i < 16; ++i) { const int e = 16 * cgp + i;
            *(LAS bf16_t*)(lds + VBT_OFF + (e * 72 + r) * 2) = f2bf(val[2][i] * bta);
            *(LAS bf16_t*)(lds + KBGT_OFF + (e * 72 + r) * 2) = f2bf(tkb[i] * eg);
            *(LAS bf16_t*)(lds + KDT_OFF + (e * 72 + r) * 2) = f2bf(tk[i] * ekd); }
        float tqd[16];
#pragma unroll
        for (int i = 0; i < 16; ++i) tqd[i] = tq[i] * eg;
        bf16_t* QD = (bf16_t*)(p.ws + G_QD) + (ub * 64 + r) * 128 + 16 * cgp;
        *(u32x4*)QD = pack8(tqd); *(u32x4*)(QD + 8) = pack8(tqd + 8);
        if (tid == 0) ((float*)(p.ws + G_GL))[ub] = expf(glast);
    }
    lds_barrier();
    LAS float* Lm = (LAS float*)(lds + L_OFF);
#pragma unroll
    for (int tt = 0; tt < 2; ++tt) { const int id = 2 * wave + tt, mi = id >> 2, ni = id & 3;
        f32x4 aK = {0.f, 0.f, 0.f, 0.f}, aA = {0.f, 0.f, 0.f, 0.f};
#pragma unroll
        for (int ks = 0; ks < 4; ++ks) { const bf16x8 kf = lds_frag(lds + K_OFF, 16 * ni + l15, 136, 32 * ks + 8 * quad);
            const bf16x8 kbf = lds_frag(lds + KB_OFF, 16 * mi + l15, 136, 32 * ks + 8 * quad), qf = lds_frag(lds + Q_OFF, 16 * mi + l15, 136, 32 * ks + 8 * quad);
            aK = mfma16(kbf, kf, aK);
            aA = mfma16(kf, qf, aA); }
        { const int s = 16 * ni + l15; const float gs = GC[s];
#pragma unroll
            for (int j = 0; j < 4; ++j) { const int c = 16 * mi + 4 * quad + j; Lm[c * 68 + s] = (c > s) ? aK[j] * expf(GC[c] - gs) : 0.f; } }
        { const int c = 16 * mi + l15; const float gcc = GC[c]; float o[4];
#pragma unroll
            for (int j = 0; j < 4; ++j) { const int s = 16 * ni + 4 * quad + j; o[j] = (c >= s) ? aA[j] * expf(gcc - GC[s]) : 0.f; }
            u32x2 w; w.x = pk2(o[0], o[1]); w.y = pk2(o[2], o[3]);
            *(u32x2*)((bf16_t*)(p.ws + G_ATT) + (ub * 64 + c) * 64 + 16 * ni + 4 * quad) = w; }
    }
#pragma unroll
    for (int i = 0; i < 2; ++i) { const int id = tid + 512 * i, row = id >> 3, chn = id & 7;
        *(u32x4*)((bf16_t*)(p.ws + G_KDT) + (ub * 128 + row) * 64 + 8 * chn) = *(const LAS u32x4*)(lds + KDT_OFF + (row * 72 + 8 * chn) * 2); }
    lds_barrier();
    if (wave == 0) {
        float Tc[64];
        int zoff; asm volatile("v_mov_b32 %0, 0" : "=v"(zoff));
        const LAS float* Lz = Lm + zoff;
#pragma unroll
        for (int i = 0; i < 64; ++i) { float a = (lane == i) ? 1.f : 0.f;
#pragma unroll
            for (int j4 = 0; j4 < (i + 3) / 4; ++j4) { const f32x4 lv = *(const LAS f32x4*)(Lz + i * 68 + 4 * j4);
#pragma unroll
                for (int jj = 0; jj < 4; ++jj) if (4 * j4 + jj < i) a -= lv[jj] * Tc[4 * j4 + jj]; }
            Tc[i] = a; if (i & 1) asm volatile("" ::: "memory"); }
#pragma unroll
        for (int i = 0; i < 64; ++i) *(LAS bf16_t*)(lds + T_OFF + (i * 72 + lane) * 2) = f2bf(Tc[i]);
    }
    lds_barrier();
    {   bf16x8 vf[2], gf[2];
#pragma unroll
        for (int ks = 0; ks < 2; ++ks) { vf[ks] = lds_frag(lds + VBT_OFF, 16 * wave + l15, 72, 32 * ks + 8 * quad); gf[ks] = lds_frag(lds + KBGT_OFF, 16 * wave + l15, 72, 32 * ks + 8 * quad); }
#pragma unroll
        for (int mi = 0; mi < 4; ++mi) { f32x4 aU = {0.f, 0.f, 0.f, 0.f}, aW = {0.f, 0.f, 0.f, 0.f};
#pragma unroll
            for (int ks = 0; ks < 2; ++ks) { const bf16x8 tf = lds_frag(lds + T_OFF, 16 * mi + l15, 72, 32 * ks + 8 * quad);
                aU = mfma16(vf[ks], tf, aU); aW = mfma16(gf[ks], tf, aW); }
            const int c = 16 * mi + l15;
            *(f32x4*)((float*)(p.ws + G_U) + (ub * 64 + c) * 128 + 16 * wave + 4 * quad) = aU;
            u32x2 w; w.x = pk2(aW[0], aW[1]); w.y = pk2(aW[2], aW[3]);
            *(u32x2*)((bf16_t*)(p.ws + G_W) + (ub * 64 + c) * 128 + 16 * wave + 4 * quad) = w; }
    }
    lds_barrier();
}

DI void ret_prep_unit(const Params& p, int hr, int n, LAS unsigned char* lds, int tid) {
    asm volatile("" : "+v"(tid));
    const int lane = tid & 63, wave = tid >> 6, quad = lane >> 4, l15 = lane & 15;
    const int r = tid >> 3, cgp = tid & 7, t = 64 * n + r;
    constexpr int RQ_OFF = 0, RK_OFF = 17408, KTT_OFF = 34816, VT_OFF = 53248;
    const bf16_t* PROJ = (const bf16_t*)(p.ws + WS_PROJ);
    const size_t ub = (size_t)hr * 128 + n;
    const float lg2 = log2f(1.0f - exp2f(-5.0f - (float)hr));
    const float xi = exp2f((float)(r + 1) * lg2), zeta = exp2f((float)(63 - r) * lg2);
    const float posf = (float)p.pos[t];
    {   const bf16_t* pq = PROJ + (size_t)t * PROJ_LD + 4096 + hr * 128 + 8 * cgp; const bf16_t* pk = PROJ + (size_t)t * PROJ_LD + 4608 + hr * 128 + 8 * cgp;
        float q1[8], q2[8], k1[8], k2[8];
        unpack8(*(const u32x4*)pq, q1); unpack8(*(const u32x4*)(pq + 64), q2); unpack8(*(const u32x4*)pk, k1); unpack8(*(const u32x4*)(pk + 64), k2);
        float rq1[8], rq2[8], rk1[8], rk2[8];
#pragma unroll
        for (int ii = 0; ii < 8; ++ii) { const int i = 8 * cgp + ii;
            const float invf = expf(-(float)i * (9.210340371976184f / 64.0f)); const float ang = posf * invf; const float cs = cosf(ang), sn = sinf(ang);
            rq1[ii] = q1[ii] * cs - q2[ii] * sn; rq2[ii] = q1[ii] * sn + q2[ii] * cs;
            rk1[ii] = (k1[ii] * cs - k2[ii] * sn) * 0.08838834764831845f; rk2[ii] = (k1[ii] * sn + k2[ii] * cs) * 0.08838834764831845f; }
        *(LAS u32x4*)(lds + RQ_OFF + (r * 136 + 8 * cgp) * 2) = pack8(rq1); *(LAS u32x4*)(lds + RQ_OFF + (r * 136 + 64 + 8 * cgp) * 2) = pack8(rq2);
        *(LAS u32x4*)(lds + RK_OFF + (r * 136 + 8 * cgp) * 2) = pack8(rk1); *(LAS u32x4*)(lds + RK_OFF + (r * 136 + 64 + 8 * cgp) * 2) = pack8(rk2);
#pragma unroll
        for (int ii = 0; ii < 8; ++ii) { *(LAS bf16_t*)(lds + KTT_OFF + ((8 * cgp + ii) * 72 + r) * 2) = f2bf(rk1[ii] * zeta); *(LAS bf16_t*)(lds + KTT_OFF + ((64 + 8 * cgp + ii) * 72 + r) * 2) = f2bf(rk2[ii] * zeta);
            rq1[ii] *= xi; rq2[ii] *= xi; }
        bf16_t* QI = (bf16_t*)(p.ws + R_QI) + (ub * 64 + r) * 128 + 8 * cgp;
        *(u32x4*)QI = pack8(rq1); *(u32x4*)(QI + 64) = pack8(rq2);
    }
    {   const bf16_t* pv = PROJ + (size_t)t * PROJ_LD + 5120 + hr * 256 + 32 * cgp;
#pragma unroll
        for (int q = 0; q < 4; ++q) { float vv[8]; unpack8(*(const u32x4*)(pv + 8 * q), vv);
#pragma unroll
            for (int i = 0; i < 8; ++i) *(LAS bf16_t*)(lds + VT_OFF + ((32 * cgp + 8 * q + i) * 72 + r) * 2) = f2bf(vv[i]); }
    }
    lds_barrier();
#pragma unroll
    for (int tt = 0; tt < 2; ++tt) { const int id = 2 * wave + tt, mi = id >> 2, ni = id & 3;
        f32x4 aA = {0.f, 0.f, 0.f, 0.f};
#pragma unroll
        for (int ks = 0; ks < 4; ++ks) { const bf16x8 kf = lds_frag(lds + RK_OFF, 16 * ni + l15, 136, 32 * ks + 8 * quad), qf = lds_frag(lds + RQ_OFF, 16 * mi + l15, 136, 32 * ks + 8 * quad);
            aA = mfma16(kf, qf, aA); }
        const int c = 16 * mi + l15; float o[4];
#pragma unroll
        for (int j = 0; j < 4; ++j) { const int s = 16 * ni + 4 * quad + j; o[j] = (c >= s) ? aA[j] * exp2f((float)(c - s) * lg2) : 0.f; }
        u32x2 w; w.x = pk2(o[0], o[1]); w.y = pk2(o[2], o[3]);
        *(u32x2*)((bf16_t*)(p.ws + R_SC) + (ub * 64 + c) * 64 + 16 * ni + 4 * quad) = w; }
#pragma unroll
    for (int i = 0; i < 2; ++i) { const int id = tid + 512 * i, row = id >> 3, chn = id & 7;
        *(u32x4*)((bf16_t*)(p.ws + R_KTT) + (ub * 128 + row) * 64 + 8 * chn) = *(const LAS u32x4*)(lds + KTT_OFF + (row * 72 + 8 * chn) * 2); }
#pragma unroll
    for (int i = 0; i < 4; ++i) { const int id = tid + 512 * i, row = id >> 3, chn = id & 7;
        *(u32x4*)((bf16_t*)(p.ws + R_VT) + (ub * 256 + row) * 64 + 8 * chn) = *(const LAS u32x4*)(lds + VT_OFF + (row * 72 + 8 * chn) * 2); }
    lds_barrier();
}

struct GFrag { bf16x8 wf[4], qf[4], af[2], kf[2]; float uu[4]; float gl; };
DI void gdn_load(GFrag& f, const unsigned char* ws, int hh, int es, int n, int wave, int quad, int l15) {
    const int mi = wave >> 1, ei = wave & 1; const size_t ub = (size_t)hh * 128 + n;
    const bf16_t* Wp = (const bf16_t*)(ws + G_W) + (ub * 64 + 16 * mi + l15) * 128 + 8 * quad;
    const bf16_t* Qp = (const bf16_t*)(ws + G_QD) + (ub * 64 + 16 * mi + l15) * 128 + 8 * quad;
    const bf16_t* Ap = (const bf16_t*)(ws + G_ATT) + (ub * 64 + 16 * mi + l15) * 64 + 8 * quad;
    const bf16_t* Kp = (const bf16_t*)(ws + G_KDT) + (ub * 128 + 16 * wave + l15) * 64 + 8 * quad;
    const float* Up = (const float*)(ws + G_U) + (ub * 64 + 16 * mi + 4 * quad) * 128 + 32 * es + 16 * ei + l15;
#pragma unroll
    for (int ks = 0; ks < 4; ++ks) { f.wf[ks] = *(const bf16x8*)(Wp + 32 * ks); f.qf[ks] = *(const bf16x8*)(Qp + 32 * ks); }
#pragma unroll
    for (int ks = 0; ks < 2; ++ks) { f.af[ks] = *(const bf16x8*)(Ap + 32 * ks); f.kf[ks] = *(const bf16x8*)(Kp + 32 * ks); }
#pragma unroll
    for (int j = 0; j < 4; ++j) f.uu[j] = Up[j * 128];
    f.gl = ((const float*)(ws + G_GL))[ub];
}
DI void gdn_chain(const Params& p, int hh, int es, LAS unsigned char* lds, int tid) {
    asm volatile("" : "+v"(tid));
    const int lane = tid & 63, wave = tid >> 6, quad = lane >> 4, l15 = lane & 15, mi = wave >> 1, ei = wave & 1;
    constexpr int ST_OFF = 0, VNT_OFF = 8704;
    for (int i = tid; i < 8704 / 4; i += NTHR) ((LAS unsigned*)(lds + ST_OFF))[i] = 0u;
    f32x4 Sacc[2] = {{0.f, 0.f, 0.f, 0.f}, {0.f, 0.f, 0.f, 0.f}};
    float* OA = (float*)(p.ws + WS_OA);
    GFrag cur, nxt;
    gdn_load(cur, p.ws, hh, es, 0, wave, quad, l15);
    lds_barrier();
    for (int n = 0; n < 128; ++n) {
        gdn_load(nxt, p.ws, hh, es, n + 1 < 128 ? n + 1 : n, wave, quad, l15);
        f32x4 aw = {0.f, 0.f, 0.f, 0.f}, aq = {0.f, 0.f, 0.f, 0.f};
#pragma unroll
        for (int ks = 0; ks < 4; ++ks) { const bf16x8 sf = lds_frag(lds + ST_OFF, 16 * ei + l15, 136, 32 * ks + 8 * quad); aw = mfma16(cur.wf[ks], sf, aw); aq = mfma16(cur.qf[ks], sf, aq); }
        {   u32x2 w; w.x = pk2(cur.uu[0] - aw[0], cur.uu[1] - aw[1]); w.y = pk2(cur.uu[2] - aw[2], cur.uu[3] - aw[3]);
            *(LAS u32x2*)(lds + VNT_OFF + ((16 * ei + l15) * 72 + 16 * mi + 4 * quad) * 2) = w; }
        lds_barrier();
#pragma unroll
        for (int ks = 0; ks < 2; ++ks) { const bf16x8 vf = lds_frag(lds + VNT_OFF, 16 * ei + l15, 72, 32 * ks + 8 * quad); aq = mfma16(cur.af[ks], vf, aq); }
        {   float* op = OA + (size_t)(64 * n + 16 * mi + 4 * quad) * 1024 + hh * 128 + 32 * es + 16 * ei + l15;
#pragma unroll
            for (int j = 0; j < 4; ++j) op[(size_t)j * 1024] = aq[j]; }
#pragma unroll
        for (int et = 0; et < 2; ++et) { f32x4 a = Sacc[et] * cur.gl;
#pragma unroll
            for (int ks = 0; ks < 2; ++ks) { const bf16x8 vf = lds_frag(lds + VNT_OFF, 16 * et + l15, 72, 32 * ks + 8 * quad); a = mfma16(cur.kf[ks], vf, a); }
            Sacc[et] = a;
            u32x2 w; w.x = pk2(a[0], a[1]); w.y = pk2(a[2], a[3]);
            *(LAS u32x2*)(lds + ST_OFF + ((16 * et + l15) * 136 + 16 * wave + 4 * quad) * 2) = w; }
        lds_barrier();
        cur = nxt;
    }
}

struct RFrag { bf16x8 qf[4], sf[2], kf[2], vf[2][2]; };
DI void ret_load(RFrag& f, const unsigned char* ws, int hr, int es, int n, int wave, int quad, int l15) {
    const int mi = wave >> 1; const size_t ub = (size_t)hr * 128 + n;
    const bf16_t* Qp = (const bf16_t*)(ws + R_QI) + (ub * 64 + 16 * mi + l15) * 128 + 8 * quad;
    const bf16_t* Sp = (const bf16_t*)(ws + R_SC) + (ub * 64 + 16 * mi + l15) * 64 + 8 * quad;
    const bf16_t* Kp = (const bf16_t*)(ws + R_KTT) + (ub * 128 + 16 * wave + l15) * 64 + 8 * quad;
    const bf16_t* Vp = (const bf16_t*)(ws + R_VT) + (ub * 256 + 32 * es + l15) * 64 + 8 * quad;
#pragma unroll
    for (int ks = 0; ks < 4; ++ks) f.qf[ks] = *(const bf16x8*)(Qp + 32 * ks);
#pragma unroll
    for (int ks = 0; ks < 2; ++ks) { f.sf[ks] = *(const bf16x8*)(Sp + 32 * ks); f.kf[ks] = *(const bf16x8*)(Kp + 32 * ks);
        f.vf[0][ks] = *(const bf16x8*)(Vp + 32 * ks); f.vf[1][ks] = *(const bf16x8*)(Vp + 16 * 64 + 32 * ks); }
}
DI void ret_chain(const Params& p, int hr, int es, LAS unsigned char* lds, int tid) {
    asm volatile("" : "+v"(tid));
    const int lane = tid & 63, wave = tid >> 6, quad = lane >> 4, l15 = lane & 15, mi = wave >> 1, ei = wave & 1;
    constexpr int RT_BYTES = 8704;
    for (int i = tid; i < 2 * RT_BYTES / 4; i += NTHR) ((LAS unsigned*)lds)[i] = 0u;
    f32x4 Racc[2] = {{0.f, 0.f, 0.f, 0.f}, {0.f, 0.f, 0.f, 0.f}};
    const float cd = exp2f(64.0f * log2f(1.0f - exp2f(-5.0f - (float)hr)));
    float* OB = (float*)(p.ws + WS_OB);
    RFrag cur, nxt;
    ret_load(cur, p.ws, hr, es, 0, wave, quad, l15);
    lds_barrier();
    for (int n = 0; n < 128; ++n) {
        ret_load(nxt, p.ws, hr, es, n + 1 < 128 ? n + 1 : n, wave, quad, l15);
        LAS unsigned char* rc = lds + (n & 1) * RT_BYTES; LAS unsigned char* rn = lds + ((n + 1) & 1) * RT_BYTES;
        f32x4 a = {0.f, 0.f, 0.f, 0.f};
#pragma unroll
        for (int ks = 0; ks < 4; ++ks) { const bf16x8 rf = lds_frag(rc, 16 * ei + l15, 136, 32 * ks + 8 * quad); a = mfma16(cur.qf[ks], rf, a); }
#pragma unroll
        for (int ks = 0; ks < 2; ++ks) a = mfma16(cur.sf[ks], ei ? cur.vf[1][ks] : cur.vf[0][ks], a);
        {   float* op = OB + (size_t)(64 * n + 16 * mi + 4 * quad) * 1024 + hr * 256 + 32 * es + 16 * ei + l15;
#pragma unroll
            for (int j = 0; j < 4; ++j) op[(size_t)j * 1024] = a[j]; }
#pragma unroll
        for (int et = 0; et < 2; ++et) { f32x4 s = Racc[et] * cd;
#pragma unroll
            for (int ks = 0; ks < 2; ++ks) s = mfma16(cur.kf[ks], cur.vf[et][ks], s);
            Racc[et] = s;
            u32x2 w; w.x = pk2(s[0], s[1]); w.y = pk2(s[2], s[3]);
            *(LAS u32x2*)(rn + ((16 * et + l15) * 136 + 16 * wave + 4 * quad) * 2) = w; }
        lds_barrier();
        cur = nxt;
    }
}

DI void conv_unit(const Params& p, int l, int u, LAS unsigned char* lds, int tid) {
    asm volatile("" : "+v"(tid));
    const int tt = u >> 2, cs = u & 3, t0 = 64 * tt;
    const bf16_t* PROJ = (const bf16_t*)(p.ws + WS_PROJ);
    LAS float* Ug = (LAS float*)lds;
    {   const int c8 = tid & 31, rg = tid >> 5;
        for (int rr = rg; rr < 94; rr += 16) { const int t = t0 - 30 + rr; float o[8];
            if (t >= 0) { float a[8], g[8]; unpack8(*(const u32x4*)(PROJ + (size_t)t * PROJ_LD + 7168 + 256 * cs + 8 * c8), a); unpack8(*(const u32x4*)(PROJ + (size_t)t * PROJ_LD + 8192 + 256 * cs + 8 * c8), g);
#pragma unroll
                for (int i = 0; i < 8; ++i) o[i] = a[i] * sigmoidf_(g[i]); }
            else {
#pragma unroll
                for (int i = 0; i < 8; ++i) o[i] = 0.f; }
            *(LAS f32x4*)(Ug + rr * 256 + 8 * c8) = (f32x4){o[0], o[1], o[2], o[3]}; *(LAS f32x4*)(Ug + rr * 256 + 8 * c8 + 4) = (f32x4){o[4], o[5], o[6], o[7]}; }
    }
    lds_barrier();
    {   const int ch = tid & 255, half = tid >> 8, cg_ = 256 * cs + ch;
        float w[31];
#pragma unroll
        for (int j = 0; j < 31; ++j) w[j] = p.conv_dw_w[((size_t)l * 31 + j) * 1024 + cg_];
        const float bias = p.conv_dw_b[l * 1024 + cg_];
        float* CV = (float*)(p.ws + WS_CV);
        for (int tl = 32 * half; tl < 32 * half + 32; ++tl) { float a = bias;
#pragma unroll
            for (int j = 0; j < 31; ++j) a += w[j] * Ug[(tl + j) * 256 + ch];
            CV[(size_t)(t0 + tl) * 1024 + cg_] = a; }
    }
    lds_barrier();
}

DI void phase_post(const Params& p, int l, int tid) {
    const int lane = tid & 63, wave = tid >> 6, gw = blockIdx.x * 8 + wave, NGW = gridDim.x * 8;
    const bf16_t* PROJ = (const bf16_t*)(p.ws + WS_PROJ);
    const float* OA = (const float*)(p.ws + WS_OA); const float* OB = (const float*)(p.ws + WS_OB); const float* CV = (const float*)(p.ws + WS_CV);
    bf16_t* ACTA = (bf16_t*)(p.ws + WS_ACT); bf16_t* ACTB = ACTA + (size_t)T_ * 1024; bf16_t* ACTC = ACTB + (size_t)T_ * 1024;
    for (int t = gw; t < T_; t += NGW) {
#pragma unroll
        for (int hh = 0; hh < 8; ++hh) { const int cc = hh * 128 + 2 * lane;
            const float o0 = OA[(size_t)t * 1024 + cc], o1 = OA[(size_t)t * 1024 + cc + 1];
            const float ss = wave_sum(o0 * o0 + o1 * o1); const float rs = 1.0f / sqrtf(ss * (1.0f / 128.0f) + EPS);
            const unsigned zw = *(const unsigned*)(PROJ + (size_t)t * PROJ_LD + 3072 + cc);
            const float w0 = p.gdn_norm_w[l * 128 + 2 * lane], w1 = p.gdn_norm_w[l * 128 + 2 * lane + 1];
            *(unsigned*)(ACTA + (size_t)t * 1024 + cc) = pk2(o0 * rs * w0 * siluf_(bf_lo(zw)), o1 * rs * w1 * siluf_(bf_hi(zw))); }
#pragma unroll
        for (int hr = 0; hr < 4; ++hr) { const int cc = hr * 256 + 4 * lane;
            const f32x4 o = *(const f32x4*)(OB + (size_t)t * 1024 + cc);
            const float mu = wave_sum((o[0] + o[1]) + (o[2] + o[3])) * (1.0f / 256.0f);
            const f32x4 d = o - mu; const float var = wave_sum((d[0] * d[0] + d[1] * d[1]) + (d[2] * d[2] + d[3] * d[3])) * (1.0f / 256.0f);
            const float rs = 1.0f / sqrtf(var + 1e-5f);
            const u32x2 gwd = *(const u32x2*)(PROJ + (size_t)t * PROJ_LD + 6144 + cc);
            u32x2 w; w.x = pk2(d[0] * rs * siluf_(bf_lo(gwd.x)), d[1] * rs * siluf_(bf_hi(gwd.x))); w.y = pk2(d[2] * rs * siluf_(bf_lo(gwd.y)), d[3] * rs * siluf_(bf_hi(gwd.y)));
            *(u32x2*)(ACTB + (size_t)t * 1024 + cc) = w; }
        {   f32x4 v[4]; float s = 0.f;
#pragma unroll
            for (int j = 0; j < 4; ++j) { v[j] = *(const f32x4*)(CV + (size_t)t * 1024 + (j * 64 + lane) * 4); s += (v[j][0] + v[j][1]) + (v[j][2] + v[j][3]); }
            const float mu = wave_sum(s) * (1.0f / 1024.0f); float q = 0.f;
#pragma unroll
            for (int j = 0; j < 4; ++j) { v[j] = v[j] - mu; q += (v[j][0] * v[j][0] + v[j][1] * v[j][1]) + (v[j][2] * v[j][2] + v[j][3] * v[j][3]); }
            const float rs = 1.0f / sqrtf(wave_sum(q) * (1.0f / 1024.0f) + 1e-5f);
#pragma unroll
            for (int j = 0; j < 4; ++j) { const int cc = (j * 64 + lane) * 4; const f32x4 lw = *(const f32x4*)(p.conv_ln_w + l * 1024 + cc), lb = *(const f32x4*)(p.conv_ln_b + l * 1024 + cc);
                const f32x4 y = v[j] * rs * lw + lb;
                u32x2 w; w.x = pk2(siluf_(y[0]), siluf_(y[1])); w.y = pk2(siluf_(y[2]), siluf_(y[3]));
                *(u32x2*)(ACTC + (size_t)t * 1024 + cc) = w; }
        }
    }
}

template <class Epi> DI void run_gemm(LAS unsigned char* lds, const bf16_t* A, const bf16_t* Bt, int N, int K, const Epi& E) {
    Gemm g{A, Bt, T_, N, K}; StaticOrder S; S.init(T_, N, (int)gridDim.x, (int)blockIdx.x);
    gemm_phase<Epi, StaticOrder, false>(lds, g, S, E, nullptr);
}

DI void run_phase(const Params& p, int ph, LAS unsigned char* lds, int tid) {
    const int G = gridDim.x, b = blockIdx.x;
#ifndef SUBM
#define SUBM 3
#endif
#ifndef PHM
#define PHM 0xFFF
#endif
    if (ph == 0) { if (PHM & 0x400) phase_prep(p, lds, tid); return; }
    if (ph == 21) { if (PHM & 0x800) phase_norm((const float*)(p.ws + WS_XC), p.final_w, nullptr, nullptr, nullptr, p.out, tid); return; }
    const int l = (ph - 1) / 10, sp = (ph - 1) % 10;
    const float* mod = (const float*)(p.ws + WS_MOD) + l * 12288;
    const float* xin = (l == 0) ? p.x : (const float*)(p.ws + WS_XC);
    float* XC = (float*)(p.ws + WS_XC);
    bf16_t* H = (bf16_t*)(p.ws + WS_H);
    bf16_t* PROJ = (bf16_t*)(p.ws + WS_PROJ);
    const unsigned char* wl = p.ws + WS_W + (size_t)l * SZ_WL;
    const bf16_t* WT_IN = (const bf16_t*)wl; const bf16_t* WT_BR = (const bf16_t*)(wl + SZ_WT_IN); const bf16_t* WT_O = (const bf16_t*)(wl + SZ_WT_IN + 3 * SZ_WT_BR);
    const bf16_t* WT_MI = (const bf16_t*)(wl + SZ_WT_IN + 3 * SZ_WT_BR + SZ_WT_O); const bf16_t* WT_MO = (const bf16_t*)(wl + SZ_WT_IN + 3 * SZ_WT_BR + SZ_WT_O + SZ_WT_M);
    switch (sp) {
    case 0: if (PHM & (1<<0)) phase_norm(xin, p.norm_mix_w + l * D_, mod + 2048, mod, H, nullptr, tid); break;
    case 1: if (PHM & (1<<1)) { EpiProj E{PROJ, (float*)(p.ws + WS_BA)}; run_gemm(lds, H, WT_IN, NP1, 2048, E); } break;
    case 2: if (PHM & (1<<2)) for (int u = b; u < 1536; u += G) { if (u < 1024) { if (SUBM & 1) gdn_prep_unit(p, l, u >> 7, u & 127, lds, tid); } else { if (SUBM & 2) ret_prep_unit(p, (u - 1024) >> 7, (u - 1024) & 127, lds, tid); } } break;
    case 3: if (PHM & (1<<3)) {
        for (int ch = b; ch < 64; ch += G) { if (ch < 32) gdn_chain(p, ch >> 2, ch & 3, lds, tid); else ret_chain(p, (ch - 32) >> 3, (ch - 32) & 7, lds, tid); lds_barrier(); }
        if (G > 64) { if (b >= 64) for (int u = b - 64; u < 512; u += G - 64) conv_unit(p, l, u, lds, tid); }
        else for (int u = b; u < 512; u += G) conv_unit(p, l, u, lds, tid);
    } break;
    case 4: if (PHM & (1<<4)) phase_post(p, l, tid); break;
    case 5: if (PHM & (1<<5)) { const bf16_t* ACT = (const bf16_t*)(p.ws + WS_ACT); float* MF = (float*)(p.ws + WS_MF); bf16_t* MB = (bf16_t*)(p.ws + WS_MB);
        { EpiBranch<0> E{PROJ, MF, MB}; run_gemm(lds, ACT, WT_BR, 2048, 1024, E); }
        { EpiBranch<1> E{PROJ, MF, MB}; run_gemm(lds, ACT + (size_t)T_ * 1024, WT_BR + (size_t)2048 * 1024, 2048, 1024, E); }
        { EpiBranch<2> E{PROJ, MF, MB}; run_gemm(lds, ACT + 2 * (size_t)T_ * 1024, WT_BR + 2 * (size_t)2048 * 1024, 2048, 1024, E); }
    } break;
    case 6: if (PHM & (1<<6)) { EpiResid E{xin, XC, mod + 4096}; run_gemm(lds, (const bf16_t*)(p.ws + WS_MB), WT_O, 2048, 2048, E); } break;
    case 7: if (PHM & (1<<7)) phase_norm(XC, p.norm_mlp_w + l * D_, mod + 8192, mod + 6144, H, nullptr, tid); break;
    case 8: if (PHM & (1<<8)) { EpiRelu2 E{PROJ}; run_gemm(lds, H, WT_MI, 8192, 2048, E); } break;
    case 9: if (PHM & (1<<9)) { EpiResid E{XC, XC, mod + 10240}; run_gemm(lds, PROJ, WT_MO, 2048, 8192, E); } break;
    }
}

constexpr int NPHASE = 22;
__global__ void __launch_bounds__(NTHR, 2) mega_kernel(Params p) {
    extern __shared__ __attribute__((aligned(16))) unsigned char smem[];
    LAS unsigned char* lds = (LAS unsigned char*)smem;
    const int tid = threadIdx.x;
    for (int ph = p.ph_lo; ph < p.ph_hi; ++ph) {
        if (ph > p.ph_lo) { __threadfence(); cg::this_grid().sync(); }
        int t2 = tid; asm volatile("" : "+v"(t2));
        run_phase(p, ph, lds, t2);
    }
}

#ifndef ONE_LAUNCH
#define ONE_LAUNCH 0
#endif
extern "C" void kernel_launch(void* const* d_in, const int* in_sizes, int n_in, void* d_out, int out_size, void* d_ws, size_t ws_size, hipStream_t stream) {
    static int grid = 0;
    if (grid == 0) {
        if (n_in != 23 || ws_size < WS_END) { fprintf(stderr, "kernel_launch: bad inputs (n_in %d ws %zu need %zu)\n", n_in, ws_size, (size_t)WS_END); grid = -1; return; }
        int dev = 0, cus = 0, per_cu = 0;
        hipGetDevice(&dev); hipDeviceGetAttribute(&cus, hipDeviceAttributeMultiprocessorCount, dev);
        if (hipFuncSetAttribute((const void*)mega_kernel, hipFuncAttributeMaxDynamicSharedMemorySize, LDS_BYTES) != hipSuccess) { fprintf(stderr, "hipFuncSetAttribute failed\n"); grid = -1; return; }
        if (hipOccupancyMaxActiveBlocksPerMultiprocessor(&per_cu, (const void*)mega_kernel, NTHR, LDS_BYTES) != hipSuccess || per_cu < 1) per_cu = 1;
        (void)hipGetLastError();
        grid = cus * 1;
    }
    if (grid < 0) return;
    Params p{};
    p.x = (const float*)d_in[0]; p.c = (const float*)d_in[1]; p.pos = (const int*)d_in[2]; p.w_ada = (const float*)d_in[3]; p.b_ada = (const float*)d_in[4];
    p.norm_mix_w = (const float*)d_in[5]; p.norm_mlp_w = (const float*)d_in[6]; p.w_in = (const float*)d_in[7]; p.conv_qkv_w = (const float*)d_in[8];
    p.a_log = (const float*)d_in[9]; p.dt_bias = (const float*)d_in[10]; p.gdn_norm_w = (const float*)d_in[11]; p.conv_dw_w = (const float*)d_in[12]; p.conv_dw_b = (const float*)d_in[13];
    p.conv_ln_w = (const float*)d_in[14]; p.conv_ln_b = (const float*)d_in[15]; p.w_a = (const float*)d_in[16]; p.w_b = (const float*)d_in[17]; p.w_c = (const float*)d_in[18];
    p.w_out = (const float*)d_in[19]; p.w_mi = (const float*)d_in[20]; p.w_mo = (const float*)d_in[21]; p.final_w = (const float*)d_in[22];
    p.out = (float*)d_out; p.ws = (unsigned char*)d_ws;
#if ONE_LAUNCH
    p.ph_lo = 0; p.ph_hi = NPHASE;
    void* args[] = {&p};
    hipError_t e = hipLaunchCooperativeKernel((const void*)mega_kernel, dim3(grid), dim3(NTHR), args, LDS_BYTES, stream);
    if (e != hipSuccess) fprintf(stderr, "cooperative launch failed: %s (grid %d)\n", hipGetErrorString(e), grid);
#else
    for (int ph = 0; ph < NPHASE; ++ph) { p.ph_lo = ph; p.ph_hi = ph + 1;
        hipLaunchKernelGGL(mega_kernel, dim3(grid), dim3(NTHR), LDS_BYTES, stream, p); }
#endif
}
```

```cpp
#include <hip/hip_runtime.h>
#include <hip/hip_cooperative_groups.h>
#include <cstdio>
namespace pg8 {
#define PG8_LAS __attribute__((address_space(3)))
typedef unsigned short bf16_t;
typedef short bf16x8 __attribute__((ext_vector_type(8)));
typedef float f32x4 __attribute__((ext_vector_type(4)));
typedef unsigned u32x4 __attribute__((ext_vector_type(4)));
constexpr int BM = 256, BK = 64, HALF = 128, HTB = HALF * BK * 2  , STAGE_BYTES = 8 * HTB, NXCD = 8, WGM = 8;

__host__ __device__ __forceinline__ int lds_byte(int r, int c) { const int st = (r >> 4) * 2 + (c >> 5), rr = r & 15, cc = c & 31, ob = rr * 64 + cc * 2; return st * 1024 + (ob ^ (((ob >> 9) & 1) << 5)); }
__host__ __device__ __forceinline__ void stage_rc(int b, int& R, int& C) { const int st = b / 1024, sb = b % 1024, swz = sb ^ (((sb >> 9) & 1) << 5); R = (st >> 1) * 16 + swz / 64; C = (st & 1) * 32 + (swz % 64) / 2; }
__host__ __device__ __forceinline__ int perm32(int rho) { const int n = rho >> 4, i = rho & 15; return 8 * (i >> 2) + 4 * n + (i & 3); }

struct Unit { int pm, pn; };
struct Gemm { const bf16_t* A; const bf16_t* Bt; int M, N, K; };

struct StaticOrder {
    int nM, nN, nwg, G, c;
    __host__ __device__ void init(int M, int N, int G_, int c_) { nM = M / BM; nN = N / BM; nwg = nM * nN; G = G_; c = c_; }
    __host__ __device__ bool next(int i, Unit& u) const {
        const long L = (long)i * G + c; if (L >= nwg) return false;
        int wgid = (int)L; { const int q = nwg / NXCD, r = nwg % NXCD, xcd = wgid % NXCD, off = wgid / NXCD; wgid = (xcd < r ? xcd * (q + 1) : r * (q + 1) + (xcd - r) * q) + off; }
        const int nig = WGM * nN, gid = wgid / nig, fm = gid * WGM, gsz = (nM - fm) < WGM ? (nM - fm) : WGM;
        u.pm = fm + ((wgid % nig) % gsz); u.pn = (wgid % nig) / gsz; return true;
    }
    __device__ __forceinline__ void a_ready(const Unit&) const {}
    __device__ __forceinline__ void done(const Unit&) const {}
};
typedef float f32x2c_ __attribute__((ext_vector_type(2)));
typedef __bf16 bf16x2c_ __attribute__((ext_vector_type(2)));
__device__ __forceinline__ unsigned cvt_pk_bf16(float lo, float hi) { const f32x2c_ v = {lo, hi}; const bf16x2c_ b = __builtin_convertvector(v, bf16x2c_); return __builtin_bit_cast(unsigned, b); }
typedef unsigned u32x2 __attribute__((ext_vector_type(2)));
__device__ __forceinline__ float bf_lo(unsigned w) { return __uint_as_float(w << 16); }
__device__ __forceinline__ float bf_hi(unsigned w) { return __uint_as_float(w & 0xffff0000u); }
__device__ __forceinline__ float sigmoidf_(float x) { return 1.0f / (1.0f + __expf(-x)); }

constexpr int PROJ_LD = 15360;

struct EpiProj {
    static constexpr bool PERM = true, AFTER_DRAIN = false;
    bf16_t* O; float* BA;
    __device__ __forceinline__ void operator()(const f32x4 (&acc)[2][2][4][2], const Unit& u, int wr, int wc, int fr, int fq) const {
        const int row0 = u.pm * BM + wr * 64 + fr;
        if (u.pn < 60) {
            const int col0 = u.pn * BM + wc * 32 + 8 * fq;
#pragma unroll
            for (int ai = 0; ai < 2; ++ai)
#pragma unroll
                for (int m = 0; m < 4; ++m) { bf16_t* rowp = O + (size_t)(row0 + ai * HALF + m * 16) * PROJ_LD + col0;
#pragma unroll
                    for (int bj = 0; bj < 2; ++bj) { const f32x4 v0 = acc[ai][bj][m][0], v1 = acc[ai][bj][m][1];
                        u32x4 w; w.x = cvt_pk_bf16(v0[0], v0[1]); w.y = cvt_pk_bf16(v0[2], v0[3]); w.z = cvt_pk_bf16(v1[0], v1[1]); w.w = cvt_pk_bf16(v1[2], v1[3]);
                        *(u32x4*)(rowp + bj * HALF) = w; } }
        } else {
            if (wc == 0 && fq < 2) {
#pragma unroll
                for (int ai = 0; ai < 2; ++ai)
#pragma unroll
                    for (int m = 0; m < 4; ++m) { float* rowp = BA + (size_t)(row0 + ai * HALF + m * 16) * 16 + 8 * fq;
#pragma unroll
                        for (int n = 0; n < 2; ++n) *(f32x4*)(rowp + 4 * n) = acc[ai][0][m][n]; }
            }
        }
    }
};
template <int PASS> struct EpiBranch {
    static constexpr bool PERM = false, AFTER_DRAIN = false;
    const bf16_t* PROJ; float* MF; bf16_t* MB;
    __device__ __forceinline__ void operator()(const f32x4 (&acc)[2][2][4][2], const Unit& u, int wr, int wc, int fr, int fq) const {
        const int row0 = u.pm * BM + wr * 64 + fr, col0 = u.pn * BM + wc * 32 + 4 * fq;
#pragma unroll
        for (int ai = 0; ai < 2; ++ai)
#pragma unroll
            for (int mp = 0; mp < 2; ++mp) {
                u32x2 gw[2][2][2]; f32x4 mv[2][2][2];
#pragma unroll
                for (int mm = 0; mm < 2; ++mm) { const size_t row = (size_t)(row0 + ai * HALF + (2 * mp + mm) * 16);
#pragma unroll
                    for (int bj = 0; bj < 2; ++bj)
#pragma unroll
                        for (int n = 0; n < 2; ++n) { const int col = col0 + bj * HALF + n * 16;
                            gw[mm][bj][n] = *(const u32x2*)(PROJ + row * PROJ_LD + 9216 + PASS * 2048 + col);
                            if (PASS > 0) mv[mm][bj][n] = *(const f32x4*)(MF + row * 2048 + col); } }
#pragma unroll
                for (int mm = 0; mm < 2; ++mm) { const int m = 2 * mp + mm; const size_t row = (size_t)(row0 + ai * HALF + m * 16);
#pragma unroll
                    for (int bj = 0; bj < 2; ++bj)
#pragma unroll
                        for (int n = 0; n < 2; ++n) { const int col = col0 + bj * HALF + n * 16; const u32x2 g2 = gw[mm][bj][n];
                            f32x4 g; g[0] = sigmoidf_(bf_lo(g2.x)); g[1] = sigmoidf_(bf_hi(g2.x)); g[2] = sigmoidf_(bf_lo(g2.y)); g[3] = sigmoidf_(bf_hi(g2.y));
                            f32x4 v = g * acc[ai][bj][m][n];
                            if (PASS > 0) v += mv[mm][bj][n];
                            if (PASS < 2) *(f32x4*)(MF + row * 2048 + col) = v;
                            else { u32x2 w; w.x = cvt_pk_bf16(v[0], v[1]); w.y = cvt_pk_bf16(v[2], v[3]); *(u32x2*)(MB + row * 2048 + col) = w; } } }
                asm volatile("" ::: "memory"); }
    }
};
struct EpiResid {
    static constexpr bool PERM = false, AFTER_DRAIN = false;
    const float* xin; float* xout; const float* gate;
    __device__ __forceinline__ void operator()(const f32x4 (&acc)[2][2][4][2], const Unit& u, int wr, int wc, int fr, int fq) const {
        const int row0 = u.pm * BM + wr * 64 + fr, col0 = u.pn * BM + wc * 32 + 4 * fq;
        f32x4 gv[2][2];
#pragma unroll
        for (int bj = 0; bj < 2; ++bj)
#pragma unroll
            for (int n = 0; n < 2; ++n) gv[bj][n] = *(const f32x4*)(gate + col0 + bj * HALF + n * 16);
#pragma unroll
        for (int ai = 0; ai < 2; ++ai)
#pragma unroll
            for (int mp = 0; mp < 2; ++mp) { f32x4 bv[2][2][2];
#pragma unroll
                for (int mm = 0; mm < 2; ++mm) { const size_t off = (size_t)(row0 + ai * HALF + (2 * mp + mm) * 16) * 2048 + col0;
#pragma unroll
                    for (int bj = 0; bj < 2; ++bj)
#pragma unroll
                        for (int n = 0; n < 2; ++n) bv[mm][bj][n] = *(const f32x4*)(xin + off + bj * HALF + n * 16); }
#pragma unroll
                for (int mm = 0; mm < 2; ++mm) { const int m = 2 * mp + mm; const size_t off = (size_t)(row0 + ai * HALF + m * 16) * 2048 + col0;
#pragma unroll
                    for (int bj = 0; bj < 2; ++bj)
#pragma unroll
                        for (int n = 0; n < 2; ++n) *(f32x4*)(xout + off + bj * HALF + n * 16) = bv[mm][bj][n] + gv[bj][n] * acc[ai][bj][m][n]; }
                asm volatile("" ::: "memory"); }
    }
};
struct EpiRelu2 {
    static constexpr bool PERM = true, AFTER_DRAIN = false;
    bf16_t* O;
    __device__ __forceinline__ void operator()(const f32x4 (&acc)[2][2][4][2], const Unit& u, int wr, int wc, int fr, int fq) const {
        const int row0 = u.pm * BM + wr * 64 + fr, col0 = u.pn * BM + wc * 32 + 8 * fq;
#pragma unroll
        for (int ai = 0; ai < 2; ++ai)
#pragma unroll
            for (int m = 0; m < 4; ++m) { bf16_t* rowp = O + (size_t)(row0 + ai * HALF + m * 16) * 8192 + col0;
#pragma unroll
                for (int bj = 0; bj < 2; ++bj) { f32x4 v0 = acc[ai][bj][m][0], v1 = acc[ai][bj][m][1];
#pragma unroll
                    for (int j = 0; j < 4; ++j) { const float a = fmaxf(v0[j], 0.f), b = fmaxf(v1[j], 0.f); v0[j] = a * a; v1[j] = b * b; }
                    u32x4 w; w.x = cvt_pk_bf16(v0[0], v0[1]); w.y = cvt_pk_bf16(v0[2], v0[3]); w.z = cvt_pk_bf16(v1[0], v1[1]); w.w = cvt_pk_bf16(v1[2], v1[3]);
                    *(u32x4*)(rowp + bj * HALF) = w; } }
    }
};

template <class Epi, class Sched, bool STAMP = false>
__device__ __forceinline__ void gemm_phase(PG8_LAS unsigned char* lds, const Gemm g, const Sched& S, const Epi& E, unsigned long long* stamps) {
    int tid = threadIdx.x; asm volatile("" : "+v"(tid));
    const int wid = __builtin_amdgcn_readfirstlane(tid >> 6), lane = tid & 63, wr = wid >> 2, wc = wid & 3, fr = lane & 15, fq = lane >> 4;
    const int K = g.K, nt = K / BK;
    int ts_lo = 0, ts_hi = 0, nts = 0; const unsigned long long rt_entry = STAMP ? (unsigned long long)wall_clock64() : 0ull;
#define PG8_STAMP() do { if (STAMP && wid == 0 && nts < 64) { const unsigned long long _c = (unsigned long long)clock64(); \
        ts_lo = (lane == nts) ? (int)(unsigned)_c : ts_lo; ts_hi = (lane == nts) ? (int)(unsigned)(_c >> 32) : ts_hi; ++nts; } } while (0)
    PG8_STAMP();
    unsigned voffA[2], voffB[2];
#pragma unroll
    for (int i = 0; i < 2; ++i) { int R, C; stage_rc(tid * 16 + i * 8192, R, C); const int Rb = Epi::PERM ? ((R & ~31) + perm32(R & 31)) : R;
        voffA[i] = (unsigned)(R * K + C) * 2u; voffB[i] = (unsigned)(Rb * K + C) * 2u; }
    const size_t kstep = (size_t)(BK * 2);
    const size_t hstep = (size_t)HALF * K * 2;
    const size_t tstep = 2 * hstep;
    const unsigned ldsw = (unsigned)wid * 1024u;
    const int aoff = lds_byte(wr * 64 + fr, fq * 8), boff = lds_byte(wc * 32 + fr, fq * 8);
#define PG8_SA(b, h) (((b) * 2 + (h)) * HTB)
#define PG8_SB(b, h) ((4 + (b) * 2 + (h)) * HTB)
#define PG8_STAGE(bufoff, gbase, voff) do { _Pragma("unroll") for (int _i = 0; _i < 2; ++_i) \
        __builtin_amdgcn_global_load_lds((const unsigned*)((const char*)(gbase) + (voff)[_i]), (PG8_LAS unsigned*)(lds + (bufoff) + ldsw + _i * 8192), 16, 0, 0); } while (0)
#define PG8_LDA(dst, b, h) do { _Pragma("unroll") for (int m = 0; m < 4; ++m) _Pragma("unroll") for (int k = 0; k < 2; ++k) dst[m][k] = *(const PG8_LAS bf16x8*)(lds + PG8_SA(b, h) + aoff + m * 2048 + k * 1024); } while (0)
#define PG8_LDB(dst, b, h) do { _Pragma("unroll") for (int n = 0; n < 2; ++n) _Pragma("unroll") for (int k = 0; k < 2; ++k) dst[n][k] = *(const PG8_LAS bf16x8*)(lds + PG8_SB(b, h) + boff + n * 2048 + k * 1024); } while (0)
#define PG8_MMA(ai, bj, At, Bt) do { __builtin_amdgcn_s_setprio(1); _Pragma("unroll") for (int m = 0; m < 4; ++m) _Pragma("unroll") for (int n = 0; n < 2; ++n) _Pragma("unroll") for (int k = 0; k < 2; ++k) \
        acc[ai][bj][m][n] = __builtin_amdgcn_mfma_f32_16x16x32_bf16(Bt[n][k], At[m][k], acc[ai][bj][m][n], 0, 0, 0); __builtin_amdgcn_s_setprio(0); } while (0)
#define PG8_WAIT_V(n) asm volatile("s_waitcnt vmcnt(" #n ")" ::: "memory")
#define PG8_WAIT_L(n) asm volatile("s_waitcnt lgkmcnt(" #n ")" ::: "memory")
#define PG8_BAR __builtin_amdgcn_s_barrier()
#define PG8_SCHED __builtin_amdgcn_sched_barrier(0)
    Unit cur, nxt; int ui = 0;
    if (!S.next(0, cur)) return;
    f32x4 acc[2][2][4][2];
#pragma unroll
    for (int a = 0; a < 2; ++a)
#pragma unroll
        for (int b = 0; b < 2; ++b)
#pragma unroll
            for (int m = 0; m < 4; ++m)
#pragma unroll
                for (int n = 0; n < 2; ++n) acc[a][b][m][n] = (f32x4){0.f, 0.f, 0.f, 0.f};
    bf16x8 At[4][2], B0[2][2], B1[2][2];
    const char* cA = (const char*)g.A + (size_t)cur.pm * tstep; const char* cB = (const char*)g.Bt + (size_t)cur.pn * tstep;
    S.a_ready(cur);
    PG8_STAGE(PG8_SB(0, 0), cB, voffB); PG8_STAGE(PG8_SA(0, 0), cA, voffA); PG8_STAGE(PG8_SB(0, 1), cB + hstep, voffB); PG8_STAGE(PG8_SA(0, 1), cA + hstep, voffA);
    if (wr == 1) PG8_BAR;
    PG8_WAIT_V(4); PG8_BAR;
    PG8_STAGE(PG8_SB(1, 0), cB + kstep, voffB); PG8_STAGE(PG8_SA(1, 0), cA + kstep, voffA); PG8_STAGE(PG8_SB(1, 1), cB + hstep + kstep, voffB);
    PG8_WAIT_V(6); PG8_BAR;
    PG8_STAMP();
    for (;;) {
        const bool has_next = S.next(ui + 1, nxt);
        const char* nA = has_next ? (const char*)g.A + (size_t)nxt.pm * tstep : cA; const char* nB = has_next ? (const char*)g.Bt + (size_t)nxt.pn * tstep : cB;
        for (int t = 0; t < nt; t += 2) {
            const bool last = (t == nt - 2);
            const char* a1 = cA + (size_t)(t + 1) * kstep;
            const char* a2 = last ? nA : cA + (size_t)(t + 2) * kstep; const char* b2 = last ? nB : cB + (size_t)(t + 2) * kstep;
            const char* a3 = a2 + kstep; const char* b3 = b2 + kstep;
            if (last && has_next) S.a_ready(nxt);
            PG8_LDB(B0, 0, 0); PG8_SCHED; PG8_LDA(At, 0, 0); PG8_STAGE(PG8_SA(1, 1), a1 + hstep, voffA);
            PG8_WAIT_L(8); PG8_BAR; PG8_WAIT_L(0); PG8_MMA(0, 0, At, B0); PG8_BAR; PG8_SCHED;
            PG8_LDB(B1, 0, 1); PG8_STAGE(PG8_SB(0, 0), b2, voffB);
            PG8_BAR; PG8_WAIT_L(0); PG8_MMA(0, 1, At, B1); PG8_BAR;
            PG8_LDA(At, 0, 1); PG8_STAGE(PG8_SA(0, 0), a2, voffA);
            PG8_BAR; PG8_WAIT_L(0); PG8_MMA(1, 0, At, B0); PG8_BAR; PG8_SCHED;
            PG8_STAGE(PG8_SB(0, 1), b2 + hstep, voffB);
            PG8_WAIT_V(6); PG8_BAR; PG8_MMA(1, 1, At, B1); PG8_BAR;
            PG8_LDB(B0, 1, 0); PG8_SCHED; PG8_LDA(At, 1, 0); PG8_STAGE(PG8_SA(0, 1), a2 + hstep, voffA);
            PG8_WAIT_L(8); PG8_BAR; PG8_WAIT_L(0); PG8_MMA(0, 0, At, B0); PG8_BAR; PG8_SCHED;
            PG8_LDB(B1, 1, 1); PG8_STAGE(PG8_SB(1, 0), b3, voffB);
            PG8_BAR; PG8_WAIT_L(0); PG8_MMA(0, 1, At, B1); PG8_BAR;
            PG8_LDA(At, 1, 1); PG8_STAGE(PG8_SA(1, 0), a3, voffA);
            PG8_BAR; PG8_WAIT_L(0); PG8_MMA(1, 0, At, B0); PG8_BAR; PG8_SCHED;
            PG8_STAGE(PG8_SB(1, 1), b3 + hstep, voffB);
            PG8_WAIT_V(6); PG8_BAR; PG8_MMA(1, 1, At, B1); PG8_BAR;
        }
        PG8_STAMP();
        if constexpr (!Epi::AFTER_DRAIN) { E(acc, cur, wr, wc, fr, fq); S.done(cur); }
        PG8_STAMP();
        if (!has_next) break;
#pragma unroll
        for (int a = 0; a < 2; ++a)
#pragma unroll
            for (int b = 0; b < 2; ++b)
#pragma unroll
                for (int m = 0; m < 4; ++m)
#pragma unroll
                    for (int n = 0; n < 2; ++n) acc[a][b][m][n] = (f32x4){0.f, 0.f, 0.f, 0.f};
        cur = nxt; cA = nA; cB = nB; ++ui;
    }
    PG8_WAIT_V(0);
    if (wr == 0) PG8_BAR;
    PG8_BAR;
    if constexpr (Epi::AFTER_DRAIN) { E.fused(acc, cur, wr, wc, fr, fq, lds, wid, lane); S.done(cur); }
    PG8_STAMP();
    if (STAMP && wid == 0) { stamps[lane] = lane < nts ? (((unsigned long long)(unsigned)ts_hi << 32) | (unsigned)ts_lo) : 0ull;
        if (lane == 62) stamps[62] = rt_entry; if (lane == 63) stamps[63] = (unsigned long long)wall_clock64(); }
#undef PG8_STAMP
#undef PG8_SA
#undef PG8_SB
#undef PG8_STAGE
#undef PG8_LDA
#undef PG8_LDB
#undef PG8_MMA
#undef PG8_WAIT_V
#undef PG8_WAIT_L
#undef PG8_BAR
#undef PG8_SCHED
}
}
using namespace pg8;
namespace cg = cooperative_groups;
#define LAS PG8_LAS
#define DI __device__ __forceinline__

constexpr int T_ = 8192, D_ = 2048, INW = 15376, NP1 = 15616, DFF = 8192;
constexpr int LDS_BYTES = 147456;
constexpr int NTHR = 512;
constexpr float EPS = 1e-6f;

constexpr size_t SZ_WT_IN = (size_t)NP1 * 2048 * 2, SZ_WT_BR = (size_t)2048 * 1024 * 2, SZ_WT_O = (size_t)2048 * 2048 * 2, SZ_WT_M = (size_t)8192 * 2048 * 2;
constexpr size_t SZ_WL = SZ_WT_IN + 3 * SZ_WT_BR + SZ_WT_O + 2 * SZ_WT_M;
constexpr size_t WS_W = 0;
constexpr size_t WS_MOD = WS_W + 2 * SZ_WL;
constexpr size_t WS_XC = WS_MOD + 2 * 12288 * 4;
constexpr size_t WS_H = WS_XC + (size_t)T_ * D_ * 4;
constexpr size_t WS_PROJ = WS_H + (size_t)T_ * D_ * 2;
constexpr size_t WS_BA = WS_PROJ + (size_t)T_ * 15360 * 2;
constexpr size_t WS_R2 = WS_BA + (size_t)T_ * 16 * 4;
constexpr size_t G_A = WS_R2;
constexpr size_t G_BT = G_A + (size_t)T_ * 2048 * 2;
constexpr size_t G_C = G_BT + (size_t)T_ * 2048 * 2;
constexpr size_t G_D = G_C + (size_t)T_ * 1024 * 2;
constexpr size_t G_GL = G_D + (size_t)T_ * 1024 * 2;
constexpr size_t R_SC = G_GL + 4096;
constexpr size_t R_QI = R_SC + (size_t)T_ * 256 * 2;
constexpr size_t R_VT = R_QI + (size_t)T_ * 512 * 2;
constexpr size_t WS_R3 = R_VT + (size_t)T_ * 1024 * 2;
constexpr size_t WS_OA = WS_R3;
constexpr size_t WS_OB = WS_OA + (size_t)T_ * 1024 * 4;
constexpr size_t WS_CV = WS_OB + (size_t)T_ * 1024 * 4;
constexpr size_t WS_ACT = WS_CV + (size_t)T_ * 1024 * 4;
constexpr size_t WS_MB = WS_ACT + 3 * (size_t)T_ * 1024 * 2;
constexpr size_t WS_BAR = WS_MB + (size_t)T_ * D_ * 2;
constexpr size_t WS_PROG = WS_BAR + 16384;
constexpr size_t WS_END = WS_PROG + 16384;
constexpr size_t R_P = WS_OA;
constexpr size_t G_S = WS_H;
constexpr size_t R_RT = WS_MB;
constexpr size_t WS_MF = WS_R2;
static_assert(WS_MF + (size_t)T_ * D_ * 4 <= WS_R3, "merged f32 alias");

struct Params {
    const float* x; const float* c; const int* pos; const float* w_ada; const float* b_ada; const float* norm_mix_w; const float* norm_mlp_w; const float* w_in;
    const float* conv_qkv_w; const float* a_log; const float* dt_bias; const float* gdn_norm_w; const float* conv_dw_w; const float* conv_dw_b; const float* conv_ln_w; const float* conv_ln_b;
    const float* w_a; const float* w_b; const float* w_c; const float* w_out; const float* w_mi; const float* w_mo; const float* final_w;
    float* out; unsigned char* ws; int ph_lo, ph_hi;
};

DI unsigned pk2(float lo, float hi) { return cvt_pk_bf16(lo, hi); }
DI bf16_t f2bf(float f) { return (bf16_t)(cvt_pk_bf16(f, 0.f) & 0xffffu); }
DI float siluf_(float x) { return x / (1.0f + __expf(-x)); }
DI float ret_lg2(int hr) { return hr == 0 ? -0.04580368961312479f : hr == 1 ? -0.02272007650008353f : hr == 2 ? -0.011315313227834146f : -0.005646563141142063f; }
DI float wave_sum(float v) {
#pragma unroll
    for (int o = 1; o < 64; o <<= 1) v += __shfl_xor(v, o);
    return v;
}
DI void lds_barrier() { asm volatile("s_waitcnt lgkmcnt(0)" ::: "memory"); __builtin_amdgcn_s_barrier(); asm volatile("" ::: "memory"); }
DI void full_barrier() { asm volatile("s_waitcnt vmcnt(0) lgkmcnt(0)" ::: "memory"); __builtin_amdgcn_s_barrier(); asm volatile("" ::: "memory"); }
DI f32x4 mfma16(bf16x8 a, bf16x8 b, f32x4 c) { return __builtin_amdgcn_mfma_f32_16x16x32_bf16(a, b, c, 0, 0, 0); }
DI bf16x8 lds_frag(LAS unsigned char* base, int row, int stride_el, int k0) { return *(const LAS bf16x8*)(base + ((size_t)row * stride_el + k0) * 2); }
DI void unpack8(const u32x4 w, float (&f)[8]) { f[0] = bf_lo(w.x); f[1] = bf_hi(w.x); f[2] = bf_lo(w.y); f[3] = bf_hi(w.y); f[4] = bf_lo(w.z); f[5] = bf_hi(w.z); f[6] = bf_lo(w.w); f[7] = bf_hi(w.w); }
DI u32x4 pack8(const float* f) { u32x4 w; w.x = pk2(f[0], f[1]); w.y = pk2(f[2], f[3]); w.z = pk2(f[4], f[5]); w.w = pk2(f[6], f[7]); return w; }

#define XB_TMO      128
#define XB_XCNT(j)  (256  + 64 * (j))
#define XB_XSUB(j)  (1280 + 64 * (j))
#define XB_XGEN(j)  (2304 + 64 * (j))
#define XB_TOP      3328
#define XB_TOPGEN   3392
#define XCD_BAR_WORDS 3456
#define XB_SPIN_CAP (1u << 18)


__device__ __forceinline__ unsigned xb_ld(unsigned* p)              { return __hip_atomic_load(p, __ATOMIC_RELAXED, __HIP_MEMORY_SCOPE_AGENT); }
__device__ __forceinline__ unsigned xb_add(unsigned* p, unsigned v) { return __hip_atomic_fetch_add(p, v, __ATOMIC_RELAXED, __HIP_MEMORY_SCOPE_AGENT); }
__device__ __forceinline__ unsigned xb_xcc_id() { return (unsigned)__builtin_amdgcn_s_getreg((3 << 11) | 20) & 0xFu; }
#define XB_SPIN(cond, bar) do { unsigned _sp = 0; while (cond) { __builtin_amdgcn_s_sleep(1); \
    if ((++_sp & 255u) == 0u) { if (xb_ld(&(bar)[XB_TMO])) break; if (_sp > XB_SPIN_CAP) { atomicAdd(&(bar)[XB_TMO], 1u); break; } } } } while (0)

struct XcdBarrier {
    unsigned* bar; unsigned x;
    volatile LAS unsigned* st;
};

__device__ __forceinline__ XcdBarrier xcd_barrier_post(unsigned* bar, volatile LAS unsigned* st) {
    XcdBarrier b; b.bar = bar; b.x = xb_xcc_id(); b.st = st;
    if (threadIdx.x == 0) (void)xb_add(&bar[XB_XCNT(b.x)], 1u);
    return b;
}
__device__ __forceinline__ void xcd_barrier_complete(unsigned* bar, unsigned x, unsigned& nloc, unsigned& nx) {
    const unsigned G = gridDim.x * gridDim.y * gridDim.z;
    unsigned sum, cnt, mine, sp = 0u;
    for (;;) {
        sum = 0u; cnt = 0u; mine = 0u;
#pragma unroll
        for (unsigned j = 0; j < 16; ++j) { const unsigned c = xb_ld(&bar[XB_XCNT(j)]); sum += c; cnt += (c > 0u) ? 1u : 0u; mine = (j == x) ? c : mine; }
        if (sum == G) break;
        __builtin_amdgcn_s_sleep(1);
        if ((++sp & 255u) == 0u) { if (xb_ld(&bar[XB_TMO])) break; if (sp > XB_SPIN_CAP) { atomicAdd(&bar[XB_TMO], 1u); break; } }
    }
    nloc = mine > 0u ? mine : 1u; nx = cnt > 0u ? cnt : 1u;
}

__device__ __forceinline__ void xcd_barrier(const XcdBarrier& b) {
    asm volatile("s_waitcnt vmcnt(0)" ::: "memory");
    __syncthreads();
    if (threadIdx.x == 0) {
        unsigned* bar = b.bar;
        __builtin_amdgcn_s_waitcnt(0);
        unsigned nloc = b.st[0], nx = b.st[1];
        if (nloc == 0u) { xcd_barrier_complete(bar, b.x, nloc, nx); b.st[0] = nloc; b.st[1] = nx; }
        const unsigned old = xb_add(&bar[XB_XSUB(b.x)], 1u);
        const unsigned gen = old / nloc;
        if (old + 1u == (gen + 1u) * nloc) {
            __builtin_amdgcn_fence(__ATOMIC_RELEASE, "agent");
            asm volatile("s_waitcnt vmcnt(0)" ::: "memory");
            const unsigned og = xb_add(&bar[XB_TOP], 1u);
            const unsigned tg = og / nx;
            if (og + 1u == (tg + 1u) * nx) xb_add(&bar[XB_TOPGEN], 1u);
            else XB_SPIN(xb_ld(&bar[XB_TOPGEN]) == tg, bar);
            __builtin_amdgcn_fence(__ATOMIC_ACQUIRE, "agent");
            xb_add(&bar[XB_XGEN(b.x)], 1u);
            asm volatile("s_waitcnt vmcnt(0)" ::: "memory");
        } else {
            XB_SPIN(xb_ld(&bar[XB_XGEN(b.x)]) == gen, bar);
            __builtin_amdgcn_fence(__ATOMIC_ACQUIRE, "agent");
            asm volatile("s_waitcnt vmcnt(0)" ::: "memory");
        }
    }
    __syncthreads();
}


DI void transpose_item(const float* W, int ldw, int K, int src_col0, int valid, bf16_t* WT, int dst_row0, int k0, LAS float* scr, int lane) {
    const int nn = lane & 31;
    float tv[64];
#pragma unroll
    for (int i = 0; i < 64; ++i) { const int kk = 2 * i + (lane >> 5);
        tv[i] = 0.f; if (nn < valid) tv[i] = W[(size_t)(k0 + kk) * ldw + src_col0 + nn]; }
#pragma unroll
    for (int i = 0; i < 64; ++i) { const int kk = 2 * i + (lane >> 5); scr[kk * 33 + nn] = tv[i]; }
    asm volatile("s_waitcnt lgkmcnt(0)" ::: "memory");
    const int c = lane & 15;
#pragma unroll
    for (int j = 0; j < 8; ++j) { const int n = (lane >> 4) + 4 * j; const LAS float* s = scr + (8 * c) * 33 + n;
        u32x4 o; o.x = pk2(s[0 * 33], s[1 * 33]); o.y = pk2(s[2 * 33], s[3 * 33]); o.z = pk2(s[4 * 33], s[5 * 33]); o.w = pk2(s[6 * 33], s[7 * 33]);
        *(u32x4*)(WT + (size_t)(dst_row0 + n) * K + k0 + 8 * c) = o; }
    asm volatile("s_waitcnt lgkmcnt(0)" ::: "memory");
}

DI void phase_prep(const Params& p, unsigned char* wsp, LAS unsigned char* lds, int tid) {
    const int lane = tid & 63, wave = tid >> 6, G = gridDim.x, b = blockIdx.x;
    float* mod = (float*)(wsp + WS_MOD);
    for (int u = b; u < 192; u += G) {
        const int l = u / 96, strip = u % 96, kg = tid >> 5, cl = tid & 31, col = 128 * strip + 4 * cl;
        f32x4 acc = {0.f, 0.f, 0.f, 0.f};
        const float* wp = p.w_ada + (size_t)l * 2048 * 12288 + col;
#pragma unroll 16
        for (int k = kg; k < 2048; k += 16) { const float s = siluf_(p.c[k]); const f32x4 w = *(const f32x4*)(wp + (size_t)k * 12288); acc += s * w; }
        LAS f32x4* red = (LAS f32x4*)lds;
        red[kg * 32 + cl] = acc;
        lds_barrier();
        if (tid < 128) { float s = 0.f; const LAS float* rf = (const LAS float*)lds;
#pragma unroll
            for (int g = 0; g < 16; ++g) s += rf[g * 128 + tid];
            mod[l * 12288 + 128 * strip + tid] = s + p.b_ada[l * 12288 + 128 * strip + tid]; }
        lds_barrier();
    }
    LAS float* scr = (LAS float*)(lds + wave * 17408);
    const int gw = b * 8 + wave, NGW = G * 8;
    constexpr int I_IN = 488 * 16, I_BR = 64 * 8, I_O = 64 * 16, I_MI = 256 * 16, I_MO = 64 * 64, I_L = I_IN + 3 * I_BR + I_O + I_MI + I_MO;
    for (int it = gw; it < 2 * I_L; it += NGW) {
        const int l = it / I_L; int r = it % I_L;
        unsigned char* wl = wsp + WS_W + (size_t)l * SZ_WL;
        if (r < I_IN) { const int kb = r / 488, nb = r % 488, d0 = 32 * nb; int src, valid;
            if (d0 < 4096) { src = d0; valid = 32; } else if (d0 < 15360) { src = d0 + 16; valid = 32; } else if (d0 == 15360) { src = 4096; valid = 16; } else { src = 0; valid = 0; }
            transpose_item(p.w_in + (size_t)l * 2048 * INW, INW, 2048, src, valid, (bf16_t*)wl, d0, 128 * kb, scr, lane); continue; }
        r -= I_IN;
        if (r < 3 * I_BR) { const int which = r / I_BR, q = r % I_BR, kb = q / 64, nb = q % 64;
            const float* W = (which == 0 ? p.w_a : which == 1 ? p.w_b : p.w_c) + (size_t)l * 1024 * 2048;
            transpose_item(W, 2048, 1024, 32 * nb, 32, (bf16_t*)(wl + SZ_WT_IN + which * SZ_WT_BR), 32 * nb, 128 * kb, scr, lane); continue; }
        r -= 3 * I_BR;
        if (r < I_O) { const int kb = r / 64, nb = r % 64;
            transpose_item(p.w_out + (size_t)l * 2048 * 2048, 2048, 2048, 32 * nb, 32, (bf16_t*)(wl + SZ_WT_IN + 3 * SZ_WT_BR), 32 * nb, 128 * kb, scr, lane); continue; }
        r -= I_O;
        if (r < I_MI) { const int kb = r / 256, nb = r % 256;
            transpose_item(p.w_mi + (size_t)l * 2048 * 8192, 8192, 2048, 32 * nb, 32, (bf16_t*)(wl + SZ_WT_IN + 3 * SZ_WT_BR + SZ_WT_O), 32 * nb, 128 * kb, scr, lane); continue; }
        r -= I_MI;
        { const int kb = r / 64, nb = r % 64;
            transpose_item(p.w_mo + (size_t)l * 8192 * 2048, 2048, 8192, 32 * nb, 32, (bf16_t*)(wl + SZ_WT_IN + 3 * SZ_WT_BR + SZ_WT_O + SZ_WT_M), 32 * nb, 128 * kb, scr, lane); }
    }
}

DI void phase_norm(const float* xin, const float* nw, const float* scale, const float* shift, bf16_t* H, float* outf, int tid) {
    const int lane = tid & 63, wave = tid >> 6, gw = blockIdx.x * 8 + wave, NGW = gridDim.x * 8;
    for (int row0 = gw; row0 < T_; row0 += 2 * NGW) {
        const int row1 = (row0 + NGW < T_) ? row0 + NGW : row0;
        f32x4 v[2][8]; float ss[2] = {0.f, 0.f};
#pragma unroll
        for (int r = 0; r < 2; ++r) { const float* xr = xin + (size_t)(r ? row1 : row0) * D_;
#pragma unroll
            for (int j = 0; j < 8; ++j) v[r][j] = *(const f32x4*)(xr + (j * 64 + lane) * 4); }
#pragma unroll
        for (int r = 0; r < 2; ++r) {
#pragma unroll
            for (int j = 0; j < 8; ++j) ss[r] += (v[r][j][0] * v[r][j][0] + v[r][j][1] * v[r][j][1]) + (v[r][j][2] * v[r][j][2] + v[r][j][3] * v[r][j][3]);
            ss[r] = wave_sum(ss[r]); }
#pragma unroll
        for (int r = 0; r < 2; ++r) { const int row = r ? row1 : row0; if (r == 1 && row1 == row0) break;
            const float rstd = 1.0f / sqrtf(ss[r] * (1.0f / D_) + EPS);
#pragma unroll
            for (int j = 0; j < 8; ++j) { const int c = (j * 64 + lane) * 4; const f32x4 w = *(const f32x4*)(nw + c);
                f32x4 y = v[r][j] * rstd * w;
                if (H) { const f32x4 sc = *(const f32x4*)(scale + c), sh = *(const f32x4*)(shift + c); y = y * (1.0f + sc) + sh;
                    u32x2 o; o.x = pk2(y[0], y[1]); o.y = pk2(y[2], y[3]); *(u32x2*)(H + (size_t)row * D_ + c) = o; }
                else *(f32x4*)(outf + (size_t)row * D_ + c) = y; } }
    }
}

DI void gdn_prep_unit(const Params& p, unsigned char* wsp, int l, int hh, int n, LAS unsigned char* lds, int tid) {
    asm volatile("" : "+v"(tid));
    const int lane = tid & 63, wave = tid >> 6, quad = lane >> 4, l15 = lane & 15;
    const int r = tid >> 3, cgp = tid & 7, t = 64 * n + r;
    constexpr int K_OFF = 0, KB_OFF = 17408, Q_OFF = 34816, VBT_OFF = 52224, KBGT_OFF = 70656, KDT_OFF = 89088, T_OFF = 107520, L_OFF = 116736, SG_OFF = 134144, SB_OFF = SG_OFF + 256, GC_OFF = SB_OFF + 256;
    constexpr int ATTI_OFF = 135168, WT_OFF = K_OFF, UT_OFF = KB_OFF;
    static_assert(ATTI_OFF + 9216 <= LDS_BYTES - 16, "lds");
    const bf16_t* PROJ = (const bf16_t*)(wsp + WS_PROJ); const float* BA = (const float*)(wsp + WS_BA);
    const size_t ub = (size_t)hh * 128 + n;
    u32x4 pa[3][4][2];
#pragma unroll
    for (int X = 0; X < 3; ++X) { const int ch = X * 1024 + hh * 128 + 16 * cgp;
#pragma unroll
        for (int j = 0; j < 4; ++j) { const int tt = t - 3 + j; pa[X][j][0] = (u32x4){0u, 0u, 0u, 0u}; pa[X][j][1] = (u32x4){0u, 0u, 0u, 0u};
            if (tt >= 0) { pa[X][j][0] = *(const u32x4*)(PROJ + (size_t)tt * PROJ_LD + ch); pa[X][j][1] = *(const u32x4*)(PROJ + (size_t)tt * PROJ_LD + ch + 8); } } }
    float ba_b = 0.f, ba_a = 0.f;
    if (cgp == 0) { ba_b = BA[(size_t)t * 16 + hh]; ba_a = BA[(size_t)t * 16 + 8 + hh]; }
    {   LAS float* CW = (LAS float*)lds;
#pragma unroll
        for (int i = 0; i < 3; ++i) { const int f = tid + 512 * i, X = f >> 9, j = (f >> 7) & 3, c = f & 127;
            CW[f] = p.conv_qkv_w[((size_t)l * 4 + j) * 3072 + X * 1024 + hh * 128 + c]; } }
    lds_barrier();
    float val[3][16];
#pragma unroll
    for (int X = 0; X < 3; ++X) {
#pragma unroll
        for (int i = 0; i < 16; ++i) val[X][i] = 0.f;
#pragma unroll
        for (int j = 0; j < 4; ++j) { float xa[8], xb[8]; unpack8(pa[X][j][0], xa); unpack8(pa[X][j][1], xb);
            const LAS float* cw = (const LAS float*)lds + X * 512 + j * 128 + 16 * cgp;
#pragma unroll
            for (int q4 = 0; q4 < 4; ++q4) { const f32x4 w = *(const LAS f32x4*)(cw + 4 * q4);
#pragma unroll
                for (int e = 0; e < 4; ++e) { const int i = 4 * q4 + e; val[X][i] += w[e] * (i < 8 ? xa[i] : xb[i - 8]); } } }
#pragma unroll
        for (int i = 0; i < 16; ++i) val[X][i] = siluf_(val[X][i]);
    }
    {   float sq = 0.f, sk = 0.f;
#pragma unroll
        for (int i = 0; i < 16; ++i) { sq += val[0][i] * val[0][i]; sk += val[1][i] * val[1][i]; }
        sq += __shfl_xor(sq, 1); sq += __shfl_xor(sq, 2); sq += __shfl_xor(sq, 4);
        sk += __shfl_xor(sk, 1); sk += __shfl_xor(sk, 2); sk += __shfl_xor(sk, 4);
        const float rq = (1.0f / sqrtf(sq + 1e-6f)) * 0.08838834764831845f, rk = 1.0f / sqrtf(sk + 1e-6f);
#pragma unroll
        for (int i = 0; i < 16; ++i) { val[0][i] *= rq; val[1][i] *= rk; }
    }
    LAS float* SG = (LAS float*)(lds + SG_OFF); LAS float* SB = (LAS float*)(lds + SB_OFF); LAS float* GC = (LAS float*)(lds + GC_OFF);
    if (cgp == 0) { const float ab = ba_b, aa = ba_a;
        const float xx = aa + p.dt_bias[l * 8 + hh]; const float sp = xx > 20.f ? xx : __logf(1.0f + __expf(xx));
        SG[r] = -expf(p.a_log[l * 8 + hh]) * sp; SB[r] = 1.0f / (1.0f + expf(-ab)); }
    lds_barrier();
    if (wave == 0) { float xg = SG[lane];
#pragma unroll
        for (int o = 1; o < 64; o <<= 1) { const float y = __shfl_up(xg, o); if (lane >= o) xg += y; }
        GC[lane] = xg; }
    lds_barrier();
    {   const float bta = SB[r], gcr = GC[r], glast = GC[63], eg = expf(gcr), ekd = expf(glast - gcr);
        float tq[16], tk[16], tkb[16];
#pragma unroll
        for (int i = 0; i < 16; ++i) { tq[i] = val[0][i]; tk[i] = val[1][i]; tkb[i] = val[1][i] * bta; }
        *(LAS u32x4*)(lds + K_OFF + (r * 136 + 16 * cgp) * 2) = pack8(tk); *(LAS u32x4*)(lds + K_OFF + (r * 136 + 16 * cgp + 8) * 2) = pack8(tk + 8);
        *(LAS u32x4*)(lds + KB_OFF + (r * 136 + 16 * cgp) * 2) = pack8(tkb); *(LAS u32x4*)(lds + KB_OFF + (r * 136 + 16 * cgp + 8) * 2) = pack8(tkb + 8);
        *(LAS u32x4*)(lds + Q_OFF + (r * 136 + 16 * cgp) * 2) = pack8(tq); *(LAS u32x4*)(lds + Q_OFF + (r * 136 + 16 * cgp + 8) * 2) = pack8(tq + 8);
#pragma unroll
        for (int i = 0; i < 16; ++i) { const int e = 16 * cgp + i;
            *(LAS bf16_t*)(lds + VBT_OFF + (e * 72 + r) * 2) = f2bf(val[2][i] * bta);
            *(LAS bf16_t*)(lds + KBGT_OFF + (e * 72 + r) * 2) = f2bf(tkb[i] * eg);
            *(LAS bf16_t*)(lds + KDT_OFF + (e * 72 + r) * 2) = f2bf(tk[i] * ekd); }
        if (tid == 0) ((float*)(wsp + G_GL))[ub] = expf(glast);
    }
    lds_barrier();
    LAS float* Lm = (LAS float*)(lds + L_OFF);
#pragma unroll
    for (int tt = 0; tt < 2; ++tt) { const int id = 2 * wave + tt, mi = id >> 2, ni = id & 3;
        f32x4 aK = {0.f, 0.f, 0.f, 0.f}, aA = {0.f, 0.f, 0.f, 0.f};
#pragma unroll
        for (int ks = 0; ks < 4; ++ks) { const bf16x8 kf = lds_frag(lds + K_OFF, 16 * ni + l15, 136, 32 * ks + 8 * quad);
            const bf16x8 kbf = lds_frag(lds + KB_OFF, 16 * mi + l15, 136, 32 * ks + 8 * quad), qf = lds_frag(lds + Q_OFF, 16 * mi + l15, 136, 32 * ks + 8 * quad);
            aK = mfma16(kbf, kf, aK);
            aA = mfma16(kf, qf, aA); }
        { const int s = 16 * ni + l15; const float gs = GC[s];
#pragma unroll
            for (int j = 0; j < 4; ++j) { const int c = 16 * mi + 4 * quad + j; Lm[c * 68 + s] = (c > s) ? aK[j] * expf(GC[c] - gs) : 0.f; } }
        { const int c = 16 * mi + l15; const float gcc = GC[c]; float o[4];
#pragma unroll
            for (int j = 0; j < 4; ++j) { const int s = 16 * ni + 4 * quad + j; o[j] = (c >= s) ? aA[j] * expf(gcc - GC[s]) : 0.f; }
            u32x2 w; w.x = pk2(o[0], o[1]); w.y = pk2(o[2], o[3]);
            *(LAS u32x2*)(lds + ATTI_OFF + (c * 72 + 16 * ni + 4 * quad) * 2) = w; }
    }
    lds_barrier();
    if (wave == 0) {
        float Tc[64];
        int zoff; asm volatile("v_mov_b32 %0, 0" : "=v"(zoff));
        const LAS float* Lz = Lm + zoff;
#pragma unroll
        for (int i = 0; i < 64; ++i) { float a = (lane == i) ? 1.f : 0.f;
#pragma unroll
            for (int j4 = 0; j4 < (i + 3) / 4; ++j4) { const f32x4 lv = *(const LAS f32x4*)(Lz + i * 68 + 4 * j4);
#pragma unroll
                for (int jj = 0; jj < 4; ++jj) if (4 * j4 + jj < i) a -= lv[jj] * Tc[4 * j4 + jj]; }
            Tc[i] = a; if ((i & 3) == 3) asm volatile("" ::: "memory"); }
#pragma unroll
        for (int i = 0; i < 64; ++i) *(LAS bf16_t*)(lds + T_OFF + (i * 72 + lane) * 2) = f2bf(Tc[i]);
    }
    lds_barrier();
    {   bf16x8 vf[2], gf[2];
#pragma unroll
        for (int ks = 0; ks < 2; ++ks) { vf[ks] = lds_frag(lds + VBT_OFF, 16 * wave + l15, 72, 32 * ks + 8 * quad); gf[ks] = lds_frag(lds + KBGT_OFF, 16 * wave + l15, 72, 32 * ks + 8 * quad); }
#pragma unroll
        for (int mi = 0; mi < 4; ++mi) { f32x4 aU = {0.f, 0.f, 0.f, 0.f}, aW = {0.f, 0.f, 0.f, 0.f};
#pragma unroll
            for (int ks = 0; ks < 2; ++ks) { const bf16x8 tf = lds_frag(lds + T_OFF, 16 * mi + l15, 72, 32 * ks + 8 * quad);
                aU = mfma16(tf, vf[ks], aU); aW = mfma16(tf, gf[ks], aW); }
            u32x2 wu; wu.x = pk2(aU[0], aU[1]); wu.y = pk2(aU[2], aU[3]);
            u32x2 ww; ww.x = pk2(aW[0], aW[1]); ww.y = pk2(aW[2], aW[3]);
            *(LAS u32x2*)(lds + UT_OFF + ((16 * wave + l15) * 64 + 16 * mi + 4 * quad) * 2) = wu;
            *(LAS u32x2*)(lds + WT_OFF + ((16 * wave + l15) * 64 + 16 * mi + 4 * quad) * 2) = ww; }
    }
    lds_barrier();
    {   bf16x8 kdf[2], wtf[2], utf[2];
#pragma unroll
        for (int ks = 0; ks < 2; ++ks) { kdf[ks] = lds_frag(lds + KDT_OFF, 16 * wave + l15, 72, 32 * ks + 8 * quad);
            wtf[ks] = lds_frag(lds + WT_OFF, 16 * wave + l15, 64, 32 * ks + 8 * quad); utf[ks] = lds_frag(lds + UT_OFF, 16 * wave + l15, 64, 32 * ks + 8 * quad); }
        bf16_t* GA = (bf16_t*)(wsp + G_A) + ub * 16384; bf16_t* GB = (bf16_t*)(wsp + G_BT) + ub * 16384;
        bf16_t* GCp = (bf16_t*)(wsp + G_C) + ub * 8192; bf16_t* GD = (bf16_t*)(wsp + G_D) + ub * 8192;
#pragma unroll
        for (int t2 = 0; t2 < 8; ++t2) {
            f32x4 aA = {0.f, 0.f, 0.f, 0.f}, aB = {0.f, 0.f, 0.f, 0.f};
#pragma unroll
            for (int ks = 0; ks < 2; ++ks) { const bf16x8 wx = lds_frag(lds + WT_OFF, 16 * t2 + l15, 64, 32 * ks + 8 * quad), kx = lds_frag(lds + KDT_OFF, 16 * t2 + l15, 72, 32 * ks + 8 * quad);
                aA = mfma16(wx, kdf[ks], aA);
                aB = mfma16(kx, utf[ks], aB); }
            u32x2 wa; wa.x = pk2(-aA[0], -aA[1]); wa.y = pk2(-aA[2], -aA[3]);
            *(u32x2*)(GA + ((wave * 4 + (t2 >> 1)) * 64 + (2 * (t2 & 1) + (quad >> 1)) * 16 + l15) * 8 + 4 * (quad & 1)) = wa;
            u32x2 wb; wb.x = pk2(aB[0], aB[1]); wb.y = pk2(aB[2], aB[3]);
            *(u32x2*)(GB + ((((wave >> 1) * 8 + t2) * 64 + quad * 16 + l15) * 2 + (wave & 1)) * 4) = wb; }
#pragma unroll
        for (int mi = 0; mi < 4; ++mi) {
            f32x4 aC = {0.f, 0.f, 0.f, 0.f}, aD = {0.f, 0.f, 0.f, 0.f};
#pragma unroll
            for (int ks = 0; ks < 2; ++ks) { const bf16x8 af = lds_frag(lds + ATTI_OFF, 16 * mi + l15, 72, 32 * ks + 8 * quad);
                aC = mfma16(wtf[ks], af, aC);
                aD = mfma16(utf[ks], af, aD); }
            const int c = 16 * mi + l15; const float egc = expf(GC[c]);
            const u32x2 qw = *(const LAS u32x2*)(lds + Q_OFF + (c * 136 + 16 * wave + 4 * quad) * 2);
            u32x2 wc; wc.x = pk2(bf_lo(qw.x) * egc - aC[0], bf_hi(qw.x) * egc - aC[1]); wc.y = pk2(bf_lo(qw.y) * egc - aC[2], bf_hi(qw.y) * egc - aC[3]);
            *(u32x2*)(GCp + ((mi * 4 + (wave >> 1)) * 64 + (2 * (wave & 1) + (quad >> 1)) * 16 + l15) * 8 + 4 * (quad & 1)) = wc;
            u32x2 wd; wd.x = pk2(aD[0], aD[1]); wd.y = pk2(aD[2], aD[3]);
            *(u32x2*)(GD + ((wave * 4 + mi) * 64 + quad * 16 + l15) * 4) = wd; }
    }
    lds_barrier();
}

DI void ret_prep_unit(const Params& p, unsigned char* wsp, int hr, int n, LAS unsigned char* lds, int tid) {
    asm volatile("" : "+v"(tid));
    const int lane = tid & 63, wave = tid >> 6, quad = lane >> 4, l15 = lane & 15;
    const int r = tid >> 3, cgp = tid & 7, t = 64 * n + r;
    constexpr int RQ_OFF = 0, RK_OFF = 17408, KTT_OFF = 34816, VT_OFF = 53248;
    const bf16_t* PROJ = (const bf16_t*)(wsp + WS_PROJ);
    const size_t ub = (size_t)hr * 128 + n;
    const float lg2 = ret_lg2(hr);
    const float xi = exp2f((float)(r + 1) * lg2), zeta = exp2f((float)(63 - r) * lg2);
    const float posf = (float)p.pos[t];
    {   const bf16_t* pq = PROJ + (size_t)t * PROJ_LD + 4096 + hr * 128 + 8 * cgp; const bf16_t* pk = PROJ + (size_t)t * PROJ_LD + 4608 + hr * 128 + 8 * cgp;
        float q1[8], q2[8], k1[8], k2[8];
        unpack8(*(const u32x4*)pq, q1); unpack8(*(const u32x4*)(pq + 64), q2); unpack8(*(const u32x4*)pk, k1); unpack8(*(const u32x4*)(pk + 64), k2);
        float rq1[8], rq2[8], rk1[8], rk2[8];
#pragma unroll
        for (int ii = 0; ii < 8; ++ii) { const int i = 8 * cgp + ii;
            const float invf = expf(-(float)i * (9.210340371976184f / 64.0f)); const float ang = posf * invf; const float trev = ang * 0.15915494309189535f; const float fr = trev - rintf(trev);
            const float cs = __builtin_amdgcn_cosf(fr), sn = __builtin_amdgcn_sinf(fr);
            rq1[ii] = q1[ii] * cs - q2[ii] * sn; rq2[ii] = q1[ii] * sn + q2[ii] * cs;
            rk1[ii] = (k1[ii] * cs - k2[ii] * sn) * 0.08838834764831845f; rk2[ii] = (k1[ii] * sn + k2[ii] * cs) * 0.08838834764831845f; }
        *(LAS u32x4*)(lds + RQ_OFF + (r * 136 + 8 * cgp) * 2) = pack8(rq1); *(LAS u32x4*)(lds + RQ_OFF + (r * 136 + 64 + 8 * cgp) * 2) = pack8(rq2);
        *(LAS u32x4*)(lds + RK_OFF + (r * 136 + 8 * cgp) * 2) = pack8(rk1); *(LAS u32x4*)(lds + RK_OFF + (r * 136 + 64 + 8 * cgp) * 2) = pack8(rk2);
#pragma unroll
        for (int ii = 0; ii < 8; ++ii) { *(LAS bf16_t*)(lds + KTT_OFF + ((8 * cgp + ii) * 72 + r) * 2) = f2bf(rk1[ii] * zeta); *(LAS bf16_t*)(lds + KTT_OFF + ((64 + 8 * cgp + ii) * 72 + r) * 2) = f2bf(rk2[ii] * zeta);
            rq1[ii] *= xi; rq2[ii] *= xi; }
        bf16_t* QI = (bf16_t*)(wsp + R_QI) + ub * 8192 + (size_t)((((r >> 4) * 4 + (cgp >> 2)) * 64 + (cgp & 3) * 16 + (r & 15)) * 8);
        *(u32x4*)QI = pack8(rq1); *(u32x4*)(QI + 2 * 512) = pack8(rq2);
    }
    {   const bf16_t* pv = PROJ + (size_t)t * PROJ_LD + 5120 + hr * 256 + 32 * cgp;
#pragma unroll
        for (int q = 0; q < 4; ++q) { float vv[8]; unpack8(*(const u32x4*)(pv + 8 * q), vv);
#pragma unroll
            for (int i = 0; i < 8; ++i) *(LAS bf16_t*)(lds + VT_OFF + ((32 * cgp + 8 * q + i) * 72 + r) * 2) = f2bf(vv[i]); }
    }
    lds_barrier();
#pragma unroll
    for (int tt = 0; tt < 2; ++tt) { const int id = 2 * wave + tt, mi = id >> 2, ni = id & 3;
        f32x4 aA = {0.f, 0.f, 0.f, 0.f};
#pragma unroll
        for (int ks = 0; ks < 4; ++ks) { const bf16x8 kf = lds_frag(lds + RK_OFF, 16 * ni + l15, 136, 32 * ks + 8 * quad), qf = lds_frag(lds + RQ_OFF, 16 * mi + l15, 136, 32 * ks + 8 * quad);
            aA = mfma16(kf, qf, aA); }
        const int c = 16 * mi + l15; float o[4];
#pragma unroll
        for (int j = 0; j < 4; ++j) { const int s = 16 * ni + 4 * quad + j; o[j] = (c >= s) ? aA[j] * exp2f((float)(c - s) * lg2) : 0.f; }
        u32x2 w; w.x = pk2(o[0], o[1]); w.y = pk2(o[2], o[3]);
        *(u32x2*)((bf16_t*)(wsp + R_SC) + ub * 4096 + ((mi * 2 + (ni >> 1)) * 64 + (2 * (ni & 1) + (quad >> 1)) * 16 + l15) * 8 + 4 * (quad & 1)) = w; }
    {
        bf16x8 kf[2];
#pragma unroll
        for (int ks = 0; ks < 2; ++ks) kf[ks] = lds_frag(lds + KTT_OFF, 16 * wave + l15, 72, 32 * ks + 8 * quad);
        float* PT = (float*)(wsp + R_P) + ub * 32768;
#pragma unroll 4
        for (int et = 0; et < 16; ++et) { f32x4 a = {0.f, 0.f, 0.f, 0.f};
#pragma unroll
            for (int ks = 0; ks < 2; ++ks) a = mfma16(kf[ks], lds_frag(lds + VT_OFF, 16 * et + l15, 72, 32 * ks + 8 * quad), a);
            *(f32x4*)(PT + ((et * 4 + (wave >> 1)) * 64 + (2 * (wave & 1) + (quad >> 1)) * 16 + l15) * 8 + 4 * (quad & 1)) = a; }
    }
#pragma unroll
    for (int i = 0; i < 4; ++i) { const int id = tid + 512 * i, row = id >> 3, chn = id & 7;
        *(u32x4*)((bf16_t*)(wsp + R_VT) + (ub * 256 + row) * 64 + 8 * chn) = *(const LAS u32x4*)(lds + VT_OFF + (row * 72 + 8 * chn) * 2); }
    lds_barrier();
}

struct SFrag { bf16x8 af[4]; u32x2 bt[2]; };
DI void sfrag_load(SFrag& f, const unsigned char* ws, int hh, int es, int n, int wave, int quad, int l15) {
    const size_t ub = (size_t)hh * 128 + n;
    const int lane = quad * 16 + l15;
    const bf16_t* Ap = (const bf16_t*)(ws + G_A) + ub * 16384 + (size_t)(wave * 4) * 512 + lane * 8;
    const bf16_t* Bp = (const bf16_t*)(ws + G_BT) + ub * 16384 + (size_t)((es * 8 + wave) * 64 + lane) * 8;
#pragma unroll
    for (int ks = 0; ks < 4; ++ks) f.af[ks] = *(const bf16x8*)(Ap + ks * 512);
    {   const u32x4 b4 = *(const u32x4*)Bp; f.bt[0] = (u32x2){b4.x, b4.y}; f.bt[1] = (u32x2){b4.z, b4.w}; }
}
DI void gdn_chain(const Params& p, unsigned char* wsp, int l, int hh, int es, LAS unsigned char* lds, int tid) {
    asm volatile("" : "+v"(tid));
    const int lane = tid & 63, wave = tid >> 6, quad = lane >> 4, l15 = lane & 15;
    constexpr int ST_BYTES = 8704;
    for (int i = tid; i < 2 * ST_BYTES / 4; i += NTHR) ((LAS unsigned*)lds)[i] = 0u;
    LAS float* GLs = (LAS float*)(lds + 2 * ST_BYTES);
    if (tid < 128) GLs[tid] = ((const float*)(wsp + G_GL))[hh * 128 + tid];
    f32x4 Sacc[2] = {{0.f, 0.f, 0.f, 0.f}, {0.f, 0.f, 0.f, 0.f}};
    bf16_t* SG = (bf16_t*)(wsp + G_S) + ((size_t)hh * 128) * 16384 + (size_t)(((2 * es + (wave >> 2)) * 4 + (wave & 3)) * 64 + lane) * 8;
    const int srd = ((16 * (wave >> 2) + l15) * 136 + 32 * (wave & 3) + 8 * quad) * 2;
    SFrag f0, f1, f2, f3, f4, f5;
#define CFENCE() asm volatile("" ::: "memory")
    sfrag_load(f0, wsp, hh, es, 0, wave, quad, l15); CFENCE(); sfrag_load(f1, wsp, hh, es, 1, wave, quad, l15); CFENCE(); sfrag_load(f2, wsp, hh, es, 2, wave, quad, l15); CFENCE();
    sfrag_load(f3, wsp, hh, es, 3, wave, quad, l15); CFENCE(); sfrag_load(f4, wsp, hh, es, 4, wave, quad, l15); CFENCE();
#undef CFENCE
    lds_barrier();
#define S_STEP(cur, n) do { \
        LAS unsigned char* sc = lds + ((n) & 1) * ST_BYTES; LAS unsigned char* sn = lds + (((n) + 1) & 1) * ST_BYTES; \
        const float glv = GLs[(n)]; \
        bf16x8 sfr[2][4]; \
        _Pragma("unroll") for (int et = 0; et < 2; ++et) _Pragma("unroll") for (int ks = 0; ks < 4; ++ks) sfr[et][ks] = lds_frag(sc, 16 * et + l15, 136, 32 * ks + 8 * quad);     \
        *(u32x4*)(SG + (size_t)(n) * 16384) = *(const LAS u32x4*)(sc + srd);                  \
        _Pragma("unroll") for (int et = 0; et < 2; ++et) { \
            f32x4 a; a[0] = Sacc[et][0] * glv + bf_lo(cur.bt[et].x); a[1] = Sacc[et][1] * glv + bf_hi(cur.bt[et].x); a[2] = Sacc[et][2] * glv + bf_lo(cur.bt[et].y); a[3] = Sacc[et][3] * glv + bf_hi(cur.bt[et].y); \
            _Pragma("unroll") for (int ks = 0; ks < 4; ++ks) a = mfma16(cur.af[ks], sfr[et][ks], a);     \
            Sacc[et] = a; \
            u32x2 w; w.x = pk2(a[0], a[1]); w.y = pk2(a[2], a[3]); \
            *(LAS u32x2*)(sn + ((16 * et + l15) * 136 + 16 * wave + 4 * quad) * 2) = w; } \
        lds_barrier(); } while (0)
#define S_LOAD(f, n) sfrag_load(f, wsp, hh, es, (n) < 128 ? (n) : 127, wave, quad, l15)
    for (int n = 0; n < 126; n += 6) {
        S_LOAD(f5, n + 5);  S_STEP(f0, n);
        S_LOAD(f0, n + 6);  S_STEP(f1, n + 1);
        S_LOAD(f1, n + 7);  S_STEP(f2, n + 2);
        S_LOAD(f2, n + 8);  S_STEP(f3, n + 3);
        S_LOAD(f3, n + 9);  S_STEP(f4, n + 4);
        S_LOAD(f4, n + 10); S_STEP(f5, n + 5);
    }
    S_STEP(f0, 126); S_STEP(f1, 127);
#undef S_STEP
#undef S_LOAD
}

DI void ret_scan(unsigned char* wsp, int sb, int tid) {
    const int idx = sb * NTHR + tid;
    const int hr = idx >> 13, off = (idx & 8191) * 4;
    const float cd = exp2f(64.0f * ret_lg2(hr));
    const float* P = (const float*)(wsp + R_P) + (size_t)hr * 128 * 32768 + off;
    bf16_t* RT = (bf16_t*)(wsp + R_RT) + (size_t)hr * 128 * 32768 + off;
    f32x4 R = {0.f, 0.f, 0.f, 0.f};
    for (int n0 = 0; n0 < 128; n0 += 16) {
        f32x4 pv[16];
#pragma unroll
        for (int i = 0; i < 16; ++i) pv[i] = *(const f32x4*)(P + (size_t)(n0 + i) * 32768);
#pragma unroll
        for (int i = 0; i < 16; ++i) { u32x2 w; w.x = pk2(R[0], R[1]); w.y = pk2(R[2], R[3]); *(u32x2*)(RT + (size_t)(n0 + i) * 32768) = w; R = R * cd + pv[i]; }
    }
}

DI void gdn_out_unit(const Params& p, unsigned char* wsp, int l, int hh, int n, LAS unsigned char* lds, int tid) {
    asm volatile("" : "+v"(tid));
    const int lane = tid & 63, wave = tid >> 6, quad = lane >> 4, l15 = lane & 15;
    const size_t ub = (size_t)hh * 128 + n;
    const bf16_t* Sp = (const bf16_t*)(wsp + G_S) + ub * 16384 + (size_t)(wave * 4) * 512 + lane * 8;
    const bf16_t* Cp = (const bf16_t*)(wsp + G_C) + ub * 8192 + lane * 8;
    const bf16_t* Dp = (const bf16_t*)(wsp + G_D) + ub * 8192 + (size_t)((wave * 4) * 64 + lane) * 4;
    bf16x8 sf[4]; f32x4 acc[4];
    const int e0 = 16 * wave + 4 * quad;
    const bf16_t* PROJ = (const bf16_t*)(wsp + WS_PROJ);
    u32x2 zwv[4];
#pragma unroll
    for (int mi = 0; mi < 4; ++mi) zwv[mi] = *(const u32x2*)(PROJ + (size_t)(64 * n + 16 * mi + l15) * PROJ_LD + 3072 + hh * 128 + e0);
    const f32x4 nw = *(const f32x4*)(p.gdn_norm_w + l * 128 + e0);
#pragma unroll
    for (int ks = 0; ks < 4; ++ks) sf[ks] = *(const bf16x8*)(Sp + ks * 512);
#pragma unroll
    for (int mi = 0; mi < 4; ++mi) { const u32x2 dw = *(const u32x2*)(Dp + mi * 256);
        f32x4 a; a[0] = bf_lo(dw.x); a[1] = bf_hi(dw.x); a[2] = bf_lo(dw.y); a[3] = bf_hi(dw.y);
#pragma unroll
        for (int ks = 0; ks < 4; ++ks) a = mfma16(sf[ks], *(const bf16x8*)(Cp + (mi * 4 + ks) * 512), a);
        acc[mi] = a; }
    LAS float* red = (LAS float*)lds;
#pragma unroll
    for (int mi = 0; mi < 4; ++mi) { float s = (acc[mi][0] * acc[mi][0] + acc[mi][1] * acc[mi][1]) + (acc[mi][2] * acc[mi][2] + acc[mi][3] * acc[mi][3]);
        s += __shfl_xor(s, 16); s += __shfl_xor(s, 32);
        if (quad == 0) red[wave * 64 + 16 * mi + l15] = s; }
    lds_barrier();
    bf16_t* ACTA = (bf16_t*)(wsp + WS_ACT);
#pragma unroll
    for (int mi = 0; mi < 4; ++mi) { const int c = 16 * mi + l15; float tot = 0.f;
#pragma unroll
        for (int w8 = 0; w8 < 8; ++w8) tot += red[w8 * 64 + c];
        const float rs = 1.0f / sqrtf(tot * (1.0f / 128.0f) + EPS);
        const size_t t = (size_t)(64 * n + c);
        const u32x2 zw = zwv[mi];
        u32x2 o; o.x = pk2(acc[mi][0] * rs * nw[0] * siluf_(bf_lo(zw.x)), acc[mi][1] * rs * nw[1] * siluf_(bf_hi(zw.x)));
        o.y = pk2(acc[mi][2] * rs * nw[2] * siluf_(bf_lo(zw.y)), acc[mi][3] * rs * nw[3] * siluf_(bf_hi(zw.y)));
        *(u32x2*)(ACTA + t * 1024 + hh * 128 + e0) = o; }
    lds_barrier();
}
DI void ret_out_unit(const Params& p, unsigned char* wsp, int hr, int n, LAS unsigned char* lds, int tid) {
    asm volatile("" : "+v"(tid));
    const int lane = tid & 63, wave = tid >> 6, quad = lane >> 4, l15 = lane & 15;
    const size_t ub = (size_t)hr * 128 + n;
    const bf16_t* Qp = (const bf16_t*)(wsp + R_QI) + ub * 8192 + lane * 8;
    const bf16_t* Sp = (const bf16_t*)(wsp + R_SC) + ub * 4096 + lane * 8;
    const bf16_t* PROJ = (const bf16_t*)(wsp + WS_PROJ);
    u32x2 bgw[2][4];
#pragma unroll
    for (int tt = 0; tt < 2; ++tt)
#pragma unroll
        for (int mi = 0; mi < 4; ++mi) bgw[tt][mi] = *(const u32x2*)(PROJ + (size_t)(64 * n + 16 * mi + l15) * PROJ_LD + 6144 + hr * 256 + 16 * (2 * wave + tt) + 4 * quad);
    f32x4 acc[2][4];
#pragma unroll
    for (int tt = 0; tt < 2; ++tt) { const int et = 2 * wave + tt;
        const bf16_t* Rp = (const bf16_t*)(wsp + R_RT) + ub * 32768 + (size_t)(et * 4) * 512 + lane * 8;
        const bf16_t* Vp = (const bf16_t*)(wsp + R_VT) + ub * 16384 + (16 * et + l15) * 64 + 8 * quad;
        bf16x8 rf[4], vf[2];
#pragma unroll
        for (int ks = 0; ks < 4; ++ks) rf[ks] = *(const bf16x8*)(Rp + ks * 512);
#pragma unroll
        for (int ks = 0; ks < 2; ++ks) vf[ks] = *(const bf16x8*)(Vp + 32 * ks);
#pragma unroll
        for (int mi = 0; mi < 4; ++mi) { f32x4 a = {0.f, 0.f, 0.f, 0.f};
#pragma unroll
            for (int ks = 0; ks < 4; ++ks) a = mfma16(rf[ks], *(const bf16x8*)(Qp + (mi * 4 + ks) * 512), a);
#pragma unroll
            for (int ks = 0; ks < 2; ++ks) a = mfma16(vf[ks], *(const bf16x8*)(Sp + (mi * 2 + ks) * 512), a);
            acc[tt][mi] = a; } }
    LAS float* red = (LAS float*)lds;
#pragma unroll
    for (int mi = 0; mi < 4; ++mi) { float s = 0.f, q = 0.f;
#pragma unroll
        for (int tt = 0; tt < 2; ++tt) { const f32x4 a = acc[tt][mi]; s += (a[0] + a[1]) + (a[2] + a[3]); q += (a[0] * a[0] + a[1] * a[1]) + (a[2] * a[2] + a[3] * a[3]); }
        s += __shfl_xor(s, 16); s += __shfl_xor(s, 32); q += __shfl_xor(q, 16); q += __shfl_xor(q, 32);
        if (quad == 0) { red[(wave * 64 + 16 * mi + l15) * 2] = s; red[(wave * 64 + 16 * mi + l15) * 2 + 1] = q; } }
    lds_barrier();
    bf16_t* ACTB = (bf16_t*)(wsp + WS_ACT) + (size_t)T_ * 1024;
#pragma unroll
    for (int mi = 0; mi < 4; ++mi) { const int c = 16 * mi + l15; float S = 0.f, Q = 0.f;
#pragma unroll
        for (int w8 = 0; w8 < 8; ++w8) { S += red[(w8 * 64 + c) * 2]; Q += red[(w8 * 64 + c) * 2 + 1]; }
        const float mu = S * (1.0f / 256.0f), var = fmaxf(Q * (1.0f / 256.0f) - mu * mu, 0.f), rs = 1.0f / sqrtf(var + 1e-5f);
#pragma unroll
        for (int tt = 0; tt < 2; ++tt) { const f32x4 a = acc[tt][mi]; const u32x2 g = bgw[tt][mi];
            u32x2 o; o.x = pk2((a[0] - mu) * rs * siluf_(bf_lo(g.x)), (a[1] - mu) * rs * siluf_(bf_hi(g.x))); o.y = pk2((a[2] - mu) * rs * siluf_(bf_lo(g.y)), (a[3] - mu) * rs * siluf_(bf_hi(g.y)));
            *(u32x2*)(ACTB + (size_t)(64 * n + c) * 1024 + hr * 256 + 16 * (2 * wave + tt) + 4 * quad) = o; } }
    lds_barrier();
}

DI void sub_barrier(unsigned* cnt, unsigned target) {
    asm volatile("s_waitcnt vmcnt(0)" ::: "memory");
    __syncthreads();
    if (threadIdx.x == 0) {
        __builtin_amdgcn_fence(__ATOMIC_RELEASE, "agent");
        asm volatile("s_waitcnt vmcnt(0)" ::: "memory");
        (void)__hip_atomic_fetch_add(cnt, 1u, __ATOMIC_RELAXED, __HIP_MEMORY_SCOPE_AGENT);
        unsigned sp = 0;
        while (__hip_atomic_load(cnt, __ATOMIC_RELAXED, __HIP_MEMORY_SCOPE_AGENT) < target) { __builtin_amdgcn_s_sleep(24); if (++sp > (1u << 20)) break; }
        __builtin_amdgcn_fence(__ATOMIC_ACQUIRE, "agent");
        asm volatile("s_waitcnt vmcnt(0)" ::: "memory");
    }
    __syncthreads();
}

DI void conv_unit(const Params& p, unsigned char* wsp, int l, int u, LAS unsigned char* lds, int tid) {
    asm volatile("" : "+v"(tid));
    const int tt = u >> 2, cs = u & 3, t0 = 64 * tt;
    const bf16_t* PROJ = (const bf16_t*)(wsp + WS_PROJ);
    LAS float* Ug = (LAS float*)lds;
    {   const int c8 = tid & 31, rg = tid >> 5;
        u32x4 ga[6], gg[6];
#pragma unroll
        for (int i = 0; i < 6; ++i) { const int rr = rg + 16 * i, t = t0 - 30 + rr; ga[i] = (u32x4){0u, 0u, 0u, 0u}; gg[i] = (u32x4){0u, 0u, 0u, 0u};
            if (rr < 94 && t >= 0) { ga[i] = *(const u32x4*)(PROJ + (size_t)t * PROJ_LD + 7168 + 256 * cs + 8 * c8); gg[i] = *(const u32x4*)(PROJ + (size_t)t * PROJ_LD + 8192 + 256 * cs + 8 * c8); } }
#pragma unroll
        for (int i = 0; i < 6; ++i) { const int rr = rg + 16 * i;
            if (rr < 94) { float a[8], g[8], o[8]; unpack8(ga[i], a); unpack8(gg[i], g);
#pragma unroll
                for (int q = 0; q < 8; ++q) o[q] = a[q] * sigmoidf_(g[q]);
                *(LAS f32x4*)(Ug + rr * 256 + 8 * c8) = (f32x4){o[0], o[1], o[2], o[3]}; *(LAS f32x4*)(Ug + rr * 256 + 8 * c8 + 4) = (f32x4){o[4], o[5], o[6], o[7]}; } }
    }
    lds_barrier();
    {   const int ch = tid & 255, half = tid >> 8, cg_ = 256 * cs + ch;
        float w[31];
#pragma unroll
        for (int j = 0; j < 31; ++j) w[j] = p.conv_dw_w[((size_t)l * 31 + j) * 1024 + cg_];
        const float bias = p.conv_dw_b[l * 1024 + cg_];
        float* CV = (float*)(wsp + WS_CV);
        for (int tl = 32 * half; tl < 32 * half + 32; ++tl) { float a = bias;
#pragma unroll
            for (int j = 0; j < 31; ++j) a += w[j] * Ug[(tl + j) * 256 + ch];
            CV[(size_t)(t0 + tl) * 1024 + cg_] = a; }
    }
    lds_barrier();
}

DI void phase_post(const Params& p, unsigned char* wsp, int l, int tid, const int mask, const int b0, const int nblk) {
    const int lane = tid & 63, wave = tid >> 6, gw = ((int)blockIdx.x - b0) * 8 + wave, NGW = nblk * 8;
    const bf16_t* PROJ = (const bf16_t*)(wsp + WS_PROJ);
    const float* OA = (const float*)(wsp + WS_OA); const float* OB = (const float*)(wsp + WS_OB); const float* CV = (const float*)(wsp + WS_CV);
    bf16_t* ACTA = (bf16_t*)(wsp + WS_ACT); bf16_t* ACTB = ACTA + (size_t)T_ * 1024; bf16_t* ACTC = ACTB + (size_t)T_ * 1024;
    for (int t = gw; t < T_; t += NGW) {
        if (mask & 1)
#pragma unroll
        for (int hh = 0; hh < 8; ++hh) { const int cc = hh * 128 + 2 * lane;
            const float o0 = OA[(size_t)t * 1024 + cc], o1 = OA[(size_t)t * 1024 + cc + 1];
            const float ss = wave_sum(o0 * o0 + o1 * o1); const float rs = 1.0f / sqrtf(ss * (1.0f / 128.0f) + EPS);
            const unsigned zw = *(const unsigned*)(PROJ + (size_t)t * PROJ_LD + 3072 + cc);
            const float w0 = p.gdn_norm_w[l * 128 + 2 * lane], w1 = p.gdn_norm_w[l * 128 + 2 * lane + 1];
            *(unsigned*)(ACTA + (size_t)t * 1024 + cc) = pk2(o0 * rs * w0 * siluf_(bf_lo(zw)), o1 * rs * w1 * siluf_(bf_hi(zw))); }
        if (mask & 2)
#pragma unroll
        for (int hr = 0; hr < 4; ++hr) { const int cc = hr * 256 + 4 * lane;
            const f32x4 o = *(const f32x4*)(OB + (size_t)t * 1024 + cc);
            const float mu = wave_sum((o[0] + o[1]) + (o[2] + o[3])) * (1.0f / 256.0f);
            const f32x4 d = o - mu; const float var = wave_sum((d[0] * d[0] + d[1] * d[1]) + (d[2] * d[2] + d[3] * d[3])) * (1.0f / 256.0f);
            const float rs = 1.0f / sqrtf(var + 1e-5f);
            const u32x2 gwd = *(const u32x2*)(PROJ + (size_t)t * PROJ_LD + 6144 + cc);
            u32x2 w; w.x = pk2(d[0] * rs * siluf_(bf_lo(gwd.x)), d[1] * rs * siluf_(bf_hi(gwd.x))); w.y = pk2(d[2] * rs * siluf_(bf_lo(gwd.y)), d[3] * rs * siluf_(bf_hi(gwd.y)));
            *(u32x2*)(ACTB + (size_t)t * 1024 + cc) = w; }
        if (mask & 4)
        {   f32x4 v[4]; float s = 0.f;
#pragma unroll
            for (int j = 0; j < 4; ++j) { v[j] = *(const f32x4*)(CV + (size_t)t * 1024 + (j * 64 + lane) * 4); s += (v[j][0] + v[j][1]) + (v[j][2] + v[j][3]); }
            const float mu = wave_sum(s) * (1.0f / 1024.0f); float q = 0.f;
#pragma unroll
            for (int j = 0; j < 4; ++j) { v[j] = v[j] - mu; q += (v[j][0] * v[j][0] + v[j][1] * v[j][1]) + (v[j][2] * v[j][2] + v[j][3] * v[j][3]); }
            const float rs = 1.0f / sqrtf(wave_sum(q) * (1.0f / 1024.0f) + 1e-5f);
#pragma unroll
            for (int j = 0; j < 4; ++j) { const int cc = (j * 64 + lane) * 4; const f32x4 lw = *(const f32x4*)(p.conv_ln_w + l * 1024 + cc), lb = *(const f32x4*)(p.conv_ln_b + l * 1024 + cc);
                const f32x4 y = v[j] * rs * lw + lb;
                u32x2 w; w.x = pk2(siluf_(y[0]), siluf_(y[1])); w.y = pk2(siluf_(y[2]), siluf_(y[3]));
                *(u32x2*)(ACTC + (size_t)t * 1024 + cc) = w; }
        }
    }
}

template <class Epi> DI void run_gemm(LAS unsigned char* lds, const bf16_t* A, const bf16_t* Bt, int N, int K, const Epi& E) {
    Gemm g{A, Bt, T_, N, K}; StaticOrder S; S.init(T_, N, (int)gridDim.x, (int)blockIdx.x);
    gemm_phase<Epi, StaticOrder, false>(lds, g, S, E, nullptr);
}

DI void run_phase(const Params& p, unsigned char* wsp, int ph, LAS unsigned char* lds, int tid) {
    const int G = gridDim.x, b = blockIdx.x;
#ifndef SUBM
#define SUBM 3
#endif
#ifndef PHM
#define PHM 0xFFF
#endif
    if (ph == 0) { if (PHM & 0x400) phase_prep(p, wsp, lds, tid); return; }
    if (ph == 21) { if (PHM & 0x800) phase_norm((const float*)(wsp + WS_XC), p.final_w, nullptr, nullptr, nullptr, p.out, tid); return; }
    const int l = (ph - 1) / 10, sp = (ph - 1) % 10;
    const float* mod = (const float*)(wsp + WS_MOD) + l * 12288;
    const float* xin = (l == 0) ? p.x : (const float*)(wsp + WS_XC);
    float* XC = (float*)(wsp + WS_XC);
    bf16_t* H = (bf16_t*)(wsp + WS_H);
    bf16_t* PROJ = (bf16_t*)(wsp + WS_PROJ);
    const unsigned char* wl = wsp + WS_W + (size_t)l * SZ_WL;
    const bf16_t* WT_IN = (const bf16_t*)wl; const bf16_t* WT_BR = (const bf16_t*)(wl + SZ_WT_IN); const bf16_t* WT_O = (const bf16_t*)(wl + SZ_WT_IN + 3 * SZ_WT_BR);
    const bf16_t* WT_MI = (const bf16_t*)(wl + SZ_WT_IN + 3 * SZ_WT_BR + SZ_WT_O); const bf16_t* WT_MO = (const bf16_t*)(wl + SZ_WT_IN + 3 * SZ_WT_BR + SZ_WT_O + SZ_WT_M);
    switch (sp) {
    case 0: if (PHM & (1<<0)) phase_norm(xin, p.norm_mix_w + l * D_, mod + 2048, mod, H, nullptr, tid); break;
    case 1: if (PHM & (1<<1)) { EpiProj E{PROJ, (float*)(wsp + WS_BA)}; run_gemm(lds, H, WT_IN, NP1, 2048, E); } break;
    case 2: if (PHM & (1<<2)) for (int u = b; u < 1024; u += G) gdn_prep_unit(p, wsp, l, u >> 7, u & 127, lds, tid); break;
    case 3: if (PHM & (1<<3)) {
        if (b < 32) { gdn_chain(p, wsp, l, b >> 2, b & 3, lds, tid); lds_barrier(); }
        else {
            const int nb = b - 32, NB = G - 32; unsigned* cnt = (unsigned*)(wsp + WS_PROG) + 1024;
            for (int u = nb; u < 1024; u += NB) { if (u < 512) ret_prep_unit(p, wsp, u >> 7, u & 127, lds, tid); else conv_unit(p, wsp, l, u - 512, lds, tid); }
            sub_barrier(cnt, (unsigned)(NB * (l + 1)));
            if (nb < 64) ret_scan(wsp, nb, tid);
        }
    } break;
    case 4: if (PHM & (1<<4)) {
        for (int u = b; u < 1536; u += G) { if (u < 1024) gdn_out_unit(p, wsp, l, u >> 7, u & 127, lds, tid); else ret_out_unit(p, wsp, (u - 1024) >> 7, (u - 1024) & 127, lds, tid); }
        phase_post(p, wsp, l, tid, 4, 0, G);
    } break;
    case 5: if (PHM & (1<<5)) { const bf16_t* ACT = (const bf16_t*)(wsp + WS_ACT); float* MF = (float*)(wsp + WS_MF); bf16_t* MB = (bf16_t*)(wsp + WS_MB);
        { EpiBranch<0> E{PROJ, MF, MB}; run_gemm(lds, ACT, WT_BR, 2048, 1024, E); }
        { EpiBranch<1> E{PROJ, MF, MB}; run_gemm(lds, ACT + (size_t)T_ * 1024, WT_BR + (size_t)2048 * 1024, 2048, 1024, E); }
        { EpiBranch<2> E{PROJ, MF, MB}; run_gemm(lds, ACT + 2 * (size_t)T_ * 1024, WT_BR + 2 * (size_t)2048 * 1024, 2048, 1024, E); }
    } break;
    case 6: if (PHM & (1<<6)) { EpiResid E{xin, XC, mod + 4096}; run_gemm(lds, (const bf16_t*)(wsp + WS_MB), WT_O, 2048, 2048, E); } break;
    case 7: if (PHM & (1<<7)) phase_norm(XC, p.norm_mlp_w + l * D_, mod + 8192, mod + 6144, H, nullptr, tid); break;
    case 8: if (PHM & (1<<8)) { EpiRelu2 E{PROJ}; run_gemm(lds, H, WT_MI, 8192, 2048, E); } break;
    case 9: if (PHM & (1<<9)) { EpiResid E{XC, XC, mod + 10240}; run_gemm(lds, PROJ, WT_MO, 2048, 8192, E); } break;
    }
}

constexpr int NPHASE = 22;
__global__ void __launch_bounds__(NTHR, 2) mega_kernel(Params p) {
    extern __shared__ __attribute__((aligned(16))) unsigned char smem[];
    LAS unsigned char* lds = (LAS unsigned char*)smem;
    const int tid = threadIdx.x;
    volatile LAS unsigned* xbw = (volatile LAS unsigned*)(lds + LDS_BYTES - 16);
    if (tid == 0) { xbw[0] = 0u; xbw[1] = 0u; }
    __syncthreads();
    if (p.ph_hi - p.ph_lo > 1) (void)xcd_barrier_post((unsigned*)(p.ws + WS_BAR), xbw);
#ifndef PROBE_REP
#define PROBE_REP 0
#endif
    int ph = p.ph_lo, rep = 0, nbar = 0;
    while (ph < p.ph_hi) {
        if (nbar >= 1 && p.ph_hi - p.ph_lo == 2) { __threadfence(); cg::this_grid().sync(); }
        else if (nbar >= 1) { XcdBarrier xb; xb.bar = (unsigned*)(p.ws + WS_BAR); xb.x = xb_xcc_id(); xb.st = (volatile LAS unsigned*)(lds + LDS_BYTES - 16); xcd_barrier(xb); }
        ++nbar;
        int t2 = tid; asm volatile("" : "+v"(t2));
        unsigned char* wsp;
        {   int z; asm volatile("v_mov_b32 %0, 0" : "=v"(z)); z = __builtin_amdgcn_readfirstlane(z);
            wsp = p.ws + z; }
        run_phase(p, wsp, ph, lds, t2);
        const int sp_ = (ph == 0) ? 10 : (ph == 21) ? 11 : (ph - 1) % 10;
        if (rep == 0 && ((PROBE_REP >> sp_) & 1)) rep = 1; else { rep = 0; ++ph; }
    }
}

#ifndef ONE_LAUNCH
#define ONE_LAUNCH 1
#endif
extern "C" void kernel_launch(void* const* d_in, const int* in_sizes, int n_in, void* d_out, int out_size, void* d_ws, size_t ws_size, hipStream_t stream) {
    static int grid = 0;
    if (grid == 0) {
        if (n_in != 23 || ws_size < WS_END) { fprintf(stderr, "kernel_launch: bad inputs (n_in %d ws %zu need %zu)\n", n_in, ws_size, (size_t)WS_END); grid = -1; return; }
        int dev = 0, cus = 0, per_cu = 0;
        hipGetDevice(&dev); hipDeviceGetAttribute(&cus, hipDeviceAttributeMultiprocessorCount, dev);
        if (hipFuncSetAttribute((const void*)mega_kernel, hipFuncAttributeMaxDynamicSharedMemorySize, LDS_BYTES) != hipSuccess) { fprintf(stderr, "hipFuncSetAttribute failed\n"); grid = -1; return; }
        if (hipOccupancyMaxActiveBlocksPerMultiprocessor(&per_cu, (const void*)mega_kernel, NTHR, LDS_BYTES) != hipSuccess || per_cu < 1) per_cu = 1;
        (void)hipGetLastError();
        grid = cus * 1;
    }
    if (grid < 0) return;
    Params p{};
    p.x = (const float*)d_in[0]; p.c = (const float*)d_in[1]; p.pos = (const int*)d_in[2]; p.w_ada = (const float*)d_in[3]; p.b_ada = (const float*)d_in[4];
    p.norm_mix_w = (const float*)d_in[5]; p.norm_mlp_w = (const float*)d_in[6]; p.w_in = (const float*)d_in[7]; p.conv_qkv_w = (const float*)d_in[8];
    p.a_log = (const float*)d_in[9]; p.dt_bias = (const float*)d_in[10]; p.gdn_norm_w = (const float*)d_in[11]; p.conv_dw_w = (const float*)d_in[12]; p.conv_dw_b = (const float*)d_in[13];
    p.conv_ln_w = (const float*)d_in[14]; p.conv_ln_b = (const float*)d_in[15]; p.w_a = (const float*)d_in[16]; p.w_b = (const float*)d_in[17]; p.w_c = (const float*)d_in[18];
    p.w_out = (const float*)d_in[19]; p.w_mi = (const float*)d_in[20]; p.w_mo = (const float*)d_in[21]; p.final_w = (const float*)d_in[22];
    p.out = (float*)d_out; p.ws = (unsigned char*)d_ws;
#if ONE_LAUNCH
    p.ph_lo = 0; p.ph_hi = NPHASE;
    if (hipMemsetAsync((char*)d_ws + WS_BAR, 0, 32768, stream) != hipSuccess) { fprintf(stderr, "memset failed\n"); return; }
    void* args[] = {&p};
    hipError_t e = hipLaunchCooperativeKernel((const void*)mega_kernel, dim3(grid), dim3(NTHR), args, LDS_BYTES, stream);
    if (e != hipSuccess) fprintf(stderr, "cooperative launch failed: %s (grid %d)\n", hipGetErrorString(e), grid);
#else
    for (int ph = 0; ph < NPHASE; ++ph) { p.ph_lo = ph; p.ph_hi = ph + 1;
        hipLaunchKernelGGL(mega_kernel, dim3(grid), dim3(NTHR), LDS_BYTES, stream, p); }
#endif
}
```

```cpp
#include <hip/hip_runtime.h>
#include <hip/hip_cooperative_groups.h>
#include <cstdio>
namespace pg8 {
#define PG8_LAS __attribute__((address_space(3)))
typedef unsigned short bf16_t;
typedef short bf16x8 __attribute__((ext_vector_type(8)));
typedef float f32x4 __attribute__((ext_vector_type(4)));
typedef unsigned u32x4 __attribute__((ext_vector_type(4)));
constexpr int BM = 256, BK = 64, HALF = 128, HTB = HALF * BK * 2  , STAGE_BYTES = 8 * HTB, NXCD = 8, WGM = 8;

__host__ __device__ __forceinline__ int lds_byte(int r, int c) { const int st = (r >> 4) * 2 + (c >> 5), rr = r & 15, cc = c & 31, ob = rr * 64 + cc * 2; return st * 1024 + (ob ^ (((ob >> 9) & 1) << 5)); }
__host__ __device__ __forceinline__ void stage_rc(int b, int& R, int& C) { const int st = b / 1024, sb = b % 1024, swz = sb ^ (((sb >> 9) & 1) << 5); R = (st >> 1) * 16 + swz / 64; C = (st & 1) * 32 + (swz % 64) / 2; }
__host__ __device__ __forceinline__ int perm32(int rho) { const int n = rho >> 4, i = rho & 15; return 8 * (i >> 2) + 4 * n + (i & 3); }

struct Unit { int pm, pn; };
struct Gemm { const bf16_t* A; const bf16_t* Bt; int M, N, K; };

struct StaticOrder {
    int nM, nN, nwg, G, c;
    __host__ __device__ void init(int M, int N, int G_, int c_) { nM = M / BM; nN = N / BM; nwg = nM * nN; G = G_; c = c_; }
    __host__ __device__ bool next(int i, Unit& u) const {
        const long L = (long)i * G + c; if (L >= nwg) return false;
        int wgid = (int)L; { const int q = nwg / NXCD, r = nwg % NXCD, xcd = wgid % NXCD, off = wgid / NXCD; wgid = (xcd < r ? xcd * (q + 1) : r * (q + 1) + (xcd - r) * q) + off; }
        const int nig = WGM * nN, gid = wgid / nig, fm = gid * WGM, gsz = (nM - fm) < WGM ? (nM - fm) : WGM;
        u.pm = fm + ((wgid % nig) % gsz); u.pn = (wgid % nig) / gsz; return true;
    }
    __device__ __forceinline__ void a_ready(const Unit&) const {}
    __device__ __forceinline__ void done(const Unit&) const {}
};
typedef float f32x2c_ __attribute__((ext_vector_type(2)));
typedef __bf16 bf16x2c_ __attribute__((ext_vector_type(2)));
__device__ __forceinline__ unsigned cvt_pk_bf16(float lo, float hi) { const f32x2c_ v = {lo, hi}; const bf16x2c_ b = __builtin_convertvector(v, bf16x2c_); return __builtin_bit_cast(unsigned, b); }
typedef unsigned u32x2 __attribute__((ext_vector_type(2)));
__device__ __forceinline__ float bf_lo(unsigned w) { return __uint_as_float(w << 16); }
__device__ __forceinline__ float bf_hi(unsigned w) { return __uint_as_float(w & 0xffff0000u); }
__device__ __forceinline__ float sigmoidf_(float x) { return 1.0f / (1.0f + __expf(-x)); }

constexpr int PROJ_LD = 15360;

struct EpiProj {
    static constexpr bool PERM = true, AFTER_DRAIN = false;
    bf16_t* O; float* BA;
    __device__ __forceinline__ void operator()(const f32x4 (&acc)[2][2][4][2], const Unit& u, int wr, int wc, int fr, int fq) const {
        const int row0 = u.pm * BM + wr * 64 + fr;
        if (u.pn < 60) {
            const int col0 = u.pn * BM + wc * 32 + 8 * fq;
#pragma unroll
            for (int ai = 0; ai < 2; ++ai)
#pragma unroll
                for (int m = 0; m < 4; ++m) { bf16_t* rowp = O + (size_t)(row0 + ai * HALF + m * 16) * PROJ_LD + col0;
#pragma unroll
                    for (int bj = 0; bj < 2; ++bj) { const f32x4 v0 = acc[ai][bj][m][0], v1 = acc[ai][bj][m][1];
                        u32x4 w; w.x = cvt_pk_bf16(v0[0], v0[1]); w.y = cvt_pk_bf16(v0[2], v0[3]); w.z = cvt_pk_bf16(v1[0], v1[1]); w.w = cvt_pk_bf16(v1[2], v1[3]);
                        *(u32x4*)(rowp + bj * HALF) = w; } }
        } else {
            if (wc == 0 && fq < 2) {
#pragma unroll
                for (int ai = 0; ai < 2; ++ai)
#pragma unroll
                    for (int m = 0; m < 4; ++m) { float* rowp = BA + (size_t)(row0 + ai * HALF + m * 16) * 16 + 8 * fq;
#pragma unroll
                        for (int n = 0; n < 2; ++n) *(f32x4*)(rowp + 4 * n) = acc[ai][0][m][n]; }
            }
        }
    }
};
template <int PASS> struct EpiBranch {
    static constexpr bool PERM = false, AFTER_DRAIN = false;
    const bf16_t* PROJ; float* MF; bf16_t* MB;
    __device__ __forceinline__ void operator()(const f32x4 (&acc)[2][2][4][2], const Unit& u, int wr, int wc, int fr, int fq) const {
        const int row0 = u.pm * BM + wr * 64 + fr, col0 = u.pn * BM + wc * 32 + 4 * fq;
#pragma unroll
        for (int ai = 0; ai < 2; ++ai)
#pragma unroll
            for (int mp = 0; mp < 2; ++mp) {
                u32x2 gw[2][2][2]; f32x4 mv[2][2][2];
#pragma unroll
                for (int mm = 0; mm < 2; ++mm) { const size_t row = (size_t)(row0 + ai * HALF + (2 * mp + mm) * 16);
#pragma unroll
                    for (int bj = 0; bj < 2; ++bj)
#pragma unroll
                        for (int n = 0; n < 2; ++n) { const int col = col0 + bj * HALF + n * 16;
                            gw[mm][bj][n] = *(const u32x2*)(PROJ + row * PROJ_LD + 9216 + PASS * 2048 + col);
                            if (PASS > 0) mv[mm][bj][n] = *(const f32x4*)(MF + row * 2048 + col); } }
#pragma unroll
                for (int mm = 0; mm < 2; ++mm) { const int m = 2 * mp + mm; const size_t row = (size_t)(row0 + ai * HALF + m * 16);
#pragma unroll
                    for (int bj = 0; bj < 2; ++bj)
#pragma unroll
                        for (int n = 0; n < 2; ++n) { const int col = col0 + bj * HALF + n * 16; const u32x2 g2 = gw[mm][bj][n];
                            f32x4 g; g[0] = sigmoidf_(bf_lo(g2.x)); g[1] = sigmoidf_(bf_hi(g2.x)); g[2] = sigmoidf_(bf_lo(g2.y)); g[3] = sigmoidf_(bf_hi(g2.y));
                            f32x4 v = g * acc[ai][bj][m][n];
                            if (PASS > 0) v += mv[mm][bj][n];
                            if (PASS < 2) *(f32x4*)(MF + row * 2048 + col) = v;
                            else { u32x2 w; w.x = cvt_pk_bf16(v[0], v[1]); w.y = cvt_pk_bf16(v[2], v[3]); *(u32x2*)(MB + row * 2048 + col) = w; } } }
                asm volatile("" ::: "memory"); }
    }
};
struct EpiResid {
    static constexpr bool PERM = false, AFTER_DRAIN = false;
    const float* xin; float* xout; const float* gate;
    __device__ __forceinline__ void operator()(const f32x4 (&acc)[2][2][4][2], const Unit& u, int wr, int wc, int fr, int fq) const {
        const int row0 = u.pm * BM + wr * 64 + fr, col0 = u.pn * BM + wc * 32 + 4 * fq;
        f32x4 gv[2][2];
#pragma unroll
        for (int bj = 0; bj < 2; ++bj)
#pragma unroll
            for (int n = 0; n < 2; ++n) gv[bj][n] = *(const f32x4*)(gate + col0 + bj * HALF + n * 16);
#pragma unroll
        for (int ai = 0; ai < 2; ++ai)
#pragma unroll
            for (int mp = 0; mp < 2; ++mp) { f32x4 bv[2][2][2];
#pragma unroll
                for (int mm = 0; mm < 2; ++mm) { const size_t off = (size_t)(row0 + ai * HALF + (2 * mp + mm) * 16) * 2048 + col0;
#pragma unroll
                    for (int bj = 0; bj < 2; ++bj)
#pragma unroll
                        for (int n = 0; n < 2; ++n) bv[mm][bj][n] = *(const f32x4*)(xin + off + bj * HALF + n * 16); }
#pragma unroll
                for (int mm = 0; mm < 2; ++mm) { const int m = 2 * mp + mm; const size_t off = (size_t)(row0 + ai * HALF + m * 16) * 2048 + col0;
#pragma unroll
                    for (int bj = 0; bj < 2; ++bj)
#pragma unroll
                        for (int n = 0; n < 2; ++n) *(f32x4*)(xout + off + bj * HALF + n * 16) = bv[mm][bj][n] + gv[bj][n] * acc[ai][bj][m][n]; }
                asm volatile("" ::: "memory"); }
    }
};
struct EpiRelu2 {
    static constexpr bool PERM = true, AFTER_DRAIN = false;
    bf16_t* O;
    __device__ __forceinline__ void operator()(const f32x4 (&acc)[2][2][4][2], const Unit& u, int wr, int wc, int fr, int fq) const {
        const int row0 = u.pm * BM + wr * 64 + fr, col0 = u.pn * BM + wc * 32 + 8 * fq;
#pragma unroll
        for (int ai = 0; ai < 2; ++ai)
#pragma unroll
            for (int m = 0; m < 4; ++m) { bf16_t* rowp = O + (size_t)(row0 + ai * HALF + m * 16) * 8192 + col0;
#pragma unroll
                for (int bj = 0; bj < 2; ++bj) { f32x4 v0 = acc[ai][bj][m][0], v1 = acc[ai][bj][m][1];
#pragma unroll
                    for (int j = 0; j < 4; ++j) { const float a = fmaxf(v0[j], 0.f), b = fmaxf(v1[j], 0.f); v0[j] = a * a; v1[j] = b * b; }
                    u32x4 w; w.x = cvt_pk_bf16(v0[0], v0[1]); w.y = cvt_pk_bf16(v0[2], v0[3]); w.z = cvt_pk_bf16(v1[0], v1[1]); w.w = cvt_pk_bf16(v1[2], v1[3]);
                    *(u32x4*)(rowp + bj * HALF) = w; } }
    }
};

template <class Epi, class Sched, bool STAMP = false>
__device__ __forceinline__ void gemm_phase(PG8_LAS unsigned char* lds, const Gemm g, const Sched& S, const Epi& E, unsigned long long* stamps) {
    int tid = threadIdx.x; asm volatile("" : "+v"(tid));
    const int wid = __builtin_amdgcn_readfirstlane(tid >> 6), lane = tid & 63, wr = wid >> 2, wc = wid & 3, fr = lane & 15, fq = lane >> 4;
    const int K = g.K, nt = K / BK;
    int ts_lo = 0, ts_hi = 0, nts = 0; const unsigned long long rt_entry = STAMP ? (unsigned long long)wall_clock64() : 0ull;
#define PG8_STAMP() do { if (STAMP && wid == 0 && nts < 64) { const unsigned long long _c = (unsigned long long)clock64(); \
        ts_lo = (lane == nts) ? (int)(unsigned)_c : ts_lo; ts_hi = (lane == nts) ? (int)(unsigned)(_c >> 32) : ts_hi; ++nts; } } while (0)
    PG8_STAMP();
    unsigned voffA[2], voffB[2];
#pragma unroll
    for (int i = 0; i < 2; ++i) { int R, C; stage_rc(tid * 16 + i * 8192, R, C); const int Rb = Epi::PERM ? ((R & ~31) + perm32(R & 31)) : R;
        voffA[i] = (unsigned)(R * K + C) * 2u; voffB[i] = (unsigned)(Rb * K + C) * 2u; }
    const size_t kstep = (size_t)(BK * 2);
    const size_t hstep = (size_t)HALF * K * 2;
    const size_t tstep = 2 * hstep;
    const unsigned ldsw = (unsigned)wid * 1024u;
    const int aoff = lds_byte(wr * 64 + fr, fq * 8), boff = lds_byte(wc * 32 + fr, fq * 8);
#define PG8_SA(b, h) (((b) * 2 + (h)) * HTB)
#define PG8_SB(b, h) ((4 + (b) * 2 + (h)) * HTB)
#define PG8_STAGE(bufoff, gbase, voff) do { _Pragma("unroll") for (int _i = 0; _i < 2; ++_i) \
        __builtin_amdgcn_global_load_lds((const unsigned*)((const char*)(gbase) + (voff)[_i]), (PG8_LAS unsigned*)(lds + (bufoff) + ldsw + _i * 8192), 16, 0, 0); } while (0)
#define PG8_LDA(dst, b, h) do { _Pragma("unroll") for (int m = 0; m < 4; ++m) _Pragma("unroll") for (int k = 0; k < 2; ++k) dst[m][k] = *(const PG8_LAS bf16x8*)(lds + PG8_SA(b, h) + aoff + m * 2048 + k * 1024); } while (0)
#define PG8_LDB(dst, b, h) do { _Pragma("unroll") for (int n = 0; n < 2; ++n) _Pragma("unroll") for (int k = 0; k < 2; ++k) dst[n][k] = *(const PG8_LAS bf16x8*)(lds + PG8_SB(b, h) + boff + n * 2048 + k * 1024); } while (0)
#define PG8_MMA(ai, bj, At, Bt) do { __builtin_amdgcn_s_setprio(1); _Pragma("unroll") for (int m = 0; m < 4; ++m) _Pragma("unroll") for (int n = 0; n < 2; ++n) _Pragma("unroll") for (int k = 0; k < 2; ++k) \
        acc[ai][bj][m][n] = __builtin_amdgcn_mfma_f32_16x16x32_bf16(Bt[n][k], At[m][k], acc[ai][bj][m][n], 0, 0, 0); __builtin_amdgcn_s_setprio(0); } while (0)
#define PG8_WAIT_V(n) asm volatile("s_waitcnt vmcnt(" #n ")" ::: "memory")
#define PG8_WAIT_L(n) asm volatile("s_waitcnt lgkmcnt(" #n ")" ::: "memory")
#define PG8_BAR __builtin_amdgcn_s_barrier()
#define PG8_SCHED __builtin_amdgcn_sched_barrier(0)
    Unit cur, nxt; int ui = 0;
    if (!S.next(0, cur)) return;
    f32x4 acc[2][2][4][2];
#pragma unroll
    for (int a = 0; a < 2; ++a)
#pragma unroll
        for (int b = 0; b < 2; ++b)
#pragma unroll
            for (int m = 0; m < 4; ++m)
#pragma unroll
                for (int n = 0; n < 2; ++n) acc[a][b][m][n] = (f32x4){0.f, 0.f, 0.f, 0.f};
    bf16x8 At[4][2], B0[2][2], B1[2][2];
    const char* cA = (const char*)g.A + (size_t)cur.pm * tstep; const char* cB = (const char*)g.Bt + (size_t)cur.pn * tstep;
    S.a_ready(cur);
    PG8_STAGE(PG8_SB(0, 0), cB, voffB); PG8_STAGE(PG8_SA(0, 0), cA, voffA); PG8_STAGE(PG8_SB(0, 1), cB + hstep, voffB); PG8_STAGE(PG8_SA(0, 1), cA + hstep, voffA);
    if (wr == 1) PG8_BAR;
    PG8_WAIT_V(4); PG8_BAR;
    PG8_STAGE(PG8_SB(1, 0), cB + kstep, voffB); PG8_STAGE(PG8_SA(1, 0), cA + kstep, voffA); PG8_STAGE(PG8_SB(1, 1), cB + hstep + kstep, voffB);
    PG8_WAIT_V(6); PG8_BAR;
    PG8_STAMP();
    for (;;) {
        const bool has_next = S.next(ui + 1, nxt);
        const char* nA = has_next ? (const char*)g.A + (size_t)nxt.pm * tstep : cA; const char* nB = has_next ? (const char*)g.Bt + (size_t)nxt.pn * tstep : cB;
        for (int t = 0; t < nt; t += 2) {
            const bool last = (t == nt - 2);
            const char* a1 = cA + (size_t)(t + 1) * kstep;
            const char* a2 = last ? nA : cA + (size_t)(t + 2) * kstep; const char* b2 = last ? nB : cB + (size_t)(t + 2) * kstep;
            const char* a3 = a2 + kstep; const char* b3 = b2 + kstep;
            if (last && has_next) S.a_ready(nxt);
            PG8_LDB(B0, 0, 0); PG8_SCHED; PG8_LDA(At, 0, 0); PG8_STAGE(PG8_SA(1, 1), a1 + hstep, voffA);
            PG8_WAIT_L(8); PG8_BAR; PG8_WAIT_L(0); PG8_MMA(0, 0, At, B0); PG8_BAR; PG8_SCHED;
            PG8_LDB(B1, 0, 1); PG8_STAGE(PG8_SB(0, 0), b2, voffB);
            PG8_BAR; PG8_WAIT_L(0); PG8_MMA(0, 1, At, B1); PG8_BAR;
            PG8_LDA(At, 0, 1); PG8_STAGE(PG8_SA(0, 0), a2, voffA);
            PG8_BAR; PG8_WAIT_L(0); PG8_MMA(1, 0, At, B0); PG8_BAR; PG8_SCHED;
            PG8_STAGE(PG8_SB(0, 1), b2 + hstep, voffB);
            PG8_WAIT_V(6); PG8_BAR; PG8_MMA(1, 1, At, B1); PG8_BAR;
            PG8_LDB(B0, 1, 0); PG8_SCHED; PG8_LDA(At, 1, 0); PG8_STAGE(PG8_SA(0, 1), a2 + hstep, voffA);
            PG8_WAIT_L(8); PG8_BAR; PG8_WAIT_L(0); PG8_MMA(0, 0, At, B0); PG8_BAR; PG8_SCHED;
            PG8_LDB(B1, 1, 1); PG8_STAGE(PG8_SB(1, 0), b3, voffB);
            PG8_BAR; PG8_WAIT_L(0); PG8_MMA(0, 1, At, B1); PG8_BAR;
            PG8_LDA(At, 1, 1); PG8_STAGE(PG8_SA(1, 0), a3, voffA);
            PG8_BAR; PG8_WAIT_L(0); PG8_MMA(1, 0, At, B0); PG8_BAR; PG8_SCHED;
            PG8_STAGE(PG8_SB(1, 1), b3 + hstep, voffB);
            PG8_WAIT_V(6); PG8_BAR; PG8_MMA(1, 1, At, B1); PG8_BAR;
        }
        PG8_STAMP();
        if constexpr (!Epi::AFTER_DRAIN) { E(acc, cur, wr, wc, fr, fq); S.done(cur); }
        PG8_STAMP();
        if (!has_next) break;
#pragma unroll
        for (int a = 0; a < 2; ++a)
#pragma unroll
            for (int b = 0; b < 2; ++b)
#pragma unroll
                for (int m = 0; m < 4; ++m)
#pragma unroll
                    for (int n = 0; n < 2; ++n) acc[a][b][m][n] = (f32x4){0.f, 0.f, 0.f, 0.f};
        cur = nxt; cA = nA; cB = nB; ++ui;
    }
    PG8_WAIT_V(0);
    if (wr == 0) PG8_BAR;
    PG8_BAR;
    if constexpr (Epi::AFTER_DRAIN) { E.fused(acc, cur, wr, wc, fr, fq, lds, wid, lane); S.done(cur); }
    PG8_STAMP();
    if (STAMP && wid == 0) { stamps[lane] = lane < nts ? (((unsigned long long)(unsigned)ts_hi << 32) | (unsigned)ts_lo) : 0ull;
        if (lane == 62) stamps[62] = rt_entry; if (lane == 63) stamps[63] = (unsigned long long)wall_clock64(); }
#undef PG8_STAMP
#undef PG8_SA
#undef PG8_SB
#undef PG8_STAGE
#undef PG8_LDA
#undef PG8_LDB
#undef PG8_MMA
#undef PG8_WAIT_V
#undef PG8_WAIT_L
#undef PG8_BAR
#undef PG8_SCHED
}
}
using namespace pg8;
namespace cg = cooperative_groups;
#define LAS PG8_LAS
#define DI __device__ __forceinline__

constexpr int T_ = 8192, D_ = 2048, INW = 15376, NP1 = 15616, DFF = 8192;
constexpr int LDS_BYTES = 147456;
constexpr int NTHR = 512;
constexpr float EPS = 1e-6f;

constexpr size_t SZ_WT_IN = (size_t)NP1 * 2048 * 2, SZ_WT_BR = (size_t)2048 * 1024 * 2, SZ_WT_O = (size_t)2048 * 2048 * 2, SZ_WT_M = (size_t)8192 * 2048 * 2;
constexpr size_t SZ_WL = SZ_WT_IN + 3 * SZ_WT_BR + SZ_WT_O + 2 * SZ_WT_M;
constexpr size_t WS_W = 0;
constexpr size_t WS_MOD = WS_W + 2 * SZ_WL;
constexpr size_t WS_XC = WS_MOD + 2 * 12288 * 4;
constexpr size_t WS_H = WS_XC + (size_t)T_ * D_ * 4;
constexpr size_t WS_PROJ = WS_H + (size_t)T_ * D_ * 2;
constexpr size_t WS_BA = WS_PROJ + (size_t)T_ * 15360 * 2;
constexpr size_t WS_R2 = WS_BA + (size_t)T_ * 16 * 4;
constexpr size_t G_A = WS_R2;
constexpr size_t G_BT = G_A + (size_t)T_ * 2048 * 2;
constexpr size_t G_C = G_BT + (size_t)T_ * 2048 * 2;
constexpr size_t G_D = G_C + (size_t)T_ * 1024 * 2;
constexpr size_t G_GL = G_D + (size_t)T_ * 1024 * 2;
constexpr size_t R_SC = G_GL + 4096;
constexpr size_t R_QI = R_SC + (size_t)T_ * 256 * 2;
constexpr size_t R_VT = R_QI + (size_t)T_ * 512 * 2;
constexpr size_t WS_R3 = R_VT + (size_t)T_ * 1024 * 2;
constexpr size_t WS_OA = WS_R3;
constexpr size_t WS_OB = WS_OA + (size_t)T_ * 1024 * 4;
constexpr size_t WS_CV = WS_OB + (size_t)T_ * 1024 * 4;
constexpr size_t WS_ACT = WS_CV + (size_t)T_ * 1024 * 4;
constexpr size_t WS_MB = WS_ACT + 3 * (size_t)T_ * 1024 * 2;
constexpr size_t WS_BAR = WS_MB + (size_t)T_ * D_ * 2;
constexpr size_t WS_PROG = WS_BAR + 16384;
constexpr size_t WS_END = WS_PROG + 16384;
constexpr size_t R_P = WS_OA;
constexpr size_t G_S = WS_H;
constexpr size_t R_RT = WS_MB;
constexpr size_t WS_MF = WS_R2;
static_assert(WS_MF + (size_t)T_ * D_ * 4 <= WS_R3, "merged f32 alias");

struct Params {
    const float* x; const float* c; const int* pos; const float* w_ada; const float* b_ada; const float* norm_mix_w; const float* norm_mlp_w; const float* w_in;
    const float* conv_qkv_w; const float* a_log; const float* dt_bias; const float* gdn_norm_w; const float* conv_dw_w; const float* conv_dw_b; const float* conv_ln_w; const float* conv_ln_b;
    const float* w_a; const float* w_b; const float* w_c; const float* w_out; const float* w_mi; const float* w_mo; const float* final_w;
    float* out; unsigned char* ws; int ph_lo, ph_hi;
};

DI unsigned pk2(float lo, float hi) { return cvt_pk_bf16(lo, hi); }
DI bf16_t f2bf(float f) { return (bf16_t)(cvt_pk_bf16(f, 0.f) & 0xffffu); }
DI float siluf_(float x) { return x / (1.0f + __expf(-x)); }
DI float ret_lg2(int hr) { return hr == 0 ? -0.04580368961312479f : hr == 1 ? -0.02272007650008353f : hr == 2 ? -0.011315313227834146f : -0.005646563141142063f; }
DI float wave_sum(float v) {
#pragma unroll
    for (int o = 1; o < 64; o <<= 1) v += __shfl_xor(v, o);
    return v;
}
DI void lds_barrier() { asm volatile("s_waitcnt lgkmcnt(0)" ::: "memory"); __builtin_amdgcn_s_barrier(); asm volatile("" ::: "memory"); }
DI void full_barrier() { asm volatile("s_waitcnt vmcnt(0) lgkmcnt(0)" ::: "memory"); __builtin_amdgcn_s_barrier(); asm volatile("" ::: "memory"); }
DI f32x4 mfma16(bf16x8 a, bf16x8 b, f32x4 c) { return __builtin_amdgcn_mfma_f32_16x16x32_bf16(a, b, c, 0, 0, 0); }
DI bf16x8 lds_frag(LAS unsigned char* base, int row, int stride_el, int k0) { return *(const LAS bf16x8*)(base + ((size_t)row * stride_el + k0) * 2); }
DI void unpack8(const u32x4 w, float (&f)[8]) { f[0] = bf_lo(w.x); f[1] = bf_hi(w.x); f[2] = bf_lo(w.y); f[3] = bf_hi(w.y); f[4] = bf_lo(w.z); f[5] = bf_hi(w.z); f[6] = bf_lo(w.w); f[7] = bf_hi(w.w); }
DI u32x4 pack8(const float* f) { u32x4 w; w.x = pk2(f[0], f[1]); w.y = pk2(f[2], f[3]); w.z = pk2(f[4], f[5]); w.w = pk2(f[6], f[7]); return w; }

#define XB_TMO      128
#define XB_XCNT(j)  (256  + 64 * (j))
#define XB_XSUB(j)  (1280 + 64 * (j))
#define XB_XGEN(j)  (2304 + 64 * (j))
#define XB_TOP      3328
#define XB_TOPGEN   3392
#define XCD_BAR_WORDS 3456
#define XB_SPIN_CAP (1u << 18)


__device__ __forceinline__ unsigned xb_ld(unsigned* p)              { return __hip_atomic_load(p, __ATOMIC_RELAXED, __HIP_MEMORY_SCOPE_AGENT); }
__device__ __forceinline__ unsigned xb_add(unsigned* p, unsigned v) { return __hip_atomic_fetch_add(p, v, __ATOMIC_RELAXED, __HIP_MEMORY_SCOPE_AGENT); }
__device__ __forceinline__ unsigned xb_xcc_id() { return (unsigned)__builtin_amdgcn_s_getreg((3 << 11) | 20) & 0xFu; }
#define XB_SPIN(cond, bar) do { unsigned _sp = 0; while (cond) { __builtin_amdgcn_s_sleep(1); \
    if ((++_sp & 255u) == 0u) { if (xb_ld(&(bar)[XB_TMO])) break; if (_sp > XB_SPIN_CAP) { atomicAdd(&(bar)[XB_TMO], 1u); break; } } } } while (0)

struct XcdBarrier {
    unsigned* bar; unsigned x;
    volatile LAS unsigned* st;
};

__device__ __forceinline__ XcdBarrier xcd_barrier_post(unsigned* bar, volatile LAS unsigned* st) {
    XcdBarrier b; b.bar = bar; b.x = xb_xcc_id(); b.st = st;
    if (threadIdx.x == 0) (void)xb_add(&bar[XB_XCNT(b.x)], 1u);
    return b;
}
__device__ __forceinline__ void xcd_barrier_complete(unsigned* bar, unsigned x, unsigned& nloc, unsigned& nx) {
    const unsigned G = gridDim.x * gridDim.y * gridDim.z;
    unsigned sum, cnt, mine, sp = 0u;
    for (;;) {
        sum = 0u; cnt = 0u; mine = 0u;
#pragma unroll
        for (unsigned j = 0; j < 16; ++j) { const unsigned c = xb_ld(&bar[XB_XCNT(j)]); sum += c; cnt += (c > 0u) ? 1u : 0u; mine = (j == x) ? c : mine; }
        if (sum == G) break;
        __builtin_amdgcn_s_sleep(1);
        if ((++sp & 255u) == 0u) { if (xb_ld(&bar[XB_TMO])) break; if (sp > XB_SPIN_CAP) { atomicAdd(&bar[XB_TMO], 1u); break; } }
    }
    nloc = mine > 0u ? mine : 1u; nx = cnt > 0u ? cnt : 1u;
}

__device__ __forceinline__ void xcd_barrier(const XcdBarrier& b) {
    asm volatile("s_waitcnt vmcnt(0)" ::: "memory");
    __syncthreads();
    if (threadIdx.x == 0) {
        unsigned* bar = b.bar;
        __builtin_amdgcn_s_waitcnt(0);
        unsigned nloc = b.st[0], nx = b.st[1];
        if (nloc == 0u) { xcd_barrier_complete(bar, b.x, nloc, nx); b.st[0] = nloc; b.st[1] = nx; }
        const unsigned old = xb_add(&bar[XB_XSUB(b.x)], 1u);
        const unsigned gen = old / nloc;
        if (old + 1u == (gen + 1u) * nloc) {
            __builtin_amdgcn_fence(__ATOMIC_RELEASE, "agent");
            asm volatile("s_waitcnt vmcnt(0)" ::: "memory");
            const unsigned og = xb_add(&bar[XB_TOP], 1u);
            const unsigned tg = og / nx;
            if (og + 1u == (tg + 1u) * nx) xb_add(&bar[XB_TOPGEN], 1u);
            else XB_SPIN(xb_ld(&bar[XB_TOPGEN]) == tg, bar);
            __builtin_amdgcn_fence(__ATOMIC_ACQUIRE, "agent");
            xb_add(&bar[XB_XGEN(b.x)], 1u);
            asm volatile("s_waitcnt vmcnt(0)" ::: "memory");
        } else {
            XB_SPIN(xb_ld(&bar[XB_XGEN(b.x)]) == gen, bar);
            __builtin_amdgcn_fence(__ATOMIC_ACQUIRE, "agent");
            asm volatile("s_waitcnt vmcnt(0)" ::: "memory");
        }
    }
    __syncthreads();
}


DI void transpose_item(const float* W, int ldw, int K, int src_col0, int valid, bf16_t* WT, int dst_row0, int k0, LAS float* scr, int lane) {
    const int nn = lane & 31;
    float tv[64];
#pragma unroll
    for (int i = 0; i < 64; ++i) { const int kk = 2 * i + (lane >> 5);
        tv[i] = 0.f; if (nn < valid) tv[i] = W[(size_t)(k0 + kk) * ldw + src_col0 + nn]; }
#pragma unroll
    for (int i = 0; i < 64; ++i) { const int kk = 2 * i + (lane >> 5); scr[kk * 33 + nn] = tv[i]; }
    asm volatile("s_waitcnt lgkmcnt(0)" ::: "memory");
    const int c = lane & 15;
#pragma unroll
    for (int j = 0; j < 8; ++j) { const int n = (lane >> 4) + 4 * j; const LAS float* s = scr + (8 * c) * 33 + n;
        u32x4 o; o.x = pk2(s[0 * 33], s[1 * 33]); o.y = pk2(s[2 * 33], s[3 * 33]); o.z = pk2(s[4 * 33], s[5 * 33]); o.w = pk2(s[6 * 33], s[7 * 33]);
        *(u32x4*)(WT + (size_t)(dst_row0 + n) * K + k0 + 8 * c) = o; }
    asm volatile("s_waitcnt lgkmcnt(0)" ::: "memory");
}

DI void phase_prep(const Params& p, unsigned char* wsp, LAS unsigned char* lds, int tid) {
    const int lane = tid & 63, wave = tid >> 6, G = gridDim.x, b = blockIdx.x;
    float* mod = (float*)(wsp + WS_MOD);
    for (int u = b; u < 192; u += G) {
        const int l = u / 96, strip = u % 96, kg = tid >> 5, cl = tid & 31, col = 128 * strip + 4 * cl;
        f32x4 acc = {0.f, 0.f, 0.f, 0.f};
        const float* wp = p.w_ada + (size_t)l * 2048 * 12288 + col;
#pragma unroll 16
        for (int k = kg; k < 2048; k += 16) { const float s = siluf_(p.c[k]); const f32x4 w = *(const f32x4*)(wp + (size_t)k * 12288); acc += s * w; }
        LAS f32x4* red = (LAS f32x4*)lds;
        red[kg * 32 + cl] = acc;
        lds_barrier();
        if (tid < 128) { float s = 0.f; const LAS float* rf = (const LAS float*)lds;
#pragma unroll
            for (int g = 0; g < 16; ++g) s += rf[g * 128 + tid];
            mod[l * 12288 + 128 * strip + tid] = s + p.b_ada[l * 12288 + 128 * strip + tid]; }
        lds_barrier();
    }
    LAS float* scr = (LAS float*)(lds + wave * 17408);
    const int gw = b * 8 + wave, NGW = G * 8;
    constexpr int I_IN = 488 * 16, I_BR = 64 * 8, I_O = 64 * 16, I_MI = 256 * 16, I_MO = 64 * 64, I_L = I_IN + 3 * I_BR + I_O + I_MI + I_MO;
    for (int it = gw; it < 2 * I_L; it += NGW) {
        const int l = it / I_L; int r = it % I_L;
        unsigned char* wl = wsp + WS_W + (size_t)l * SZ_WL;
        if (r < I_IN) { const int kb = r / 488, nb = r % 488, d0 = 32 * nb; int src, valid;
            if (d0 < 4096) { src = d0; valid = 32; } else if (d0 < 15360) { src = d0 + 16; valid = 32; } else if (d0 == 15360) { src = 4096; valid = 16; } else { src = 0; valid = 0; }
            transpose_item(p.w_in + (size_t)l * 2048 * INW, INW, 2048, src, valid, (bf16_t*)wl, d0, 128 * kb, scr, lane); continue; }
        r -= I_IN;
        if (r < 3 * I_BR) { const int which = r / I_BR, q = r % I_BR, kb = q / 64, nb = q % 64;
            const float* W = (which == 0 ? p.w_a : which == 1 ? p.w_b : p.w_c) + (size_t)l * 1024 * 2048;
            transpose_item(W, 2048, 1024, 32 * nb, 32, (bf16_t*)(wl + SZ_WT_IN + which * SZ_WT_BR), 32 * nb, 128 * kb, scr, lane); continue; }
        r -= 3 * I_BR;
        if (r < I_O) { const int kb = r / 64, nb = r % 64;
            transpose_item(p.w_out + (size_t)l * 2048 * 2048, 2048, 2048, 32 * nb, 32, (bf16_t*)(wl + SZ_WT_IN + 3 * SZ_WT_BR), 32 * nb, 128 * kb, scr, lane); continue; }
        r -= I_O;
        if (r < I_MI) { const int kb = r / 256, nb = r % 256;
            transpose_item(p.w_mi + (size_t)l * 2048 * 8192, 8192, 2048, 32 * nb, 32, (bf16_t*)(wl + SZ_WT_IN + 3 * SZ_WT_BR + SZ_WT_O), 32 * nb, 128 * kb, scr, lane); continue; }
        r -= I_MI;
        { const int kb = r / 64, nb = r % 64;
            transpose_item(p.w_mo + (size_t)l * 8192 * 2048, 2048, 8192, 32 * nb, 32, (bf16_t*)(wl + SZ_WT_IN + 3 * SZ_WT_BR + SZ_WT_O + SZ_WT_M), 32 * nb, 128 * kb, scr, lane); }
    }
}

DI void phase_norm(const float* xin, const float* nw, const float* scale, const float* shift, bf16_t* H, float* outf, int tid) {
    const int lane = tid & 63, wave = tid >> 6, gw = blockIdx.x * 8 + wave, NGW = gridDim.x * 8;
    for (int row0 = gw; row0 < T_; row0 += 2 * NGW) {
        const int row1 = (row0 + NGW < T_) ? row0 + NGW : row0;
        f32x4 v[2][8]; float ss[2] = {0.f, 0.f};
#pragma unroll
        for (int r = 0; r < 2; ++r) { const float* xr = xin + (size_t)(r ? row1 : row0) * D_;
#pragma unroll
            for (int j = 0; j < 8; ++j) v[r][j] = *(const f32x4*)(xr + (j * 64 + lane) * 4); }
#pragma unroll
        for (int r = 0; r < 2; ++r) {
#pragma unroll
            for (int j = 0; j < 8; ++j) ss[r] += (v[r][j][0] * v[r][j][0] + v[r][j][1] * v[r][j][1]) + (v[r][j][2] * v[r][j][2] + v[r][j][3] * v[r][j][3]);
            ss[r] = wave_sum(ss[r]); }
#pragma unroll
        for (int r = 0; r < 2; ++r) { const int row = r ? row1 : row0; if (r == 1 && row1 == row0) break;
            const float rstd = 1.0f / sqrtf(ss[r] * (1.0f / D_) + EPS);
#pragma unroll
            for (int j = 0; j < 8; ++j) { const int c = (j * 64 + lane) * 4; const f32x4 w = *(const f32x4*)(nw + c);
                f32x4 y = v[r][j] * rstd * w;
                if (H) { const f32x4 sc = *(const f32x4*)(scale + c), sh = *(const f32x4*)(shift + c); y = y * (1.0f + sc) + sh;
                    u32x2 o; o.x = pk2(y[0], y[1]); o.y = pk2(y[2], y[3]); *(u32x2*)(H + (size_t)row * D_ + c) = o; }
                else *(f32x4*)(outf + (size_t)row * D_ + c) = y; } }
    }
}

DI void gdn_prep_unit(const Params& p, unsigned char* wsp, int l, int hh, int n, LAS unsigned char* lds, int tid) {
    asm volatile("" : "+v"(tid));
    const int lane = tid & 63, wave = tid >> 6, quad = lane >> 4, l15 = lane & 15;
    const int r = tid >> 3, cgp = tid & 7, t = 64 * n + r;
    constexpr int K_OFF = 0, KB_OFF = 17408, Q_OFF = 34816, VBT_OFF = 52224, KBGT_OFF = 70656, KDT_OFF = 89088, T_OFF = 107520, L_OFF = 116736, SG_OFF = 134144, SB_OFF = SG_OFF + 256, GC_OFF = SB_OFF + 256;
    constexpr int ATTI_OFF = 135168, WT_OFF = K_OFF, UT_OFF = KB_OFF;
    static_assert(ATTI_OFF + 9216 <= LDS_BYTES - 16, "lds");
    const bf16_t* PROJ = (const bf16_t*)(wsp + WS_PROJ); const float* BA = (const float*)(wsp + WS_BA);
    const size_t ub = (size_t)hh * 128 + n;
    u32x4 pa[3][4][2];
#pragma unroll
    for (int X = 0; X < 3; ++X) { const int ch = X * 1024 + hh * 128 + 16 * cgp;
#pragma unroll
        for (int j = 0; j < 4; ++j) { const int tt = t - 3 + j; pa[X][j][0] = (u32x4){0u, 0u, 0u, 0u}; pa[X][j][1] = (u32x4){0u, 0u, 0u, 0u};
            if (tt >= 0) { pa[X][j][0] = *(const u32x4*)(PROJ + (size_t)tt * PROJ_LD + ch); pa[X][j][1] = *(const u32x4*)(PROJ + (size_t)tt * PROJ_LD + ch + 8); } } }
    float ba_b = 0.f, ba_a = 0.f;
    if (cgp == 0) { ba_b = BA[(size_t)t * 16 + hh]; ba_a = BA[(size_t)t * 16 + 8 + hh]; }
    {   LAS float* CW = (LAS float*)lds;
#pragma unroll
        for (int i = 0; i < 3; ++i) { const int f = tid + 512 * i, X = f >> 9, j = (f >> 7) & 3, c = f & 127;
            CW[f] = p.conv_qkv_w[((size_t)l * 4 + j) * 3072 + X * 1024 + hh * 128 + c]; } }
    lds_barrier();
    float val[3][16];
#pragma unroll
    for (int X = 0; X < 3; ++X) {
#pragma unroll
        for (int i = 0; i < 16; ++i) val[X][i] = 0.f;
#pragma unroll
        for (int j = 0; j < 4; ++j) { float xa[8], xb[8]; unpack8(pa[X][j][0], xa); unpack8(pa[X][j][1], xb);
            const LAS float* cw = (const LAS float*)lds + X * 512 + j * 128 + 16 * cgp;
#pragma unroll
            for (int q4 = 0; q4 < 4; ++q4) { const f32x4 w = *(const LAS f32x4*)(cw + 4 * q4);
#pragma unroll
                for (int e = 0; e < 4; ++e) { const int i = 4 * q4 + e; val[X][i] += w[e] * (i < 8 ? xa[i] : xb[i - 8]); } } }
#pragma unroll
        for (int i = 0; i < 16; ++i) val[X][i] = siluf_(val[X][i]);
    }
    {   float sq = 0.f, sk = 0.f;
#pragma unroll
        for (int i = 0; i < 16; ++i) { sq += val[0][i] * val[0][i]; sk += val[1][i] * val[1][i]; }
        sq += __shfl_xor(sq, 1); sq += __shfl_xor(sq, 2); sq += __shfl_xor(sq, 4);
        sk += __shfl_xor(sk, 1); sk += __shfl_xor(sk, 2); sk += __shfl_xor(sk, 4);
        const float rq = (1.0f / sqrtf(sq + 1e-6f)) * 0.08838834764831845f, rk = 1.0f / sqrtf(sk + 1e-6f);
#pragma unroll
        for (int i = 0; i < 16; ++i) { val[0][i] *= rq; val[1][i] *= rk; }
    }
    LAS float* SG = (LAS float*)(lds + SG_OFF); LAS float* SB = (LAS float*)(lds + SB_OFF); LAS float* GC = (LAS float*)(lds + GC_OFF);
    if (cgp == 0) { const float ab = ba_b, aa = ba_a;
        const float xx = aa + p.dt_bias[l * 8 + hh]; const float sp = xx > 20.f ? xx : __logf(1.0f + __expf(xx));
        SG[r] = -expf(p.a_log[l * 8 + hh]) * sp; SB[r] = 1.0f / (1.0f + expf(-ab)); }
    lds_barrier();
    if (wave == 0) { float xg = SG[lane];
#pragma unroll
        for (int o = 1; o < 64; o <<= 1) { const float y = __shfl_up(xg, o); if (lane >= o) xg += y; }
        GC[lane] = xg; }
    lds_barrier();
    {   const float bta = SB[r], gcr = GC[r], glast = GC[63], eg = expf(gcr), ekd = expf(glast - gcr);
        float tq[16], tk[16], tkb[16];
#pragma unroll
        for (int i = 0; i < 16; ++i) { tq[i] = val[0][i]; tk[i] = val[1][i]; tkb[i] = val[1][i] * bta; }
        *(LAS u32x4*)(lds + K_OFF + (r * 136 + 16 * cgp) * 2) = pack8(tk); *(LAS u32x4*)(lds + K_OFF + (r * 136 + 16 * cgp + 8) * 2) = pack8(tk + 8);
        *(LAS u32x4*)(lds + KB_OFF + (r * 136 + 16 * cgp) * 2) = pack8(tkb); *(LAS u32x4*)(lds + KB_OFF + (r * 136 + 16 * cgp + 8) * 2) = pack8(tkb + 8);
        *(LAS u32x4*)(lds + Q_OFF + (r * 136 + 16 * cgp) * 2) = pack8(tq); *(LAS u32x4*)(lds + Q_OFF + (r * 136 + 16 * cgp + 8) * 2) = pack8(tq + 8);
#pragma unroll
        for (int i = 0; i < 16; ++i) { const int e = 16 * cgp + i;
            *(LAS bf16_t*)(lds + VBT_OFF + (e * 72 + r) * 2) = f2bf(val[2][i] * bta);
            *(LAS bf16_t*)(lds + KBGT_OFF + (e * 72 + r) * 2) = f2bf(tkb[i] * eg);
            *(LAS bf16_t*)(lds + KDT_OFF + (e * 72 + r) * 2) = f2bf(tk[i] * ekd); }
        if (tid == 0) ((float*)(wsp + G_GL))[ub] = expf(glast);
    }
    lds_barrier();
    LAS float* Lm = (LAS float*)(lds + L_OFF);
#pragma unroll
    for (int tt = 0; tt < 2; ++tt) { const int id = 2 * wave + tt, mi = id >> 2, ni = id & 3;
        f32x4 aK = {0.f, 0.f, 0.f, 0.f}, aA = {0.f, 0.f, 0.f, 0.f};
#pragma unroll
        for (int ks = 0; ks < 4; ++ks) { const bf16x8 kf = lds_frag(lds + K_OFF, 16 * ni + l15, 136, 32 * ks + 8 * quad);
            const bf16x8 kbf = lds_frag(lds + KB_OFF, 16 * mi + l15, 136, 32 * ks + 8 * quad), qf = lds_frag(lds + Q_OFF, 16 * mi + l15, 136, 32 * ks + 8 * quad);
            aK = mfma16(kbf, kf, aK);
            aA = mfma16(kf, qf, aA); }
        { const int s = 16 * ni + l15; const float gs = GC[s];
#pragma unroll
            for (int j = 0; j < 4; ++j) { const int c = 16 * mi + 4 * quad + j; Lm[c * 68 + s] = (c > s) ? aK[j] * expf(GC[c] - gs) : 0.f; } }
        { const int c = 16 * mi + l15; const float gcc = GC[c]; float o[4];
#pragma unroll
            for (int j = 0; j < 4; ++j) { const int s = 16 * ni + 4 * quad + j; o[j] = (c >= s) ? aA[j] * expf(gcc - GC[s]) : 0.f; }
            u32x2 w; w.x = pk2(o[0], o[1]); w.y = pk2(o[2], o[3]);
            *(LAS u32x2*)(lds + ATTI_OFF + (c * 72 + 16 * ni + 4 * quad) * 2) = w; }
    }
    lds_barrier();
    if (wave == 0) {
        float Tc[64];
        int zoff; asm volatile("v_mov_b32 %0, 0" : "=v"(zoff));
        const LAS float* Lz = Lm + zoff;
#pragma unroll
        for (int i = 0; i < 64; ++i) { float a = (lane == i) ? 1.f : 0.f;
#pragma unroll
            for (int j4 = 0; j4 < (i + 3) / 4; ++j4) { const f32x4 lv = *(const LAS f32x4*)(Lz + i * 68 + 4 * j4);
#pragma unroll
                for (int jj = 0; jj < 4; ++jj) if (4 * j4 + jj < i) a -= lv[jj] * Tc[4 * j4 + jj]; }
            Tc[i] = a; if ((i & 3) == 3) asm volatile("" ::: "memory"); }
#pragma unroll
        for (int i = 0; i < 64; ++i) *(LAS bf16_t*)(lds + T_OFF + (i * 72 + lane) * 2) = f2bf(Tc[i]);
    }
    lds_barrier();
    {   bf16x8 vf[2], gf[2];
#pragma unroll
        for (int ks = 0; ks < 2; ++ks) { vf[ks] = lds_frag(lds + VBT_OFF, 16 * wave + l15, 72, 32 * ks + 8 * quad); gf[ks] = lds_frag(lds + KBGT_OFF, 16 * wave + l15, 72, 32 * ks + 8 * quad); }
#pragma unroll
        for (int mi = 0; mi < 4; ++mi) { f32x4 aU = {0.f, 0.f, 0.f, 0.f}, aW = {0.f, 0.f, 0.f, 0.f};
#pragma unroll
            for (int ks = 0; ks < 2; ++ks) { const bf16x8 tf = lds_frag(lds + T_OFF, 16 * mi + l15, 72, 32 * ks + 8 * quad);
                aU = mfma16(tf, vf[ks], aU); aW = mfma16(tf, gf[ks], aW); }
            u32x2 wu; wu.x = pk2(aU[0], aU[1]); wu.y = pk2(aU[2], aU[3]);
            u32x2 ww; ww.x = pk2(aW[0], aW[1]); ww.y = pk2(aW[2], aW[3]);
            *(LAS u32x2*)(lds + UT_OFF + ((16 * wave + l15) * 64 + 16 * mi + 4 * quad) * 2) = wu;
            *(LAS u32x2*)(lds + WT_OFF + ((16 * wave + l15) * 64 + 16 * mi + 4 * quad) * 2) = ww; }
    }
    lds_barrier();
    {   bf16x8 kdf[2], wtf[2], utf[2];
#pragma unroll
        for (int ks = 0; ks < 2; ++ks) { kdf[ks] = lds_frag(lds + KDT_OFF, 16 * wave + l15, 72, 32 * ks + 8 * quad);
            wtf[ks] = lds_frag(lds + WT_OFF, 16 * wave + l15, 64, 32 * ks + 8 * quad); utf[ks] = lds_frag(lds + UT_OFF, 16 * wave + l15, 64, 32 * ks + 8 * quad); }
        bf16_t* GA = (bf16_t*)(wsp + G_A) + ub * 16384; bf16_t* GB = (bf16_t*)(wsp + G_BT) + ub * 16384;
        bf16_t* GCp = (bf16_t*)(wsp + G_C) + ub * 8192; bf16_t* GD = (bf16_t*)(wsp + G_D) + ub * 8192;
#pragma unroll
        for (int t2 = 0; t2 < 8; ++t2) {
            f32x4 aA = {0.f, 0.f, 0.f, 0.f}, aB = {0.f, 0.f, 0.f, 0.f};
#pragma unroll
            for (int ks = 0; ks < 2; ++ks) { const bf16x8 wx = lds_frag(lds + WT_OFF, 16 * t2 + l15, 64, 32 * ks + 8 * quad), kx = lds_frag(lds + KDT_OFF, 16 * t2 + l15, 72, 32 * ks + 8 * quad);
                aA = mfma16(wx, kdf[ks], aA);
                aB = mfma16(kx, utf[ks], aB); }
            u32x2 wa; wa.x = pk2(-aA[0], -aA[1]); wa.y = pk2(-aA[2], -aA[3]);
            *(u32x2*)(GA + ((wave * 4 + (t2 >> 1)) * 64 + (2 * (t2 & 1) + (quad >> 1)) * 16 + l15) * 8 + 4 * (quad & 1)) = wa;
            u32x2 wb; wb.x = pk2(aB[0], aB[1]); wb.y = pk2(aB[2], aB[3]);
            *(u32x2*)(GB + ((((wave >> 1) * 8 + t2) * 64 + quad * 16 + l15) * 2 + (wave & 1)) * 4) = wb; }
#pragma unroll
        for (int mi = 0; mi < 4; ++mi) {
            f32x4 aC = {0.f, 0.f, 0.f, 0.f}, aD = {0.f, 0.f, 0.f, 0.f};
#pragma unroll
            for (int ks = 0; ks < 2; ++ks) { const bf16x8 af = lds_frag(lds + ATTI_OFF, 16 * mi + l15, 72, 32 * ks + 8 * quad);
                aC = mfma16(wtf[ks], af, aC);
                aD = mfma16(utf[ks], af, aD); }
            const int c = 16 * mi + l15; const float egc = expf(GC[c]);
            const u32x2 qw = *(const LAS u32x2*)(lds + Q_OFF + (c * 136 + 16 * wave + 4 * quad) * 2);
            u32x2 wc; wc.x = pk2(bf_lo(qw.x) * egc - aC[0], bf_hi(qw.x) * egc - aC[1]); wc.y = pk2(bf_lo(qw.y) * egc - aC[2], bf_hi(qw.y) * egc - aC[3]);
            *(u32x2*)(GCp + ((mi * 4 + (wave >> 1)) * 64 + (2 * (wave & 1) + (quad >> 1)) * 16 + l15) * 8 + 4 * (quad & 1)) = wc;
            u32x2 wd; wd.x = pk2(aD[0], aD[1]); wd.y = pk2(aD[2], aD[3]);
            *(u32x2*)(GD + ((wave * 4 + mi) * 64 + quad * 16 + l15) * 4) = wd; }
    }
    lds_barrier();
}

DI void ret_prep_unit(const Params& p, unsigned char* wsp, int hr, int n, LAS unsigned char* lds, int tid) {
    asm volatile("" : "+v"(tid));
    const int lane = tid & 63, wave = tid >> 6, quad = lane >> 4, l15 = lane & 15;
    const int r = tid >> 3, cgp = tid & 7, t = 64 * n + r;
    constexpr int RQ_OFF = 0, RK_OFF = 17408, KTT_OFF = 34816, VT_OFF = 53248;
    const bf16_t* PROJ = (const bf16_t*)(wsp + WS_PROJ);
    const size_t ub = (size_t)hr * 128 + n;
    const float lg2 = ret_lg2(hr);
    const float xi = exp2f((float)(r + 1) * lg2), zeta = exp2f((float)(63 - r) * lg2);
    const float posf = (float)p.pos[t];
    {   const bf16_t* pq = PROJ + (size_t)t * PROJ_LD + 4096 + hr * 128 + 8 * cgp; const bf16_t* pk = PROJ + (size_t)t * PROJ_LD + 4608 + hr * 128 + 8 * cgp;
        float q1[8], q2[8], k1[8], k2[8];
        unpack8(*(const u32x4*)pq, q1); unpack8(*(const u32x4*)(pq + 64), q2); unpack8(*(const u32x4*)pk, k1); unpack8(*(const u32x4*)(pk + 64), k2);
        float rq1[8], rq2[8], rk1[8], rk2[8];
#pragma unroll
        for (int ii = 0; ii < 8; ++ii) { const int i = 8 * cgp + ii;
            const float invf = expf(-(float)i * (9.210340371976184f / 64.0f)); const float ang = posf * invf; const float trev = ang * 0.15915494309189535f; const float fr = trev - rintf(trev);
            const float cs = __builtin_amdgcn_cosf(fr), sn = __builtin_amdgcn_sinf(fr);
            rq1[ii] = q1[ii] * cs - q2[ii] * sn; rq2[ii] = q1[ii] * sn + q2[ii] * cs;
            rk1[ii] = (k1[ii] * cs - k2[ii] * sn) * 0.08838834764831845f; rk2[ii] = (k1[ii] * sn + k2[ii] * cs) * 0.08838834764831845f; }
        *(LAS u32x4*)(lds + RQ_OFF + (r * 136 + 8 * cgp) * 2) = pack8(rq1); *(LAS u32x4*)(lds + RQ_OFF + (r * 136 + 64 + 8 * cgp) * 2) = pack8(rq2);
        *(LAS u32x4*)(lds + RK_OFF + (r * 136 + 8 * cgp) * 2) = pack8(rk1); *(LAS u32x4*)(lds + RK_OFF + (r * 136 + 64 + 8 * cgp) * 2) = pack8(rk2);
#pragma unroll
        for (int ii = 0; ii < 8; ++ii) { *(LAS bf16_t*)(lds + KTT_OFF + ((8 * cgp + ii) * 72 + r) * 2) = f2bf(rk1[ii] * zeta); *(LAS bf16_t*)(lds + KTT_OFF + ((64 + 8 * cgp + ii) * 72 + r) * 2) = f2bf(rk2[ii] * zeta);
            rq1[ii] *= xi; rq2[ii] *= xi; }
        bf16_t* QI = (bf16_t*)(wsp + R_QI) + ub * 8192 + (size_t)((((r >> 4) * 4 + (cgp >> 2)) * 64 + (cgp & 3) * 16 + (r & 15)) * 8);
        *(u32x4*)QI = pack8(rq1); *(u32x4*)(QI + 2 * 512) = pack8(rq2);
    }
    {   const bf16_t* pv = PROJ + (size_t)t * PROJ_LD + 5120 + hr * 256 + 32 * cgp;
#pragma unroll
        for (int q = 0; q < 4; ++q) { float vv[8]; unpack8(*(const u32x4*)(pv + 8 * q), vv);
#pragma unroll
            for (int i = 0; i < 8; ++i) *(LAS bf16_t*)(lds + VT_OFF + ((32 * cgp + 8 * q + i) * 72 + r) * 2) = f2bf(vv[i]); }
    }
    lds_barrier();
#pragma unroll
    for (int tt = 0; tt < 2; ++tt) { const int id = 2 * wave + tt, mi = id >> 2, ni = id & 3;
        f32x4 aA = {0.f, 0.f, 0.f, 0.f};
#pragma unroll
        for (int ks = 0; ks < 4; ++ks) { const bf16x8 kf = lds_frag(lds + RK_OFF, 16 * ni + l15, 136, 32 * ks + 8 * quad), qf = lds_frag(lds + RQ_OFF, 16 * mi + l15, 136, 32 * ks + 8 * quad);
            aA = mfma16(kf, qf, aA); }
        const int c = 16 * mi + l15; float o[4];
#pragma unroll
        for (int j = 0; j < 4; ++j) { const int s = 16 * ni + 4 * quad + j; o[j] = (c >= s) ? aA[j] * exp2f((float)(c - s) * lg2) : 0.f; }
        u32x2 w; w.x = pk2(o[0], o[1]); w.y = pk2(o[2], o[3]);
        *(u32x2*)((bf16_t*)(wsp + R_SC) + ub * 4096 + ((mi * 2 + (ni >> 1)) * 64 + (2 * (ni & 1) + (quad >> 1)) * 16 + l15) * 8 + 4 * (quad & 1)) = w; }
    {
        bf16x8 kf[2];
#pragma unroll
        for (int ks = 0; ks < 2; ++ks) kf[ks] = lds_frag(lds + KTT_OFF, 16 * wave + l15, 72, 32 * ks + 8 * quad);
        float* PT = (float*)(wsp + R_P) + ub * 32768;
#pragma unroll 4
        for (int et = 0; et < 16; ++et) { f32x4 a = {0.f, 0.f, 0.f, 0.f};
#pragma unroll
            for (int ks = 0; ks < 2; ++ks) a = mfma16(kf[ks], lds_frag(lds + VT_OFF, 16 * et + l15, 72, 32 * ks + 8 * quad), a);
            *(f32x4*)(PT + ((et * 4 + (wave >> 1)) * 64 + (2 * (wave & 1) + (quad >> 1)) * 16 + l15) * 8 + 4 * (quad & 1)) = a; }
    }
#pragma unroll
    for (int i = 0; i < 4; ++i) { const int id = tid + 512 * i, blk = id >> 6, row = 16 * (blk >> 1) + (id & 15), chn = 4 * (blk & 1) + ((id >> 4) & 3);
        *(u32x4*)((bf16_t*)(wsp + R_VT) + ub * 16384 + (size_t)id * 8) = *(const LAS u32x4*)(lds + VT_OFF + (row * 72 + 8 * chn) * 2); }
    lds_barrier();
}

struct SFrag { bf16x8 af[4]; u32x2 bt[2]; };
DI void sfrag_load(SFrag& f, const unsigned char* ws, int hh, int es, int n, int wave, int quad, int l15) {
    const size_t ub = (size_t)hh * 128 + n;
    const int lane = quad * 16 + l15;
    const bf16_t* Ap = (const bf16_t*)(ws + G_A) + ub * 16384 + (size_t)(wave * 4) * 512 + lane * 8;
    const bf16_t* Bp = (const bf16_t*)(ws + G_BT) + ub * 16384 + (size_t)((es * 8 + wave) * 64 + lane) * 8;
#pragma unroll
    for (int ks = 0; ks < 4; ++ks) f.af[ks] = *(const bf16x8*)(Ap + ks * 512);
    {   const u32x4 b4 = *(const u32x4*)Bp; f.bt[0] = (u32x2){b4.x, b4.y}; f.bt[1] = (u32x2){b4.z, b4.w}; }
}
DI void gdn_chain(const Params& p, unsigned char* wsp, int l, int hh, int es, LAS unsigned char* lds, int tid) {
    asm volatile("" : "+v"(tid));
    const int lane = tid & 63, wave = tid >> 6, quad = lane >> 4, l15 = lane & 15;
    constexpr int ST_BYTES = 8704;
    for (int i = tid; i < 2 * ST_BYTES / 4; i += NTHR) ((LAS unsigned*)lds)[i] = 0u;
    LAS float* GLs = (LAS float*)(lds + 2 * ST_BYTES);
    if (tid < 128) GLs[tid] = ((const float*)(wsp + G_GL))[hh * 128 + tid];
    f32x4 Sacc[2] = {{0.f, 0.f, 0.f, 0.f}, {0.f, 0.f, 0.f, 0.f}};
    bf16_t* SG = (bf16_t*)(wsp + G_S) + ((size_t)hh * 128) * 16384 + (size_t)(((2 * es + (wave >> 2)) * 4 + (wave & 3)) * 64 + lane) * 8;
    const int srd = ((16 * (wave >> 2) + l15) * 136 + 32 * (wave & 3) + 8 * quad) * 2;
    SFrag f0, f1, f2, f3, f4, f5;
#define CFENCE() asm volatile("" ::: "memory")
    sfrag_load(f0, wsp, hh, es, 0, wave, quad, l15); CFENCE(); sfrag_load(f1, wsp, hh, es, 1, wave, quad, l15); CFENCE(); sfrag_load(f2, wsp, hh, es, 2, wave, quad, l15); CFENCE();
    sfrag_load(f3, wsp, hh, es, 3, wave, quad, l15); CFENCE(); sfrag_load(f4, wsp, hh, es, 4, wave, quad, l15); CFENCE();
#undef CFENCE
    lds_barrier();
#define S_STEP(cur, n) do { \
        LAS unsigned char* sc = lds + ((n) & 1) * ST_BYTES; LAS unsigned char* sn = lds + (((n) + 1) & 1) * ST_BYTES; \
        const float glv = GLs[(n)]; \
        bf16x8 sfr[2][4]; \
        _Pragma("unroll") for (int et = 0; et < 2; ++et) _Pragma("unroll") for (int ks = 0; ks < 4; ++ks) sfr[et][ks] = lds_frag(sc, 16 * et + l15, 136, 32 * ks + 8 * quad);     \
        *(u32x4*)(SG + (size_t)(n) * 16384) = *(const LAS u32x4*)(sc + srd);                  \
        _Pragma("unroll") for (int et = 0; et < 2; ++et) { \
            f32x4 a; a[0] = Sacc[et][0] * glv + bf_lo(cur.bt[et].x); a[1] = Sacc[et][1] * glv + bf_hi(cur.bt[et].x); a[2] = Sacc[et][2] * glv + bf_lo(cur.bt[et].y); a[3] = Sacc[et][3] * glv + bf_hi(cur.bt[et].y); \
            _Pragma("unroll") for (int ks = 0; ks < 4; ++ks) a = mfma16(cur.af[ks], sfr[et][ks], a);     \
            Sacc[et] = a; \
            u32x2 w; w.x = pk2(a[0], a[1]); w.y = pk2(a[2], a[3]); \
            *(LAS u32x2*)(sn + ((16 * et + l15) * 136 + 16 * wave + 4 * quad) * 2) = w; } \
        lds_barrier(); } while (0)
#define S_LOAD(f, n) sfrag_load(f, wsp, hh, es, (n) < 128 ? (n) : 127, wave, quad, l15)
    for (int n = 0; n < 126; n += 6) {
        S_LOAD(f5, n + 5);  S_STEP(f0, n);
        S_LOAD(f0, n + 6);  S_STEP(f1, n + 1);
        S_LOAD(f1, n + 7);  S_STEP(f2, n + 2);
        S_LOAD(f2, n + 8);  S_STEP(f3, n + 3);
        S_LOAD(f3, n + 9);  S_STEP(f4, n + 4);
        S_LOAD(f4, n + 10); S_STEP(f5, n + 5);
    }
    S_STEP(f0, 126); S_STEP(f1, 127);
#undef S_STEP
#undef S_LOAD
}

DI void ret_scan(unsigned char* wsp, int sb, int tid) {
    const int idx = sb * NTHR + tid;
    const int hr = idx >> 13, off = (idx & 8191) * 4;
    const float cd = exp2f(64.0f * ret_lg2(hr));
    const float* P = (const float*)(wsp + R_P) + (size_t)hr * 128 * 32768 + off;
    bf16_t* RT = (bf16_t*)(wsp + R_RT) + (size_t)hr * 128 * 32768 + off;
    f32x4 R = {0.f, 0.f, 0.f, 0.f};
    for (int n0 = 0; n0 < 128; n0 += 16) {
        f32x4 pv[16];
#pragma unroll
        for (int i = 0; i < 16; ++i) pv[i] = *(const f32x4*)(P + (size_t)(n0 + i) * 32768);
#pragma unroll
        for (int i = 0; i < 16; ++i) { u32x2 w; w.x = pk2(R[0], R[1]); w.y = pk2(R[2], R[3]); *(u32x2*)(RT + (size_t)(n0 + i) * 32768) = w; R = R * cd + pv[i]; }
    }
}

DI void gdn_out_unit(const Params& p, unsigned char* wsp, int l, int hh, int n, LAS unsigned char* lds, int tid) {
    asm volatile("" : "+v"(tid));
    const int lane = tid & 63, wave = tid >> 6, quad = lane >> 4, l15 = lane & 15;
    const size_t ub = (size_t)hh * 128 + n;
    const bf16_t* Sp = (const bf16_t*)(wsp + G_S) + ub * 16384 + (size_t)(wave * 4) * 512 + lane * 8;
    const bf16_t* Cp = (const bf16_t*)(wsp + G_C) + ub * 8192 + lane * 8;
    const bf16_t* Dp = (const bf16_t*)(wsp + G_D) + ub * 8192 + (size_t)((wave * 4) * 64 + lane) * 4;
    bf16x8 sf[4]; f32x4 acc[4];
    const int e0 = 16 * wave + 4 * quad;
    const bf16_t* PROJ = (const bf16_t*)(wsp + WS_PROJ);
    u32x2 zwv[4];
#pragma unroll
    for (int mi = 0; mi < 4; ++mi) zwv[mi] = *(const u32x2*)(PROJ + (size_t)(64 * n + 16 * mi + l15) * PROJ_LD + 3072 + hh * 128 + e0);
    const f32x4 nw = *(const f32x4*)(p.gdn_norm_w + l * 128 + e0);
#pragma unroll
    for (int ks = 0; ks < 4; ++ks) sf[ks] = *(const bf16x8*)(Sp + ks * 512);
#pragma unroll
    for (int mi = 0; mi < 4; ++mi) { const u32x2 dw = *(const u32x2*)(Dp + mi * 256);
        f32x4 a; a[0] = bf_lo(dw.x); a[1] = bf_hi(dw.x); a[2] = bf_lo(dw.y); a[3] = bf_hi(dw.y);
#pragma unroll
        for (int ks = 0; ks < 4; ++ks) a = mfma16(sf[ks], *(const bf16x8*)(Cp + (mi * 4 + ks) * 512), a);
        acc[mi] = a; }
    LAS float* red = (LAS float*)lds;
#pragma unroll
    for (int mi = 0; mi < 4; ++mi) { float s = (acc[mi][0] * acc[mi][0] + acc[mi][1] * acc[mi][1]) + (acc[mi][2] * acc[mi][2] + acc[mi][3] * acc[mi][3]);
        s += __shfl_xor(s, 16); s += __shfl_xor(s, 32);
        if (quad == 0) red[wave * 64 + 16 * mi + l15] = s; }
    lds_barrier();
    bf16_t* ACTA = (bf16_t*)(wsp + WS_ACT);
#pragma unroll
    for (int mi = 0; mi < 4; ++mi) { const int c = 16 * mi + l15; float tot = 0.f;
#pragma unroll
        for (int w8 = 0; w8 < 8; ++w8) tot += red[w8 * 64 + c];
        const float rs = 1.0f / sqrtf(tot * (1.0f / 128.0f) + EPS);
        const size_t t = (size_t)(64 * n + c);
        const u32x2 zw = zwv[mi];
        u32x2 o; o.x = pk2(acc[mi][0] * rs * nw[0] * siluf_(bf_lo(zw.x)), acc[mi][1] * rs * nw[1] * siluf_(bf_hi(zw.x)));
        o.y = pk2(acc[mi][2] * rs * nw[2] * siluf_(bf_lo(zw.y)), acc[mi][3] * rs * nw[3] * siluf_(bf_hi(zw.y)));
        *(u32x2*)(ACTA + t * 1024 + hh * 128 + e0) = o; }
    lds_barrier();
}
DI void ret_out_unit(const Params& p, unsigned char* wsp, int hr, int n, LAS unsigned char* lds, int tid) {
    asm volatile("" : "+v"(tid));
    const int lane = tid & 63, wave = tid >> 6, quad = lane >> 4, l15 = lane & 15;
    const size_t ub = (size_t)hr * 128 + n;
    const bf16_t* Qp = (const bf16_t*)(wsp + R_QI) + ub * 8192 + lane * 8;
    const bf16_t* Sp = (const bf16_t*)(wsp + R_SC) + ub * 4096 + lane * 8;
    const bf16_t* PROJ = (const bf16_t*)(wsp + WS_PROJ);
    u32x2 bgw[2][4];
#pragma unroll
    for (int tt = 0; tt < 2; ++tt)
#pragma unroll
        for (int mi = 0; mi < 4; ++mi) bgw[tt][mi] = *(const u32x2*)(PROJ + (size_t)(64 * n + 16 * mi + l15) * PROJ_LD + 6144 + hr * 256 + 16 * (2 * wave + tt) + 4 * quad);
    f32x4 acc[2][4];
#pragma unroll
    for (int tt = 0; tt < 2; ++tt) { const int et = 2 * wave + tt;
        const bf16_t* Rp = (const bf16_t*)(wsp + R_RT) + ub * 32768 + (size_t)(et * 4) * 512 + lane * 8;
        const bf16_t* Vp = (const bf16_t*)(wsp + R_VT) + ub * 16384 + (size_t)(et * 2) * 512 + lane * 8;
        bf16x8 rf[4], vf[2];
#pragma unroll
        for (int ks = 0; ks < 4; ++ks) rf[ks] = *(const bf16x8*)(Rp + ks * 512);
#pragma unroll
        for (int ks = 0; ks < 2; ++ks) vf[ks] = *(const bf16x8*)(Vp + ks * 512);
#pragma unroll
        for (int mi = 0; mi < 4; ++mi) { f32x4 a = {0.f, 0.f, 0.f, 0.f};
#pragma unroll
            for (int ks = 0; ks < 4; ++ks) a = mfma16(rf[ks], *(const bf16x8*)(Qp + (mi * 4 + ks) * 512), a);
#pragma unroll
            for (int ks = 0; ks < 2; ++ks) a = mfma16(vf[ks], *(const bf16x8*)(Sp + (mi * 2 + ks) * 512), a);
            acc[tt][mi] = a; } }
    LAS float* red = (LAS float*)lds;
#pragma unroll
    for (int mi = 0; mi < 4; ++mi) { float s = 0.f, q = 0.f;
#pragma unroll
        for (int tt = 0; tt < 2; ++tt) { const f32x4 a = acc[tt][mi]; s += (a[0] + a[1]) + (a[2] + a[3]); q += (a[0] * a[0] + a[1] * a[1]) + (a[2] * a[2] + a[3] * a[3]); }
        s += __shfl_xor(s, 16); s += __shfl_xor(s, 32); q += __shfl_xor(q, 16); q += __shfl_xor(q, 32);
        if (quad == 0) { red[(wave * 64 + 16 * mi + l15) * 2] = s; red[(wave * 64 + 16 * mi + l15) * 2 + 1] = q; } }
    lds_barrier();
    bf16_t* ACTB = (bf16_t*)(wsp + WS_ACT) + (size_t)T_ * 1024;
#pragma unroll
    for (int mi = 0; mi < 4; ++mi) { const int c = 16 * mi + l15; float S = 0.f, Q = 0.f;
#pragma unroll
        for (int w8 = 0; w8 < 8; ++w8) { S += red[(w8 * 64 + c) * 2]; Q += red[(w8 * 64 + c) * 2 + 1]; }
        const float mu = S * (1.0f / 256.0f), var = fmaxf(Q * (1.0f / 256.0f) - mu * mu, 0.f), rs = 1.0f / sqrtf(var + 1e-5f);
#pragma unroll
        for (int tt = 0; tt < 2; ++tt) { const f32x4 a = acc[tt][mi]; const u32x2 g = bgw[tt][mi];
            u32x2 o; o.x = pk2((a[0] - mu) * rs * siluf_(bf_lo(g.x)), (a[1] - mu) * rs * siluf_(bf_hi(g.x))); o.y = pk2((a[2] - mu) * rs * siluf_(bf_lo(g.y)), (a[3] - mu) * rs * siluf_(bf_hi(g.y)));
            *(u32x2*)(ACTB + (size_t)(64 * n + c) * 1024 + hr * 256 + 16 * (2 * wave + tt) + 4 * quad) = o; } }
    lds_barrier();
}

DI void sub_barrier(unsigned* cnt, unsigned target) {
    asm volatile("s_waitcnt vmcnt(0)" ::: "memory");
    __syncthreads();
    if (threadIdx.x == 0) {
        __builtin_amdgcn_fence(__ATOMIC_RELEASE, "agent");
        asm volatile("s_waitcnt vmcnt(0)" ::: "memory");
        (void)__hip_atomic_fetch_add(cnt, 1u, __ATOMIC_RELAXED, __HIP_MEMORY_SCOPE_AGENT);
        unsigned sp = 0;
        while (__hip_atomic_load(cnt, __ATOMIC_RELAXED, __HIP_MEMORY_SCOPE_AGENT) < target) { __builtin_amdgcn_s_sleep(24); if (++sp > (1u << 20)) break; }
        __builtin_amdgcn_fence(__ATOMIC_ACQUIRE, "agent");
        asm volatile("s_waitcnt vmcnt(0)" ::: "memory");
    }
    __syncthreads();
}

DI void conv_unit(const Params& p, unsigned char* wsp, int l, int u, LAS unsigned char* lds, int tid) {
    asm volatile("" : "+v"(tid));
    const int tt = u >> 2, cs = u & 3, t0 = 64 * tt;
    const bf16_t* PROJ = (const bf16_t*)(wsp + WS_PROJ);
    LAS float* Ug = (LAS float*)lds;
    {   const int c8 = tid & 31, rg = tid >> 5;
        u32x4 ga[6], gg[6];
#pragma unroll
        for (int i = 0; i < 6; ++i) { const int rr = rg + 16 * i, t = t0 - 30 + rr; ga[i] = (u32x4){0u, 0u, 0u, 0u}; gg[i] = (u32x4){0u, 0u, 0u, 0u};
            if (rr < 94 && t >= 0) { ga[i] = *(const u32x4*)(PROJ + (size_t)t * PROJ_LD + 7168 + 256 * cs + 8 * c8); gg[i] = *(const u32x4*)(PROJ + (size_t)t * PROJ_LD + 8192 + 256 * cs + 8 * c8); } }
#pragma unroll
        for (int i = 0; i < 6; ++i) { const int rr = rg + 16 * i;
            if (rr < 94) { float a[8], g[8], o[8]; unpack8(ga[i], a); unpack8(gg[i], g);
#pragma unroll
                for (int q = 0; q < 8; ++q) o[q] = a[q] * sigmoidf_(g[q]);
                *(LAS f32x4*)(Ug + rr * 256 + 8 * c8) = (f32x4){o[0], o[1], o[2], o[3]}; *(LAS f32x4*)(Ug + rr * 256 + 8 * c8 + 4) = (f32x4){o[4], o[5], o[6], o[7]}; } }
    }
    lds_barrier();
    {   const int ch = tid & 255, half = tid >> 8, cg_ = 256 * cs + ch;
        float w[31];
#pragma unroll
        for (int j = 0; j < 31; ++j) w[j] = p.conv_dw_w[((size_t)l * 31 + j) * 1024 + cg_];
        const float bias = p.conv_dw_b[l * 1024 + cg_];
        float* CV = (float*)(wsp + WS_CV);
        for (int tl = 32 * half; tl < 32 * half + 32; ++tl) { float a = bias;
#pragma unroll
            for (int j = 0; j < 31; ++j) a += w[j] * Ug[(tl + j) * 256 + ch];
            CV[(size_t)(t0 + tl) * 1024 + cg_] = a; }
    }
    lds_barrier();
}

DI void phase_post(const Params& p, unsigned char* wsp, int l, int tid, const int mask, const int b0, const int nblk) {
    const int lane = tid & 63, wave = tid >> 6, gw = ((int)blockIdx.x - b0) * 8 + wave, NGW = nblk * 8;
    const bf16_t* PROJ = (const bf16_t*)(wsp + WS_PROJ);
    const float* OA = (const float*)(wsp + WS_OA); const float* OB = (const float*)(wsp + WS_OB); const float* CV = (const float*)(wsp + WS_CV);
    bf16_t* ACTA = (bf16_t*)(wsp + WS_ACT); bf16_t* ACTB = ACTA + (size_t)T_ * 1024; bf16_t* ACTC = ACTB + (size_t)T_ * 1024;
    for (int t = gw; t < T_; t += NGW) {
        if (mask & 1)
#pragma unroll
        for (int hh = 0; hh < 8; ++hh) { const int cc = hh * 128 + 2 * lane;
            const float o0 = OA[(size_t)t * 1024 + cc], o1 = OA[(size_t)t * 1024 + cc + 1];
            const float ss = wave_sum(o0 * o0 + o1 * o1); const float rs = 1.0f / sqrtf(ss * (1.0f / 128.0f) + EPS);
            const unsigned zw = *(const unsigned*)(PROJ + (size_t)t * PROJ_LD + 3072 + cc);
            const float w0 = p.gdn_norm_w[l * 128 + 2 * lane], w1 = p.gdn_norm_w[l * 128 + 2 * lane + 1];
            *(unsigned*)(ACTA + (size_t)t * 1024 + cc) = pk2(o0 * rs * w0 * siluf_(bf_lo(zw)), o1 * rs * w1 * siluf_(bf_hi(zw))); }
        if (mask & 2)
#pragma unroll
        for (int hr = 0; hr < 4; ++hr) { const int cc = hr * 256 + 4 * lane;
            const f32x4 o = *(const f32x4*)(OB + (size_t)t * 1024 + cc);
            const float mu = wave_sum((o[0] + o[1]) + (o[2] + o[3])) * (1.0f / 256.0f);
            const f32x4 d = o - mu; const float var = wave_sum((d[0] * d[0] + d[1] * d[1]) + (d[2] * d[2] + d[3] * d[3])) * (1.0f / 256.0f);
            const float rs = 1.0f / sqrtf(var + 1e-5f);
            const u32x2 gwd = *(const u32x2*)(PROJ + (size_t)t * PROJ_LD + 6144 + cc);
            u32x2 w; w.x = pk2(d[0] * rs * siluf_(bf_lo(gwd.x)), d[1] * rs * siluf_(bf_hi(gwd.x))); w.y = pk2(d[2] * rs * siluf_(bf_lo(gwd.y)), d[3] * rs * siluf_(bf_hi(gwd.y)));
            *(u32x2*)(ACTB + (size_t)t * 1024 + cc) = w; }
        if (mask & 4)
        {   f32x4 v[4]; float s = 0.f;
#pragma unroll
            for (int j = 0; j < 4; ++j) { v[j] = *(const f32x4*)(CV + (size_t)t * 1024 + (j * 64 + lane) * 4); s += (v[j][0] + v[j][1]) + (v[j][2] + v[j][3]); }
            const float mu = wave_sum(s) * (1.0f / 1024.0f); float q = 0.f;
#pragma unroll
            for (int j = 0; j < 4; ++j) { v[j] = v[j] - mu; q += (v[j][0] * v[j][0] + v[j][1] * v[j][1]) + (v[j][2] * v[j][2] + v[j][3] * v[j][3]); }
            const float rs = 1.0f / sqrtf(wave_sum(q) * (1.0f / 1024.0f) + 1e-5f);
#pragma unroll
            for (int j = 0; j < 4; ++j) { const int cc = (j * 64 + lane) * 4; const f32x4 lw = *(const f32x4*)(p.conv_ln_w + l * 1024 + cc), lb = *(const f32x4*)(p.conv_ln_b + l * 1024 + cc);
                const f32x4 y = v[j] * rs * lw + lb;
                u32x2 w; w.x = pk2(siluf_(y[0]), siluf_(y[1])); w.y = pk2(siluf_(y[2]), siluf_(y[3]));
                *(u32x2*)(ACTC + (size_t)t * 1024 + cc) = w; }
        }
    }
}

template <class Epi> DI void run_gemm(LAS unsigned char* lds, const bf16_t* A, const bf16_t* Bt, int N, int K, const Epi& E) {
    Gemm g{A, Bt, T_, N, K}; StaticOrder S; S.init(T_, N, (int)gridDim.x, (int)blockIdx.x);
    gemm_phase<Epi, StaticOrder, false>(lds, g, S, E, nullptr);
}

DI void run_phase(const Params& p, unsigned char* wsp, int ph, LAS unsigned char* lds, int tid) {
    const int G = gridDim.x, b = blockIdx.x;
#ifndef SUBM
#define SUBM 3
#endif
#ifndef PHM
#define PHM 0xFFF
#endif
    if (ph == 0) { if (PHM & 0x400) phase_prep(p, wsp, lds, tid); return; }
    if (ph == 21) { if (PHM & 0x800) phase_norm((const float*)(wsp + WS_XC), p.final_w, nullptr, nullptr, nullptr, p.out, tid); return; }
    const int l = (ph - 1) / 10, sp = (ph - 1) % 10;
    const float* mod = (const float*)(wsp + WS_MOD) + l * 12288;
    const float* xin = (l == 0) ? p.x : (const float*)(wsp + WS_XC);
    float* XC = (float*)(wsp + WS_XC);
    bf16_t* H = (bf16_t*)(wsp + WS_H);
    bf16_t* PROJ = (bf16_t*)(wsp + WS_PROJ);
    const unsigned char* wl = wsp + WS_W + (size_t)l * SZ_WL;
    const bf16_t* WT_IN = (const bf16_t*)wl; const bf16_t* WT_BR = (const bf16_t*)(wl + SZ_WT_IN); const bf16_t* WT_O = (const bf16_t*)(wl + SZ_WT_IN + 3 * SZ_WT_BR);
    const bf16_t* WT_MI = (const bf16_t*)(wl + SZ_WT_IN + 3 * SZ_WT_BR + SZ_WT_O); const bf16_t* WT_MO = (const bf16_t*)(wl + SZ_WT_IN + 3 * SZ_WT_BR + SZ_WT_O + SZ_WT_M);
    switch (sp) {
    case 0: if (PHM & (1<<0)) phase_norm(xin, p.norm_mix_w + l * D_, mod + 2048, mod, H, nullptr, tid); break;
    case 1: if (PHM & (1<<1)) { EpiProj E{PROJ, (float*)(wsp + WS_BA)}; run_gemm(lds, H, WT_IN, NP1, 2048, E); } break;
    case 2: if (PHM & (1<<2)) for (int u = b; u < 1024; u += G) gdn_prep_unit(p, wsp, l, u >> 7, u & 127, lds, tid); break;
    case 3: if (PHM & (1<<3)) {
        if (b < 32) { gdn_chain(p, wsp, l, b >> 2, b & 3, lds, tid); lds_barrier(); }
        else {
            const int nb = b - 32, NB = G - 32; unsigned* cnt = (unsigned*)(wsp + WS_PROG) + 1024;
            for (int u = nb; u < 1024; u += NB) { if (u < 512) ret_prep_unit(p, wsp, u >> 7, u & 127, lds, tid); else conv_unit(p, wsp, l, u - 512, lds, tid); }
            sub_barrier(cnt, (unsigned)(NB * (l + 1)));
            if (nb < 64) ret_scan(wsp, nb, tid);
        }
    } break;
    case 4: if (PHM & (1<<4)) {
        for (int u = b; u < 1536; u += G) { if (u < 1024) gdn_out_unit(p, wsp, l, u >> 7, u & 127, lds, tid); else ret_out_unit(p, wsp, (u - 1024) >> 7, (u - 1024) & 127, lds, tid); }
        phase_post(p, wsp, l, tid, 4, 0, G);
    } break;
    case 5: if (PHM & (1<<5)) { const bf16_t* ACT = (const bf16_t*)(wsp + WS_ACT); float* MF = (float*)(wsp + WS_MF); bf16_t* MB = (bf16_t*)(wsp + WS_MB);
        { EpiBranch<0> E{PROJ, MF, MB}; run_gemm(lds, ACT, WT_BR, 2048, 1024, E); }
        { EpiBranch<1> E{PROJ, MF, MB}; run_gemm(lds, ACT + (size_t)T_ * 1024, WT_BR + (size_t)2048 * 1024, 2048, 1024, E); }
        { EpiBranch<2> E{PROJ, MF, MB}; run_gemm(lds, ACT + 2 * (size_t)T_ * 1024, WT_BR + 2 * (size_t)2048 * 1024, 2048, 1024, E); }
    } break;
    case 6: if (PHM & (1<<6)) { EpiResid E{xin, XC, mod + 4096}; run_gemm(lds, (const bf16_t*)(wsp + WS_MB), WT_O, 2048, 2048, E); } break;
    case 7: if (PHM & (1<<7)) phase_norm(XC, p.norm_mlp_w + l * D_, mod + 8192, mod + 6144, H, nullptr, tid); break;
    case 8: if (PHM & (1<<8)) { EpiRelu2 E{PROJ}; run_gemm(lds, H, WT_MI, 8192, 2048, E); } break;
    case 9: if (PHM & (1<<9)) { EpiResid E{XC, XC, mod + 10240}; run_gemm(lds, PROJ, WT_MO, 2048, 8192, E); } break;
    }
}

constexpr int NPHASE = 22;
__global__ void __launch_bounds__(NTHR, 2) mega_kernel(Params p) {
    extern __shared__ __attribute__((aligned(16))) unsigned char smem[];
    LAS unsigned char* lds = (LAS unsigned char*)smem;
    const int tid = threadIdx.x;
    volatile LAS unsigned* xbw = (volatile LAS unsigned*)(lds + LDS_BYTES - 16);
    if (tid == 0) { xbw[0] = 0u; xbw[1] = 0u; }
    __syncthreads();
    if (p.ph_hi - p.ph_lo > 1) (void)xcd_barrier_post((unsigned*)(p.ws + WS_BAR), xbw);
#ifndef PROBE_REP
#define PROBE_REP 0
#endif
    int ph = p.ph_lo, rep = 0, nbar = 0;
    while (ph < p.ph_hi) {
        if (nbar >= 1 && p.ph_hi - p.ph_lo == 2) { __threadfence(); cg::this_grid().sync(); }
        else if (nbar >= 1) { XcdBarrier xb; xb.bar = (unsigned*)(p.ws + WS_BAR); xb.x = xb_xcc_id(); xb.st = (volatile LAS unsigned*)(lds + LDS_BYTES - 16); xcd_barrier(xb); }
        ++nbar;
        int t2 = tid; asm volatile("" : "+v"(t2));
        unsigned char* wsp;
        {   int z; asm volatile("v_mov_b32 %0, 0" : "=v"(z)); z = __builtin_amdgcn_readfirstlane(z);
            wsp = p.ws + z; }
        run_phase(p, wsp, ph, lds, t2);
        const int sp_ = (ph == 0) ? 10 : (ph == 21) ? 11 : (ph - 1) % 10;
        if (rep == 0 && ((PROBE_REP >> sp_) & 1)) rep = 1; else { rep = 0; ++ph; }
    }
}

#ifndef ONE_LAUNCH
#define ONE_LAUNCH 1
#endif
extern "C" void kernel_launch(void* const* d_in, const int* in_sizes, int n_in, void* d_out, int out_size, void* d_ws, size_t ws_size, hipStream_t stream) {
    static int grid = 0;
    if (grid == 0) {
        if (n_in != 23 || ws_size < WS_END) { fprintf(stderr, "kernel_launch: bad inputs (n_in %d ws %zu need %zu)\n", n_in, ws_size, (size_t)WS_END); grid = -1; return; }
        int dev = 0, cus = 0, per_cu = 0;
        hipGetDevice(&dev); hipDeviceGetAttribute(&cus, hipDeviceAttributeMultiprocessorCount, dev);
        if (hipFuncSetAttribute((const void*)mega_kernel, hipFuncAttributeMaxDynamicSharedMemorySize, LDS_BYTES) != hipSuccess) { fprintf(stderr, "hipFuncSetAttribute failed\n"); grid = -1; return; }
        if (hipOccupancyMaxActiveBlocksPerMultiprocessor(&per_cu, (const void*)mega_kernel, NTHR, LDS_BYTES) != hipSuccess || per_cu < 1) per_cu = 1;
        (void)hipGetLastError();
        grid = cus * 1;
    }
    if (grid < 0) return;
    Params p{};
    p.x = (const float*)d_in[0]; p.c = (const float*)d_in[1]; p.pos = (const int*)d_in[2]; p.w_ada = (const float*)d_in[3]; p.b_ada = (const float*)d_in[4];
    p.norm_mix_w = (const float*)d_in[5]; p.norm_mlp_w = (const float*)d_in[6]; p.w_in = (const float*)d_in[7]; p.conv_qkv_w = (const float*)d_in[8];
    p.a_log = (const float*)d_in[9]; p.dt_bias = (const float*)d_in[10]; p.gdn_norm_w = (const float*)d_in[11]; p.conv_dw_w = (const float*)d_in[12]; p.conv_dw_b = (const float*)d_in[13];
    p.conv_ln_w = (const float*)d_in[14]; p.conv_ln_b = (const float*)d_in[15]; p.w_a = (const float*)d_in[16]; p.w_b = (const float*)d_in[17]; p.w_c = (const float*)d_in[18];
    p.w_out = (const float*)d_in[19]; p.w_mi = (const float*)d_in[20]; p.w_mo = (const float*)d_in[21]; p.final_w = (const float*)d_in[22];
    p.out = (float*)d_out; p.ws = (unsigned char*)d_ws;
#if ONE_LAUNCH
    p.ph_lo = 0; p.ph_hi = NPHASE;
    if (hipMemsetAsync((char*)d_ws + WS_BAR, 0, 32768, stream) != hipSuccess) { fprintf(stderr, "memset failed\n"); return; }
    void* args[] = {&p};
    hipError_t e = hipLaunchCooperativeKernel((const void*)mega_kernel, dim3(grid), dim3(NTHR), args, LDS_BYTES, stream);
    if (e != hipSuccess) fprintf(stderr, "cooperative launch failed: %s (grid %d)\n", hipGetErrorString(e), grid);
#else
    for (int ph = 0; ph < NPHASE; ++ph) { p.ph_lo = ph; p.ph_hi = ph + 1;
        hipLaunchKernelGGL(mega_kernel, dim3(grid), dim3(NTHR), LDS_BYTES, stream, p); }
#endif
}
```

```cpp
#include <hip/hip_runtime.h>
#include <hip/hip_cooperative_groups.h>
#include <cstdio>
namespace pg8 {
#define PG8_LAS __attribute__((address_space(3)))
typedef unsigned short bf16_t;
typedef short bf16x8 __attribute__((ext_vector_type(8)));
typedef float f32x4 __attribute__((ext_vector_type(4)));
typedef unsigned u32x4 __attribute__((ext_vector_type(4)));
constexpr int BM = 256, BK = 64, HALF = 128, HTB = HALF * BK * 2  , STAGE_BYTES = 8 * HTB, NXCD = 8, WGM = 8;

__host__ __device__ __forceinline__ int lds_byte(int r, int c) { const int st = (r >> 4) * 2 + (c >> 5), rr = r & 15, cc = c & 31, ob = rr * 64 + cc * 2; return st * 1024 + (ob ^ (((ob >> 9) & 1) << 5)); }
__host__ __device__ __forceinline__ void stage_rc(int b, int& R, int& C) { const int st = b / 1024, sb = b % 1024, swz = sb ^ (((sb >> 9) & 1) << 5); R = (st >> 1) * 16 + swz / 64; C = (st & 1) * 32 + (swz % 64) / 2; }
__host__ __device__ __forceinline__ int perm32(int rho) { const int n = rho >> 4, i = rho & 15; return 8 * (i >> 2) + 4 * n + (i & 3); }

struct Unit { int pm, pn; };
struct Gemm { const bf16_t* A; const bf16_t* Bt; int M, N, K; };

struct StaticOrder {
    int nM, nN, nwg, G, c;
    __host__ __device__ void init(int M, int N, int G_, int c_) { nM = M / BM; nN = N / BM; nwg = nM * nN; G = G_; c = c_; }
    __host__ __device__ bool next(int i, Unit& u) const {
        const long L = (long)i * G + c; if (L >= nwg) return false;
        int wgid = (int)L; { const int q = nwg / NXCD, r = nwg % NXCD, xcd = wgid % NXCD, off = wgid / NXCD; wgid = (xcd < r ? xcd * (q + 1) : r * (q + 1) + (xcd - r) * q) + off; }
        const int nig = WGM * nN, gid = wgid / nig, fm = gid * WGM, gsz = (nM - fm) < WGM ? (nM - fm) : WGM;
        u.pm = fm + ((wgid % nig) % gsz); u.pn = (wgid % nig) / gsz; return true;
    }
    __device__ __forceinline__ void a_ready(const Unit&) const {}
    __device__ __forceinline__ void done(const Unit&) const {}
};
typedef float f32x2c_ __attribute__((ext_vector_type(2)));
typedef __bf16 bf16x2c_ __attribute__((ext_vector_type(2)));
__device__ __forceinline__ unsigned cvt_pk_bf16(float lo, float hi) { const f32x2c_ v = {lo, hi}; const bf16x2c_ b = __builtin_convertvector(v, bf16x2c_); return __builtin_bit_cast(unsigned, b); }
typedef unsigned u32x2 __attribute__((ext_vector_type(2)));
__device__ __forceinline__ float bf_lo(unsigned w) { return __uint_as_float(w << 16); }
__device__ __forceinline__ float bf_hi(unsigned w) { return __uint_as_float(w & 0xffff0000u); }
__device__ __forceinline__ float sigmoidf_(float x) { return 1.0f / (1.0f + __expf(-x)); }

constexpr int PROJ_LD = 15360;

struct EpiProj {
    static constexpr bool PERM = true, AFTER_DRAIN = false;
    bf16_t* O; float* BA;
    __device__ __forceinline__ void operator()(const f32x4 (&acc)[2][2][4][2], const Unit& u, int wr, int wc, int fr, int fq) const {
        const int row0 = u.pm * BM + wr * 64 + fr;
        if (u.pn < 60) {
            const int col0 = u.pn * BM + wc * 32 + 8 * fq;
#pragma unroll
            for (int ai = 0; ai < 2; ++ai)
#pragma unroll
                for (int m = 0; m < 4; ++m) { bf16_t* rowp = O + (size_t)(row0 + ai * HALF + m * 16) * PROJ_LD + col0;
#pragma unroll
                    for (int bj = 0; bj < 2; ++bj) { const f32x4 v0 = acc[ai][bj][m][0], v1 = acc[ai][bj][m][1];
                        u32x4 w; w.x = cvt_pk_bf16(v0[0], v0[1]); w.y = cvt_pk_bf16(v0[2], v0[3]); w.z = cvt_pk_bf16(v1[0], v1[1]); w.w = cvt_pk_bf16(v1[2], v1[3]);
                        *(u32x4*)(rowp + bj * HALF) = w; } }
        } else {
            if (wc == 0 && fq < 2) {
#pragma unroll
                for (int ai = 0; ai < 2; ++ai)
#pragma unroll
                    for (int m = 0; m < 4; ++m) { float* rowp = BA + (size_t)(row0 + ai * HALF + m * 16) * 16 + 8 * fq;
#pragma unroll
                        for (int n = 0; n < 2; ++n) *(f32x4*)(rowp + 4 * n) = acc[ai][0][m][n]; }
            }
        }
    }
};
template <int PASS> struct EpiBranch {
    static constexpr bool PERM = false, AFTER_DRAIN = false;
    const bf16_t* PROJ; float* MF; bf16_t* MB;
    __device__ __forceinline__ void operator()(const f32x4 (&acc)[2][2][4][2], const Unit& u, int wr, int wc, int fr, int fq) const {
        const int row0 = u.pm * BM + wr * 64 + fr, col0 = u.pn * BM + wc * 32 + 4 * fq;
#pragma unroll
        for (int ai = 0; ai < 2; ++ai)
#pragma unroll
            for (int mp = 0; mp < 2; ++mp) {
                u32x2 gw[2][2][2]; f32x4 mv[2][2][2];
#pragma unroll
                for (int mm = 0; mm < 2; ++mm) { const size_t row = (size_t)(row0 + ai * HALF + (2 * mp + mm) * 16);
#pragma unroll
                    for (int bj = 0; bj < 2; ++bj)
#pragma unroll
                        for (int n = 0; n < 2; ++n) { const int col = col0 + bj * HALF + n * 16;
                            gw[mm][bj][n] = *(const u32x2*)(PROJ + row * PROJ_LD + 9216 + PASS * 2048 + col);
                            if (PASS > 0) mv[mm][bj][n] = *(const f32x4*)(MF + row * 2048 + col); } }
#pragma unroll
                for (int mm = 0; mm < 2; ++mm) { const int m = 2 * mp + mm; const size_t row = (size_t)(row0 + ai * HALF + m * 16);
#pragma unroll
                    for (int bj = 0; bj < 2; ++bj)
#pragma unroll
                        for (int n = 0; n < 2; ++n) { const int col = col0 + bj * HALF + n * 16; const u32x2 g2 = gw[mm][bj][n];
                            f32x4 g; g[0] = sigmoidf_(bf_lo(g2.x)); g[1] = sigmoidf_(bf_hi(g2.x)); g[2] = sigmoidf_(bf_lo(g2.y)); g[3] = sigmoidf_(bf_hi(g2.y));
                            f32x4 v = g * acc[ai][bj][m][n];
                            if (PASS > 0) v += mv[mm][bj][n];
                            if (PASS < 2) *(f32x4*)(MF + row * 2048 + col) = v;
                            else { u32x2 w; w.x = cvt_pk_bf16(v[0], v[1]); w.y = cvt_pk_bf16(v[2], v[3]); *(u32x2*)(MB + row * 2048 + col) = w; } } }
                asm volatile("" ::: "memory"); }
    }
};
struct EpiResid {
    static constexpr bool PERM = false, AFTER_DRAIN = false;
    const float* xin; float* xout; const float* gate;
    __device__ __forceinline__ void operator()(const f32x4 (&acc)[2][2][4][2], const Unit& u, int wr, int wc, int fr, int fq) const {
        const int row0 = u.pm * BM + wr * 64 + fr, col0 = u.pn * BM + wc * 32 + 4 * fq;
        f32x4 gv[2][2];
#pragma unroll
        for (int bj = 0; bj < 2; ++bj)
#pragma unroll
            for (int n = 0; n < 2; ++n) gv[bj][n] = *(const f32x4*)(gate + col0 + bj * HALF + n * 16);
#pragma unroll
        for (int ai = 0; ai < 2; ++ai)
#pragma unroll
            for (int mp = 0; mp < 2; ++mp) { f32x4 bv[2][2][2];
#pragma unroll
                for (int mm = 0; mm < 2; ++mm) { const size_t off = (size_t)(row0 + ai * HALF + (2 * mp + mm) * 16) * 2048 + col0;
#pragma unroll
                    for (int bj = 0; bj < 2; ++bj)
#pragma unroll
                        for (int n = 0; n < 2; ++n) bv[mm][bj][n] = *(const f32x4*)(xin + off + bj * HALF + n * 16); }
#pragma unroll
                for (int mm = 0; mm < 2; ++mm) { const int m = 2 * mp + mm; const size_t off = (size_t)(row0 + ai * HALF + m * 16) * 2048 + col0;
#pragma unroll
                    for (int bj = 0; bj < 2; ++bj)
#pragma unroll
                        for (int n = 0; n < 2; ++n) *(f32x4*)(xout + off + bj * HALF + n * 16) = bv[mm][bj][n] + gv[bj][n] * acc[ai][bj][m][n]; }
                asm volatile("" ::: "memory"); }
    }
};
struct EpiRelu2 {
    static constexpr bool PERM = true, AFTER_DRAIN = false;
    bf16_t* O;
    __device__ __forceinline__ void operator()(const f32x4 (&acc)[2][2][4][2], const Unit& u, int wr, int wc, int fr, int fq) const {
        const int row0 = u.pm * BM + wr * 64 + fr, col0 = u.pn * BM + wc * 32 + 8 * fq;
#pragma unroll
        for (int ai = 0; ai < 2; ++ai)
#pragma unroll
            for (int m = 0; m < 4; ++m) { bf16_t* rowp = O + (size_t)(row0 + ai * HALF + m * 16) * 8192 + col0;
#pragma unroll
                for (int bj = 0; bj < 2; ++bj) { f32x4 v0 = acc[ai][bj][m][0], v1 = acc[ai][bj][m][1];
#pragma unroll
                    for (int j = 0; j < 4; ++j) { const float a = fmaxf(v0[j], 0.f), b = fmaxf(v1[j], 0.f); v0[j] = a * a; v1[j] = b * b; }
                    u32x4 w; w.x = cvt_pk_bf16(v0[0], v0[1]); w.y = cvt_pk_bf16(v0[2], v0[3]); w.z = cvt_pk_bf16(v1[0], v1[1]); w.w = cvt_pk_bf16(v1[2], v1[3]);
                    *(u32x4*)(rowp + bj * HALF) = w; } }
    }
};

template <class Epi, class Sched, bool STAMP = false>
__device__ __forceinline__ void gemm_phase(PG8_LAS unsigned char* lds, const Gemm g, const Sched& S, const Epi& E, unsigned long long* stamps) {
    int tid = threadIdx.x; asm volatile("" : "+v"(tid));
    const int wid = __builtin_amdgcn_readfirstlane(tid >> 6), lane = tid & 63, wr = wid >> 2, wc = wid & 3, fr = lane & 15, fq = lane >> 4;
    const int K = g.K, nt = K / BK;
    int ts_lo = 0, ts_hi = 0, nts = 0; const unsigned long long rt_entry = STAMP ? (unsigned long long)wall_clock64() : 0ull;
#define PG8_STAMP() do { if (STAMP && wid == 0 && nts < 64) { const unsigned long long _c = (unsigned long long)clock64(); \
        ts_lo = (lane == nts) ? (int)(unsigned)_c : ts_lo; ts_hi = (lane == nts) ? (int)(unsigned)(_c >> 32) : ts_hi; ++nts; } } while (0)
    PG8_STAMP();
    unsigned voffA[2], voffB[2];
#pragma unroll
    for (int i = 0; i < 2; ++i) { int R, C; stage_rc(tid * 16 + i * 8192, R, C); const int Rb = Epi::PERM ? ((R & ~31) + perm32(R & 31)) : R;
        voffA[i] = (unsigned)(R * K + C) * 2u; voffB[i] = (unsigned)(Rb * K + C) * 2u; }
    const size_t kstep = (size_t)(BK * 2);
    const size_t hstep = (size_t)HALF * K * 2;
    const size_t tstep = 2 * hstep;
    const unsigned ldsw = (unsigned)wid * 1024u;
    const int aoff = lds_byte(wr * 64 + fr, fq * 8), boff = lds_byte(wc * 32 + fr, fq * 8);
#define PG8_SA(b, h) (((b) * 2 + (h)) * HTB)
#define PG8_SB(b, h) ((4 + (b) * 2 + (h)) * HTB)
#define PG8_STAGE(bufoff, gbase, voff) do { _Pragma("unroll") for (int _i = 0; _i < 2; ++_i) \
        __builtin_amdgcn_global_load_lds((const unsigned*)((const char*)(gbase) + (voff)[_i]), (PG8_LAS unsigned*)(lds + (bufoff) + ldsw + _i * 8192), 16, 0, 0); } while (0)
#define PG8_LDA(dst, b, h) do { _Pragma("unroll") for (int m = 0; m < 4; ++m) _Pragma("unroll") for (int k = 0; k < 2; ++k) dst[m][k] = *(const PG8_LAS bf16x8*)(lds + PG8_SA(b, h) + aoff + m * 2048 + k * 1024); } while (0)
#define PG8_LDB(dst, b, h) do { _Pragma("unroll") for (int n = 0; n < 2; ++n) _Pragma("unroll") for (int k = 0; k < 2; ++k) dst[n][k] = *(const PG8_LAS bf16x8*)(lds + PG8_SB(b, h) + boff + n * 2048 + k * 1024); } while (0)
#define PG8_MMA(ai, bj, At, Bt) do { __builtin_amdgcn_s_setprio(1); _Pragma("unroll") for (int m = 0; m < 4; ++m) _Pragma("unroll") for (int n = 0; n < 2; ++n) _Pragma("unroll") for (int k = 0; k < 2; ++k) \
        acc[ai][bj][m][n] = __builtin_amdgcn_mfma_f32_16x16x32_bf16(Bt[n][k], At[m][k], acc[ai][bj][m][n], 0, 0, 0); __builtin_amdgcn_s_setprio(0); } while (0)
#define PG8_WAIT_V(n) asm volatile("s_waitcnt vmcnt(" #n ")" ::: "memory")
#define PG8_WAIT_L(n) asm volatile("s_waitcnt lgkmcnt(" #n ")" ::: "memory")
#define PG8_BAR __builtin_amdgcn_s_barrier()
#define PG8_SCHED __builtin_amdgcn_sched_barrier(0)
    Unit cur, nxt; int ui = 0;
    if (!S.next(0, cur)) return;
    f32x4 acc[2][2][4][2];
#pragma unroll
    for (int a = 0; a < 2; ++a)
#pragma unroll
        for (int b = 0; b < 2; ++b)
#pragma unroll
            for (int m = 0; m < 4; ++m)
#pragma unroll
                for (int n = 0; n < 2; ++n) acc[a][b][m][n] = (f32x4){0.f, 0.f, 0.f, 0.f};
    bf16x8 At[4][2], B0[2][2], B1[2][2];
    const char* cA = (const char*)g.A + (size_t)cur.pm * tstep; const char* cB = (const char*)g.Bt + (size_t)cur.pn * tstep;
    S.a_ready(cur);
    PG8_STAGE(PG8_SB(0, 0), cB, voffB); PG8_STAGE(PG8_SA(0, 0), cA, voffA); PG8_STAGE(PG8_SB(0, 1), cB + hstep, voffB); PG8_STAGE(PG8_SA(0, 1), cA + hstep, voffA);
    if (wr == 1) PG8_BAR;
    PG8_WAIT_V(4); PG8_BAR;
    PG8_STAGE(PG8_SB(1, 0), cB + kstep, voffB); PG8_STAGE(PG8_SA(1, 0), cA + kstep, voffA); PG8_STAGE(PG8_SB(1, 1), cB + hstep + kstep, voffB);
    PG8_WAIT_V(6); PG8_BAR;
    PG8_STAMP();
    for (;;) {
        const bool has_next = S.next(ui + 1, nxt);
        const char* nA = has_next ? (const char*)g.A + (size_t)nxt.pm * tstep : cA; const char* nB = has_next ? (const char*)g.Bt + (size_t)nxt.pn * tstep : cB;
        for (int t = 0; t < nt; t += 2) {
            const bool last = (t == nt - 2);
            const char* a1 = cA + (size_t)(t + 1) * kstep;
            const char* a2 = last ? nA : cA + (size_t)(t + 2) * kstep; const char* b2 = last ? nB : cB + (size_t)(t + 2) * kstep;
            const char* a3 = a2 + kstep; const char* b3 = b2 + kstep;
            if (last && has_next) S.a_ready(nxt);
            PG8_LDB(B0, 0, 0); PG8_SCHED; PG8_LDA(At, 0, 0); PG8_STAGE(PG8_SA(1, 1), a1 + hstep, voffA);
            PG8_WAIT_L(8); PG8_BAR; PG8_WAIT_L(0); PG8_MMA(0, 0, At, B0); PG8_BAR; PG8_SCHED;
            PG8_LDB(B1, 0, 1); PG8_STAGE(PG8_SB(0, 0), b2, voffB);
            PG8_BAR; PG8_WAIT_L(0); PG8_MMA(0, 1, At, B1); PG8_BAR;
            PG8_LDA(At, 0, 1); PG8_STAGE(PG8_SA(0, 0), a2, voffA);
            PG8_BAR; PG8_WAIT_L(0); PG8_MMA(1, 0, At, B0); PG8_BAR; PG8_SCHED;
            PG8_STAGE(PG8_SB(0, 1), b2 + hstep, voffB);
            PG8_WAIT_V(6); PG8_BAR; PG8_MMA(1, 1, At, B1); PG8_BAR;
            PG8_LDB(B0, 1, 0); PG8_SCHED; PG8_LDA(At, 1, 0); PG8_STAGE(PG8_SA(0, 1), a2 + hstep, voffA);
            PG8_WAIT_L(8); PG8_BAR; PG8_WAIT_L(0); PG8_MMA(0, 0, At, B0); PG8_BAR; PG8_SCHED;
            PG8_LDB(B1, 1, 1); PG8_STAGE(PG8_SB(1, 0), b3, voffB);
            PG8_BAR; PG8_WAIT_L(0); PG8_MMA(0, 1, At, B1); PG8_BAR;
            PG8_LDA(At, 1, 1); PG8_STAGE(PG8_SA(1, 0), a3, voffA);
            PG8_BAR; PG8_WAIT_L(0); PG8_MMA(1, 0, At, B0); PG8_BAR; PG8_SCHED;
            PG8_STAGE(PG8_SB(1, 1), b3 + hstep, voffB);
            PG8_WAIT_V(6); PG8_BAR; PG8_MMA(1, 1, At, B1); PG8_BAR;
        }
        PG8_STAMP();
        if constexpr (!Epi::AFTER_DRAIN) { E(acc, cur, wr, wc, fr, fq); S.done(cur); }
        PG8_STAMP();
        if (!has_next) break;
#pragma unroll
        for (int a = 0; a < 2; ++a)
#pragma unroll
            for (int b = 0; b < 2; ++b)
#pragma unroll
                for (int m = 0; m < 4; ++m)
#pragma unroll
                    for (int n = 0; n < 2; ++n) acc[a][b][m][n] = (f32x4){0.f, 0.f, 0.f, 0.f};
        cur = nxt; cA = nA; cB = nB; ++ui;
    }
    PG8_WAIT_V(0);
    if (wr == 0) PG8_BAR;
    PG8_BAR;
    if constexpr (Epi::AFTER_DRAIN) { E.fused(acc, cur, wr, wc, fr, fq, lds, wid, lane); S.done(cur); }
    PG8_STAMP();
    if (STAMP && wid == 0) { stamps[lane] = lane < nts ? (((unsigned long long)(unsigned)ts_hi << 32) | (unsigned)ts_lo) : 0ull;
        if (lane == 62) stamps[62] = rt_entry; if (lane == 63) stamps[63] = (unsigned long long)wall_clock64(); }
#undef PG8_STAMP
#undef PG8_SA
#undef PG8_SB
#undef PG8_STAGE
#undef PG8_LDA
#undef PG8_LDB
#undef PG8_MMA
#undef PG8_WAIT_V
#undef PG8_WAIT_L
#undef PG8_BAR
#undef PG8_SCHED
}
}
using namespace pg8;
namespace cg = cooperative_groups;
#define LAS PG8_LAS
#define DI __device__ __forceinline__

constexpr int T_ = 8192, D_ = 2048, INW = 15376, NP1 = 15616, DFF = 8192;
constexpr int LDS_BYTES = 147456;
constexpr int NTHR = 512;
constexpr float EPS = 1e-6f;

constexpr size_t SZ_WT_IN = (size_t)NP1 * 2048 * 2, SZ_WT_BR = (size_t)2048 * 1024 * 2, SZ_WT_O = (size_t)2048 * 2048 * 2, SZ_WT_M = (size_t)8192 * 2048 * 2;
constexpr size_t SZ_WL = SZ_WT_IN + 3 * SZ_WT_BR + SZ_WT_O + 2 * SZ_WT_M;
constexpr size_t WS_W = 0;
constexpr size_t WS_MOD = WS_W + 2 * SZ_WL;
constexpr size_t WS_XC = WS_MOD + 2 * 12288 * 4;
constexpr size_t WS_H = WS_XC + (size_t)T_ * D_ * 4;
constexpr size_t WS_PROJ = WS_H + (size_t)T_ * D_ * 2;
constexpr size_t WS_BA = WS_PROJ + (size_t)T_ * 15360 * 2;
constexpr size_t WS_R2 = WS_BA + (size_t)T_ * 16 * 4;
constexpr size_t G_A = WS_R2;
constexpr size_t G_BT = G_A + (size_t)T_ * 2048 * 2;
constexpr size_t G_C = G_BT + (size_t)T_ * 2048 * 2;
constexpr size_t G_D = G_C + (size_t)T_ * 1024 * 2;
constexpr size_t G_GL = G_D + (size_t)T_ * 1024 * 2;
constexpr size_t R_SC = G_GL + 4096;
constexpr size_t R_QI = R_SC + (size_t)T_ * 256 * 2;
constexpr size_t R_VT = R_QI + (size_t)T_ * 512 * 2;
constexpr size_t WS_R3 = R_VT + (size_t)T_ * 1024 * 2;
constexpr size_t WS_OA = WS_R3;
constexpr size_t WS_OB = WS_OA + (size_t)T_ * 1024 * 4;
constexpr size_t WS_CV = WS_OB + (size_t)T_ * 1024 * 4;
constexpr size_t WS_ACT = WS_CV + (size_t)T_ * 1024 * 4;
constexpr size_t WS_MB = WS_ACT + 3 * (size_t)T_ * 1024 * 2;
constexpr size_t WS_BAR = WS_MB + (size_t)T_ * D_ * 2;
constexpr size_t WS_PROG = WS_BAR + 16384;
constexpr size_t WS_END = WS_PROG + 16384;
constexpr size_t R_P = WS_OA;
constexpr size_t G_S = WS_H;
constexpr size_t R_RT = WS_MB;
constexpr size_t WS_MF = WS_R2;
static_assert(WS_MF + (size_t)T_ * D_ * 4 <= WS_R3, "merged f32 alias");

struct Params {
    const float* x; const float* c; const int* pos; const float* w_ada; const float* b_ada; const float* norm_mix_w; const float* norm_mlp_w; const float* w_in;
    const float* conv_qkv_w; const float* a_log; const float* dt_bias; const float* gdn_norm_w; const float* conv_dw_w; const float* conv_dw_b; const float* conv_ln_w; const float* conv_ln_b;
    const float* w_a; const float* w_b; const float* w_c; const float* w_out; const float* w_mi; const float* w_mo; const float* final_w;
    float* out; unsigned char* ws; int ph_lo, ph_hi;
};

DI unsigned pk2(float lo, float hi) { return cvt_pk_bf16(lo, hi); }
DI bf16_t f2bf(float f) { return (bf16_t)(cvt_pk_bf16(f, 0.f) & 0xffffu); }
DI float siluf_(float x) { return x / (1.0f + __expf(-x)); }
DI float ret_lg2(int hr) { return hr == 0 ? -0.04580368961312479f : hr == 1 ? -0.02272007650008353f : hr == 2 ? -0.011315313227834146f : -0.005646563141142063f; }
DI float wave_sum(float v) {
#pragma unroll
    for (int o = 1; o < 64; o <<= 1) v += __shfl_xor(v, o);
    return v;
}
DI void lds_barrier() { asm volatile("s_waitcnt lgkmcnt(0)" ::: "memory"); __builtin_amdgcn_s_barrier(); asm volatile("" ::: "memory"); }
DI void full_barrier() { asm volatile("s_waitcnt vmcnt(0) lgkmcnt(0)" ::: "memory"); __builtin_amdgcn_s_barrier(); asm volatile("" ::: "memory"); }
DI f32x4 mfma16(bf16x8 a, bf16x8 b, f32x4 c) { return __builtin_amdgcn_mfma_f32_16x16x32_bf16(a, b, c, 0, 0, 0); }
DI bf16x8 lds_frag(LAS unsigned char* base, int row, int stride_el, int k0) { return *(const LAS bf16x8*)(base + ((size_t)row * stride_el + k0) * 2); }
DI void unpack8(const u32x4 w, float (&f)[8]) { f[0] = bf_lo(w.x); f[1] = bf_hi(w.x); f[2] = bf_lo(w.y); f[3] = bf_hi(w.y); f[4] = bf_lo(w.z); f[5] = bf_hi(w.z); f[6] = bf_lo(w.w); f[7] = bf_hi(w.w); }
DI u32x4 pack8(const float* f) { u32x4 w; w.x = pk2(f[0], f[1]); w.y = pk2(f[2], f[3]); w.z = pk2(f[4], f[5]); w.w = pk2(f[6], f[7]); return w; }

#define XB_TMO      128
#define XB_XCNT(j)  (256  + 64 * (j))
#define XB_XSUB(j)  (1280 + 64 * (j))
#define XB_XGEN(j)  (2304 + 64 * (j))
#define XB_TOP      3328
#define XB_TOPGEN   3392
#define XCD_BAR_WORDS 3456
#define XB_SPIN_CAP (1u << 18)


__device__ __forceinline__ unsigned xb_ld(unsigned* p)              { return __hip_atomic_load(p, __ATOMIC_RELAXED, __HIP_MEMORY_SCOPE_AGENT); }
__device__ __forceinline__ unsigned xb_add(unsigned* p, unsigned v) { return __hip_atomic_fetch_add(p, v, __ATOMIC_RELAXED, __HIP_MEMORY_SCOPE_AGENT); }
__device__ __forceinline__ unsigned xb_xcc_id() { return (unsigned)__builtin_amdgcn_s_getreg((3 << 11) | 20) & 0xFu; }
#define XB_SPIN(cond, bar) do { unsigned _sp = 0; while (cond) { __builtin_amdgcn_s_sleep(1); \
    if ((++_sp & 255u) == 0u) { if (xb_ld(&(bar)[XB_TMO])) break; if (_sp > XB_SPIN_CAP) { atomicAdd(&(bar)[XB_TMO], 1u); break; } } } } while (0)

struct XcdBarrier {
    unsigned* bar; unsigned x;
    volatile LAS unsigned* st;
};

__device__ __forceinline__ XcdBarrier xcd_barrier_post(unsigned* bar, volatile LAS unsigned* st) {
    XcdBarrier b; b.bar = bar; b.x = xb_xcc_id(); b.st = st;
    if (threadIdx.x == 0) (void)xb_add(&bar[XB_XCNT(b.x)], 1u);
    return b;
}
__device__ __forceinline__ void xcd_barrier_complete(unsigned* bar, unsigned x, unsigned& nloc, unsigned& nx) {
    const unsigned G = gridDim.x * gridDim.y * gridDim.z;
    unsigned sum, cnt, mine, sp = 0u;
    for (;;) {
        sum = 0u; cnt = 0u; mine = 0u;
#pragma unroll
        for (unsigned j = 0; j < 16; ++j) { const unsigned c = xb_ld(&bar[XB_XCNT(j)]); sum += c; cnt += (c > 0u) ? 1u : 0u; mine = (j == x) ? c : mine; }
        if (sum == G) break;
        __builtin_amdgcn_s_sleep(1);
        if ((++sp & 255u) == 0u) { if (xb_ld(&bar[XB_TMO])) break; if (sp > XB_SPIN_CAP) { atomicAdd(&bar[XB_TMO], 1u); break; } }
    }
    nloc = mine > 0u ? mine : 1u; nx = cnt > 0u ? cnt : 1u;
}

__device__ __forceinline__ void xcd_barrier(const XcdBarrier& b) {
    asm volatile("s_waitcnt vmcnt(0)" ::: "memory");
    __syncthreads();
    if (threadIdx.x == 0) {
        unsigned* bar = b.bar;
        __builtin_amdgcn_s_waitcnt(0);
        unsigned nloc = b.st[0], nx = b.st[1];
        if (nloc == 0u) { xcd_barrier_complete(bar, b.x, nloc, nx); b.st[0] = nloc; b.st[1] = nx; }
        const unsigned old = xb_add(&bar[XB_XSUB(b.x)], 1u);
        const unsigned gen = old / nloc;
        if (old + 1u == (gen + 1u) * nloc) {
            __builtin_amdgcn_fence(__ATOMIC_RELEASE, "agent");
            asm volatile("s_waitcnt vmcnt(0)" ::: "memory");
            const unsigned og = xb_add(&bar[XB_TOP], 1u);
            const unsigned tg = og / nx;
            if (og + 1u == (tg + 1u) * nx) xb_add(&bar[XB_TOPGEN], 1u);
            else XB_SPIN(xb_ld(&bar[XB_TOPGEN]) == tg, bar);
            __builtin_amdgcn_fence(__ATOMIC_ACQUIRE, "agent");
            xb_add(&bar[XB_XGEN(b.x)], 1u);
            asm volatile("s_waitcnt vmcnt(0)" ::: "memory");
        } else {
            XB_SPIN(xb_ld(&bar[XB_XGEN(b.x)]) == gen, bar);
            __builtin_amdgcn_fence(__ATOMIC_ACQUIRE, "agent");
            asm volatile("s_waitcnt vmcnt(0)" ::: "memory");
        }
    }
    __syncthreads();
}


DI void transpose_item(const float* W, int ldw, int K, int src_col0, int valid, bf16_t* WT, int dst_row0, int k0, LAS float* scr, int lane) {
    const int nn = lane & 31;
    float tv[64];
#pragma unroll
    for (int i = 0; i < 64; ++i) { const int kk = 2 * i + (lane >> 5);
        tv[i] = 0.f; if (nn < valid) tv[i] = W[(size_t)(k0 + kk) * ldw + src_col0 + nn]; }
#pragma unroll
    for (int i = 0; i < 64; ++i) { const int kk = 2 * i + (lane >> 5); scr[kk * 33 + nn] = tv[i]; }
    asm volatile("s_waitcnt lgkmcnt(0)" ::: "memory");
    const int c = lane & 15;
#pragma unroll
    for (int j = 0; j < 8; ++j) { const int n = (lane >> 4) + 4 * j; const LAS float* s = scr + (8 * c) * 33 + n;
        u32x4 o; o.x = pk2(s[0 * 33], s[1 * 33]); o.y = pk2(s[2 * 33], s[3 * 33]); o.z = pk2(s[4 * 33], s[5 * 33]); o.w = pk2(s[6 * 33], s[7 * 33]);
        *(u32x4*)(WT + (size_t)(dst_row0 + n) * K + k0 + 8 * c) = o; }
    asm volatile("s_waitcnt lgkmcnt(0)" ::: "memory");
}

DI void phase_prep(const Params& p, unsigned char* wsp, LAS unsigned char* lds, int tid) {
    const int lane = tid & 63, wave = tid >> 6, G = gridDim.x, b = blockIdx.x;
    float* mod = (float*)(wsp + WS_MOD);
    for (int u = b; u < 192; u += G) {
        const int l = u / 96, strip = u % 96, kg = tid >> 5, cl = tid & 31, col = 128 * strip + 4 * cl;
        f32x4 acc = {0.f, 0.f, 0.f, 0.f};
        const float* wp = p.w_ada + (size_t)l * 2048 * 12288 + col;
#pragma unroll 16
        for (int k = kg; k < 2048; k += 16) { const float s = siluf_(p.c[k]); const f32x4 w = *(const f32x4*)(wp + (size_t)k * 12288); acc += s * w; }
        LAS f32x4* red = (LAS f32x4*)lds;
        red[kg * 32 + cl] = acc;
        lds_barrier();
        if (tid < 128) { float s = 0.f; const LAS float* rf = (const LAS float*)lds;
#pragma unroll
            for (int g = 0; g < 16; ++g) s += rf[g * 128 + tid];
            mod[l * 12288 + 128 * strip + tid] = s + p.b_ada[l * 12288 + 128 * strip + tid]; }
        lds_barrier();
    }
    LAS float* scr = (LAS float*)(lds + wave * 17408);
    const int gw = b * 8 + wave, NGW = G * 8;
    constexpr int I_IN = 488 * 16, I_BR = 64 * 8, I_O = 64 * 16, I_MI = 256 * 16, I_MO = 64 * 64, I_L = I_IN + 3 * I_BR + I_O + I_MI + I_MO;
    for (int it = gw; it < 2 * I_L; it += NGW) {
        const int l = it / I_L; int r = it % I_L;
        unsigned char* wl = wsp + WS_W + (size_t)l * SZ_WL;
        if (r < I_IN) { const int kb = r / 488, nb = r % 488, d0 = 32 * nb; int src, valid;
            if (d0 < 4096) { src = d0; valid = 32; } else if (d0 < 15360) { src = d0 + 16; valid = 32; } else if (d0 == 15360) { src = 4096; valid = 16; } else { src = 0; valid = 0; }
            transpose_item(p.w_in + (size_t)l * 2048 * INW, INW, 2048, src, valid, (bf16_t*)wl, d0, 128 * kb, scr, lane); continue; }
        r -= I_IN;
        if (r < 3 * I_BR) { const int which = r / I_BR, q = r % I_BR, kb = q / 64, nb = q % 64;
            const float* W = (which == 0 ? p.w_a : which == 1 ? p.w_b : p.w_c) + (size_t)l * 1024 * 2048;
            transpose_item(W, 2048, 1024, 32 * nb, 32, (bf16_t*)(wl + SZ_WT_IN + which * SZ_WT_BR), 32 * nb, 128 * kb, scr, lane); continue; }
        r -= 3 * I_BR;
        if (r < I_O) { const int kb = r / 64, nb = r % 64;
            transpose_item(p.w_out + (size_t)l * 2048 * 2048, 2048, 2048, 32 * nb, 32, (bf16_t*)(wl + SZ_WT_IN + 3 * SZ_WT_BR), 32 * nb, 128 * kb, scr, lane); continue; }
        r -= I_O;
        if (r < I_MI) { const int kb = r / 256, nb = r % 256;
            transpose_item(p.w_mi + (size_t)l * 2048 * 8192, 8192, 2048, 32 * nb, 32, (bf16_t*)(wl + SZ_WT_IN + 3 * SZ_WT_BR + SZ_WT_O), 32 * nb, 128 * kb, scr, lane); continue; }
        r -= I_MI;
        { const int kb = r / 64, nb = r % 64;
            transpose_item(p.w_mo + (size_t)l * 8192 * 2048, 2048, 8192, 32 * nb, 32, (bf16_t*)(wl + SZ_WT_IN + 3 * SZ_WT_BR + SZ_WT_O + SZ_WT_M), 32 * nb, 128 * kb, scr, lane); }
    }
}

DI void phase_norm(const float* xin, const float* nw, const float* scale, const float* shift, bf16_t* H, float* outf, int tid) {
    const int lane = tid & 63, wave = tid >> 6, gw = blockIdx.x * 8 + wave, NGW = gridDim.x * 8;
    for (int row0 = gw; row0 < T_; row0 += 2 * NGW) {
        const int row1 = (row0 + NGW < T_) ? row0 + NGW : row0;
        f32x4 v[2][8]; float ss[2] = {0.f, 0.f};
#pragma unroll
        for (int r = 0; r < 2; ++r) { const float* xr = xin + (size_t)(r ? row1 : row0) * D_;
#pragma unroll
            for (int j = 0; j < 8; ++j) v[r][j] = *(const f32x4*)(xr + (j * 64 + lane) * 4); }
#pragma unroll
        for (int r = 0; r < 2; ++r) {
#pragma unroll
            for (int j = 0; j < 8; ++j) ss[r] += (v[r][j][0] * v[r][j][0] + v[r][j][1] * v[r][j][1]) + (v[r][j][2] * v[r][j][2] + v[r][j][3] * v[r][j][3]);
            ss[r] = wave_sum(ss[r]); }
#pragma unroll
        for (int r = 0; r < 2; ++r) { const int row = r ? row1 : row0; if (r == 1 && row1 == row0) break;
            const float rstd = 1.0f / sqrtf(ss[r] * (1.0f / D_) + EPS);
#pragma unroll
            for (int j = 0; j < 8; ++j) { const int c = (j * 64 + lane) * 4; const f32x4 w = *(const f32x4*)(nw + c);
                f32x4 y = v[r][j] * rstd * w;
                if (H) { const f32x4 sc = *(const f32x4*)(scale + c), sh = *(const f32x4*)(shift + c); y = y * (1.0f + sc) + sh;
                    u32x2 o; o.x = pk2(y[0], y[1]); o.y = pk2(y[2], y[3]); *(u32x2*)(H + (size_t)row * D_ + c) = o; }
                else *(f32x4*)(outf + (size_t)row * D_ + c) = y; } }
    }
}

DI void gdn_prep_unit(const Params& p, unsigned char* wsp, int l, int hh, int n, LAS unsigned char* lds, int tid) {
    asm volatile("" : "+v"(tid));
    const int lane = tid & 63, wave = tid >> 6, quad = lane >> 4, l15 = lane & 15;
    const int r = tid >> 3, cgp = tid & 7, t = 64 * n + r;
    constexpr int K_OFF = 0, KB_OFF = 17408, Q_OFF = 34816, VBT_OFF = 52224, KBGT_OFF = 70656, KDT_OFF = 89088, T_OFF = 107520, L_OFF = 116736, SG_OFF = 134144, SB_OFF = SG_OFF + 256, GC_OFF = SB_OFF + 256;
    constexpr int ATTI_OFF = 135168, WT_OFF = K_OFF, UT_OFF = KB_OFF;
    static_assert(ATTI_OFF + 9216 <= LDS_BYTES - 16, "lds");
    const bf16_t* PROJ = (const bf16_t*)(wsp + WS_PROJ); const float* BA = (const float*)(wsp + WS_BA);
    const size_t ub = (size_t)hh * 128 + n;
    u32x4 pa[3][4][2];
#pragma unroll
    for (int X = 0; X < 3; ++X) { const int ch = X * 1024 + hh * 128 + 16 * cgp;
#pragma unroll
        for (int j = 0; j < 4; ++j) { const int tt = t - 3 + j; pa[X][j][0] = (u32x4){0u, 0u, 0u, 0u}; pa[X][j][1] = (u32x4){0u, 0u, 0u, 0u};
            if (tt >= 0) { pa[X][j][0] = *(const u32x4*)(PROJ + (size_t)tt * PROJ_LD + ch); pa[X][j][1] = *(const u32x4*)(PROJ + (size_t)tt * PROJ_LD + ch + 8); } } }
    float ba_b = 0.f, ba_a = 0.f;
    if (cgp == 0) { ba_b = BA[(size_t)t * 16 + hh]; ba_a = BA[(size_t)t * 16 + 8 + hh]; }
    {   LAS float* CW = (LAS float*)lds;
#pragma unroll
        for (int i = 0; i < 3; ++i) { const int f = tid + 512 * i, X = f >> 9, j = (f >> 7) & 3, c = f & 127;
            CW[f] = p.conv_qkv_w[((size_t)l * 4 + j) * 3072 + X * 1024 + hh * 128 + c]; } }
    lds_barrier();
    float val[3][16];
#pragma unroll
    for (int X = 0; X < 3; ++X) {
#pragma unroll
        for (int i = 0; i < 16; ++i) val[X][i] = 0.f;
#pragma unroll
        for (int j = 0; j < 4; ++j) { float xa[8], xb[8]; unpack8(pa[X][j][0], xa); unpack8(pa[X][j][1], xb);
            const LAS float* cw = (const LAS float*)lds + X * 512 + j * 128 + 16 * cgp;
#pragma unroll
            for (int q4 = 0; q4 < 4; ++q4) { const f32x4 w = *(const LAS f32x4*)(cw + 4 * q4);
#pragma unroll
                for (int e = 0; e < 4; ++e) { const int i = 4 * q4 + e; val[X][i] += w[e] * (i < 8 ? xa[i] : xb[i - 8]); } } }
#pragma unroll
        for (int i = 0; i < 16; ++i) val[X][i] = siluf_(val[X][i]);
    }
    {   float sq = 0.f, sk = 0.f;
#pragma unroll
        for (int i = 0; i < 16; ++i) { sq += val[0][i] * val[0][i]; sk += val[1][i] * val[1][i]; }
        sq += __shfl_xor(sq, 1); sq += __shfl_xor(sq, 2); sq += __shfl_xor(sq, 4);
        sk += __shfl_xor(sk, 1); sk += __shfl_xor(sk, 2); sk += __shfl_xor(sk, 4);
        const float rq = (1.0f / sqrtf(sq + 1e-6f)) * 0.08838834764831845f, rk = 1.0f / sqrtf(sk + 1e-6f);
#pragma unroll
        for (int i = 0; i < 16; ++i) { val[0][i] *= rq; val[1][i] *= rk; }
    }
    LAS float* SG = (LAS float*)(lds + SG_OFF); LAS float* SB = (LAS float*)(lds + SB_OFF); LAS float* GC = (LAS float*)(lds + GC_OFF);
    if (cgp == 0) { const float ab = ba_b, aa = ba_a;
        const float xx = aa + p.dt_bias[l * 8 + hh]; const float sp = xx > 20.f ? xx : __logf(1.0f + __expf(xx));
        SG[r] = -expf(p.a_log[l * 8 + hh]) * sp; SB[r] = 1.0f / (1.0f + expf(-ab)); }
    lds_barrier();
    if (wave == 0) { float xg = SG[lane];
#pragma unroll
        for (int o = 1; o < 64; o <<= 1) { const float y = __shfl_up(xg, o); if (lane >= o) xg += y; }
        GC[lane] = xg; }
    lds_barrier();
    {   const float bta = SB[r], gcr = GC[r], glast = GC[63], eg = expf(gcr), ekd = expf(glast - gcr);
        float tq[16], tk[16], tkb[16];
#pragma unroll
        for (int i = 0; i < 16; ++i) { tq[i] = val[0][i]; tk[i] = val[1][i]; tkb[i] = val[1][i] * bta; }
        *(LAS u32x4*)(lds + K_OFF + (r * 136 + 16 * cgp) * 2) = pack8(tk); *(LAS u32x4*)(lds + K_OFF + (r * 136 + 16 * cgp + 8) * 2) = pack8(tk + 8);
        *(LAS u32x4*)(lds + KB_OFF + (r * 136 + 16 * cgp) * 2) = pack8(tkb); *(LAS u32x4*)(lds + KB_OFF + (r * 136 + 16 * cgp + 8) * 2) = pack8(tkb + 8);
        *(LAS u32x4*)(lds + Q_OFF + (r * 136 + 16 * cgp) * 2) = pack8(tq); *(LAS u32x4*)(lds + Q_OFF + (r * 136 + 16 * cgp + 8) * 2) = pack8(tq + 8);
#pragma unroll
        for (int i = 0; i < 16; ++i) { const int e = 16 * cgp + i;
            const int rs = (((r >> 3) ^ cgp) << 3) + (r & 7);
            *(LAS bf16_t*)(lds + VBT_OFF + (e * 72 + rs) * 2) = f2bf(val[2][i] * bta);
            *(LAS bf16_t*)(lds + KBGT_OFF + (e * 72 + rs) * 2) = f2bf(tkb[i] * eg);
            *(LAS bf16_t*)(lds + KDT_OFF + (e * 72 + rs) * 2) = f2bf(tk[i] * ekd); }
        if (tid == 0) ((float*)(wsp + G_GL))[ub] = expf(glast);
    }
    lds_barrier();
    LAS float* Lm = (LAS float*)(lds + L_OFF);
#pragma unroll
    for (int tt = 0; tt < 2; ++tt) { const int id = 2 * wave + tt, mi = id >> 2, ni = id & 3;
        f32x4 aK = {0.f, 0.f, 0.f, 0.f}, aA = {0.f, 0.f, 0.f, 0.f};
#pragma unroll
        for (int ks = 0; ks < 4; ++ks) { const bf16x8 kf = lds_frag(lds + K_OFF, 16 * ni + l15, 136, 32 * ks + 8 * quad);
            const bf16x8 kbf = lds_frag(lds + KB_OFF, 16 * mi + l15, 136, 32 * ks + 8 * quad), qf = lds_frag(lds + Q_OFF, 16 * mi + l15, 136, 32 * ks + 8 * quad);
            aK = mfma16(kbf, kf, aK);
            aA = mfma16(kf, qf, aA); }
        { const int s = 16 * ni + l15; const float gs = GC[s];
#pragma unroll
            for (int j = 0; j < 4; ++j) { const int c = 16 * mi + 4 * quad + j; Lm[c * 68 + s] = (c > s) ? aK[j] * expf(GC[c] - gs) : 0.f; } }
        { const int c = 16 * mi + l15; const float gcc = GC[c]; float o[4];
#pragma unroll
            for (int j = 0; j < 4; ++j) { const int s = 16 * ni + 4 * quad + j; o[j] = (c >= s) ? aA[j] * expf(gcc - GC[s]) : 0.f; }
            u32x2 w; w.x = pk2(o[0], o[1]); w.y = pk2(o[2], o[3]);
            *(LAS u32x2*)(lds + ATTI_OFF + (c * 72 + 16 * ni + 4 * quad) * 2) = w; }
    }
    lds_barrier();
    if (wave == 0) {
        float Tc[64];
        int zoff; asm volatile("v_mov_b32 %0, 0" : "=v"(zoff));
        const LAS float* Lz = Lm + zoff;
#pragma unroll
        for (int i = 0; i < 64; ++i) { float a = (lane == i) ? 1.f : 0.f;
#pragma unroll
            for (int j4 = 0; j4 < (i + 3) / 4; ++j4) { const f32x4 lv = *(const LAS f32x4*)(Lz + i * 68 + 4 * j4);
#pragma unroll
                for (int jj = 0; jj < 4; ++jj) if (4 * j4 + jj < i) a -= lv[jj] * Tc[4 * j4 + jj]; }
            Tc[i] = a; if ((i & 3) == 3) asm volatile("" ::: "memory"); }
#pragma unroll
        for (int i = 0; i < 64; ++i) *(LAS bf16_t*)(lds + T_OFF + (i * 72 + lane) * 2) = f2bf(Tc[i]);
    }
    lds_barrier();
    {   bf16x8 vf[2], gf[2];
#pragma unroll
        for (int ks = 0; ks < 2; ++ks) { vf[ks] = lds_frag(lds + VBT_OFF, 16 * wave + l15, 72, 8 * ((4 * ks + quad) ^ wave)); gf[ks] = lds_frag(lds + KBGT_OFF, 16 * wave + l15, 72, 8 * ((4 * ks + quad) ^ wave)); }
#pragma unroll
        for (int mi = 0; mi < 4; ++mi) { f32x4 aU = {0.f, 0.f, 0.f, 0.f}, aW = {0.f, 0.f, 0.f, 0.f};
#pragma unroll
            for (int ks = 0; ks < 2; ++ks) { const bf16x8 tf = lds_frag(lds + T_OFF, 16 * mi + l15, 72, 32 * ks + 8 * quad);
                aU = mfma16(tf, vf[ks], aU); aW = mfma16(tf, gf[ks], aW); }
            u32x2 wu; wu.x = pk2(aU[0], aU[1]); wu.y = pk2(aU[2], aU[3]);
            u32x2 ww; ww.x = pk2(aW[0], aW[1]); ww.y = pk2(aW[2], aW[3]);
            *(LAS u32x2*)(lds + UT_OFF + ((16 * wave + l15) * 64 + 16 * mi + 4 * quad) * 2) = wu;
            *(LAS u32x2*)(lds + WT_OFF + ((16 * wave + l15) * 64 + 16 * mi + 4 * quad) * 2) = ww; }
    }
    lds_barrier();
    {   bf16x8 kdf[2], wtf[2], utf[2];
#pragma unroll
        for (int ks = 0; ks < 2; ++ks) { kdf[ks] = lds_frag(lds + KDT_OFF, 16 * wave + l15, 72, 8 * ((4 * ks + quad) ^ wave));
            wtf[ks] = lds_frag(lds + WT_OFF, 16 * wave + l15, 64, 32 * ks + 8 * quad); utf[ks] = lds_frag(lds + UT_OFF, 16 * wave + l15, 64, 32 * ks + 8 * quad); }
        bf16_t* GA = (bf16_t*)(wsp + G_A) + ub * 16384; bf16_t* GB = (bf16_t*)(wsp + G_BT) + ub * 16384;
        bf16_t* GCp = (bf16_t*)(wsp + G_C) + ub * 8192; bf16_t* GD = (bf16_t*)(wsp + G_D) + ub * 8192;
#pragma unroll
        for (int t2 = 0; t2 < 8; ++t2) {
            f32x4 aA = {0.f, 0.f, 0.f, 0.f}, aB = {0.f, 0.f, 0.f, 0.f};
#pragma unroll
            for (int ks = 0; ks < 2; ++ks) { const bf16x8 wx = lds_frag(lds + WT_OFF, 16 * t2 + l15, 64, 32 * ks + 8 * quad), kx = lds_frag(lds + KDT_OFF, 16 * t2 + l15, 72, 8 * ((4 * ks + quad) ^ t2));
                aA = mfma16(wx, kdf[ks], aA);
                aB = mfma16(kx, utf[ks], aB); }
            u32x2 wa; wa.x = pk2(-aA[0], -aA[1]); wa.y = pk2(-aA[2], -aA[3]);
            *(u32x2*)(GA + ((wave * 4 + (t2 >> 1)) * 64 + (2 * (t2 & 1) + (quad >> 1)) * 16 + l15) * 8 + 4 * (quad & 1)) = wa;
            u32x2 wb; wb.x = pk2(aB[0], aB[1]); wb.y = pk2(aB[2], aB[3]);
            *(u32x2*)(GB + ((((wave >> 1) * 8 + t2) * 64 + quad * 16 + l15) * 2 + (wave & 1)) * 4) = wb; }
#pragma unroll
        for (int mi = 0; mi < 4; ++mi) {
            f32x4 aC = {0.f, 0.f, 0.f, 0.f}, aD = {0.f, 0.f, 0.f, 0.f};
#pragma unroll
            for (int ks = 0; ks < 2; ++ks) { const bf16x8 af = lds_frag(lds + ATTI_OFF, 16 * mi + l15, 72, 32 * ks + 8 * quad);
                aC = mfma16(wtf[ks], af, aC);
                aD = mfma16(utf[ks], af, aD); }
            const int c = 16 * mi + l15; const float egc = expf(GC[c]);
            const u32x2 qw = *(const LAS u32x2*)(lds + Q_OFF + (c * 136 + 16 * wave + 4 * quad) * 2);
            u32x2 wc; wc.x = pk2(bf_lo(qw.x) * egc - aC[0], bf_hi(qw.x) * egc - aC[1]); wc.y = pk2(bf_lo(qw.y) * egc - aC[2], bf_hi(qw.y) * egc - aC[3]);
            *(u32x2*)(GCp + ((mi * 4 + (wave >> 1)) * 64 + (2 * (wave & 1) + (quad >> 1)) * 16 + l15) * 8 + 4 * (quad & 1)) = wc;
            u32x2 wd; wd.x = pk2(aD[0], aD[1]); wd.y = pk2(aD[2], aD[3]);
            *(u32x2*)(GD + ((wave * 4 + mi) * 64 + quad * 16 + l15) * 4) = wd; }
    }
    lds_barrier();
}

DI void ret_prep_unit(const Params& p, unsigned char* wsp, int hr, int n, LAS unsigned char* lds, int tid) {
    asm volatile("" : "+v"(tid));
    const int lane = tid & 63, wave = tid >> 6, quad = lane >> 4, l15 = lane & 15;
    const int r = tid >> 3, cgp = tid & 7, t = 64 * n + r;
    constexpr int RQ_OFF = 0, RK_OFF = 17408, KTT_OFF = 34816, VT_OFF = 53248;
    const bf16_t* PROJ = (const bf16_t*)(wsp + WS_PROJ);
    const size_t ub = (size_t)hr * 128 + n;
    const float lg2 = ret_lg2(hr);
    const float xi = exp2f((float)(r + 1) * lg2), zeta = exp2f((float)(63 - r) * lg2);
    const float posf = (float)p.pos[t];
    {   const bf16_t* pq = PROJ + (size_t)t * PROJ_LD + 4096 + hr * 128 + 8 * cgp; const bf16_t* pk = PROJ + (size_t)t * PROJ_LD + 4608 + hr * 128 + 8 * cgp;
        float q1[8], q2[8], k1[8], k2[8];
        unpack8(*(const u32x4*)pq, q1); unpack8(*(const u32x4*)(pq + 64), q2); unpack8(*(const u32x4*)pk, k1); unpack8(*(const u32x4*)(pk + 64), k2);
        float rq1[8], rq2[8], rk1[8], rk2[8];
#pragma unroll
        for (int ii = 0; ii < 8; ++ii) { const int i = 8 * cgp + ii;
            const float invf = expf(-(float)i * (9.210340371976184f / 64.0f)); const float ang = posf * invf; const float trev = ang * 0.15915494309189535f; const float fr = trev - rintf(trev);
            const float cs = __builtin_amdgcn_cosf(fr), sn = __builtin_amdgcn_sinf(fr);
            rq1[ii] = q1[ii] * cs - q2[ii] * sn; rq2[ii] = q1[ii] * sn + q2[ii] * cs;
            rk1[ii] = (k1[ii] * cs - k2[ii] * sn) * 0.08838834764831845f; rk2[ii] = (k1[ii] * sn + k2[ii] * cs) * 0.08838834764831845f; }
        *(LAS u32x4*)(lds + RQ_OFF + (r * 136 + 8 * cgp) * 2) = pack8(rq1); *(LAS u32x4*)(lds + RQ_OFF + (r * 136 + 64 + 8 * cgp) * 2) = pack8(rq2);
        *(LAS u32x4*)(lds + RK_OFF + (r * 136 + 8 * cgp) * 2) = pack8(rk1); *(LAS u32x4*)(lds + RK_OFF + (r * 136 + 64 + 8 * cgp) * 2) = pack8(rk2);
#pragma unroll
        for (int ii = 0; ii < 8; ++ii) { *(LAS bf16_t*)(lds + KTT_OFF + ((8 * cgp + ii) * 72 + r) * 2) = f2bf(rk1[ii] * zeta); *(LAS bf16_t*)(lds + KTT_OFF + ((64 + 8 * cgp + ii) * 72 + r) * 2) = f2bf(rk2[ii] * zeta);
            rq1[ii] *= xi; rq2[ii] *= xi; }
        bf16_t* QI = (bf16_t*)(wsp + R_QI) + ub * 8192 + (size_t)((((r >> 4) * 4 + (cgp >> 2)) * 64 + (cgp & 3) * 16 + (r & 15)) * 8);
        *(u32x4*)QI = pack8(rq1); *(u32x4*)(QI + 2 * 512) = pack8(rq2);
    }
    {   const bf16_t* pv = PROJ + (size_t)t * PROJ_LD + 5120 + hr * 256 + 32 * cgp;
#pragma unroll
        for (int q = 0; q < 4; ++q) { float vv[8]; unpack8(*(const u32x4*)(pv + 8 * q), vv);
#pragma unroll
            for (int i = 0; i < 8; ++i) *(LAS bf16_t*)(lds + VT_OFF + ((32 * cgp + 8 * q + i) * 72 + r) * 2) = f2bf(vv[i]); }
    }
    lds_barrier();
#pragma unroll
    for (int tt = 0; tt < 2; ++tt) { const int id = 2 * wave + tt, mi = id >> 2, ni = id & 3;
        f32x4 aA = {0.f, 0.f, 0.f, 0.f};
#pragma unroll
        for (int ks = 0; ks < 4; ++ks) { const bf16x8 kf = lds_frag(lds + RK_OFF, 16 * ni + l15, 136, 32 * ks + 8 * quad), qf = lds_frag(lds + RQ_OFF, 16 * mi + l15, 136, 32 * ks + 8 * quad);
            aA = mfma16(kf, qf, aA); }
        const int c = 16 * mi + l15; float o[4];
#pragma unroll
        for (int j = 0; j < 4; ++j) { const int s = 16 * ni + 4 * quad + j; o[j] = (c >= s) ? aA[j] * exp2f((float)(c - s) * lg2) : 0.f; }
        u32x2 w; w.x = pk2(o[0], o[1]); w.y = pk2(o[2], o[3]);
        *(u32x2*)((bf16_t*)(wsp + R_SC) + ub * 4096 + ((mi * 2 + (ni >> 1)) * 64 + (2 * (ni & 1) + (quad >> 1)) * 16 + l15) * 8 + 4 * (quad & 1)) = w; }
    {
        bf16x8 kf[2];
#pragma unroll
        for (int ks = 0; ks < 2; ++ks) kf[ks] = lds_frag(lds + KTT_OFF, 16 * wave + l15, 72, 32 * ks + 8 * quad);
        float* PT = (float*)(wsp + R_P) + ub * 32768;
#pragma unroll 4
        for (int et = 0; et < 16; ++et) { f32x4 a = {0.f, 0.f, 0.f, 0.f};
#pragma unroll
            for (int ks = 0; ks < 2; ++ks) a = mfma16(kf[ks], lds_frag(lds + VT_OFF, 16 * et + l15, 72, 32 * ks + 8 * quad), a);
            *(f32x4*)(PT + ((et * 4 + (wave >> 1)) * 64 + (2 * (wave & 1) + (quad >> 1)) * 16 + l15) * 8 + 4 * (quad & 1)) = a; }
    }
#pragma unroll
    for (int i = 0; i < 4; ++i) { const int id = tid + 512 * i, blk = id >> 6, row = 16 * (blk >> 1) + (id & 15), chn = 4 * (blk & 1) + ((id >> 4) & 3);
        *(u32x4*)((bf16_t*)(wsp + R_VT) + ub * 16384 + (size_t)id * 8) = *(const LAS u32x4*)(lds + VT_OFF + (row * 72 + 8 * chn) * 2); }
    lds_barrier();
}

struct SFrag { bf16x8 af[4]; u32x2 bt[2]; };
DI void sfrag_load(SFrag& f, const unsigned char* ws, int hh, int es, int n, int wave, int quad, int l15) {
    const size_t ub = (size_t)hh * 128 + n;
    const int lane = quad * 16 + l15;
    const bf16_t* Ap = (const bf16_t*)(ws + G_A) + ub * 16384 + (size_t)(wave * 4) * 512 + lane * 8;
    const bf16_t* Bp = (const bf16_t*)(ws + G_BT) + ub * 16384 + (size_t)((es * 8 + wave) * 64 + lane) * 8;
#pragma unroll
    for (int ks = 0; ks < 4; ++ks) f.af[ks] = *(const bf16x8*)(Ap + ks * 512);
    {   const u32x4 b4 = *(const u32x4*)Bp; f.bt[0] = (u32x2){b4.x, b4.y}; f.bt[1] = (u32x2){b4.z, b4.w}; }
}
DI void gdn_chain(const Params& p, unsigned char* wsp, int l, int hh, int es, LAS unsigned char* lds, int tid) {
    asm volatile("" : "+v"(tid));
    const int lane = tid & 63, wave = tid >> 6, quad = lane >> 4, l15 = lane & 15;
    constexpr int ST_BYTES = 8704;
    for (int i = tid; i < 2 * ST_BYTES / 4; i += NTHR) ((LAS unsigned*)lds)[i] = 0u;
    LAS float* GLs = (LAS float*)(lds + 2 * ST_BYTES);
    if (tid < 128) GLs[tid] = ((const float*)(wsp + G_GL))[hh * 128 + tid];
    f32x4 Sacc[2] = {{0.f, 0.f, 0.f, 0.f}, {0.f, 0.f, 0.f, 0.f}};
    bf16_t* SG = (bf16_t*)(wsp + G_S) + ((size_t)hh * 128) * 16384 + (size_t)(((2 * es + (wave >> 2)) * 4 + (wave & 3)) * 64 + lane) * 8;
    const int srd = ((16 * (wave >> 2) + l15) * 136 + 32 * (wave & 3) + 8 * quad) * 2;
    SFrag f0, f1, f2, f3, f4, f5;
#define CFENCE() asm volatile("" ::: "memory")
    sfrag_load(f0, wsp, hh, es, 0, wave, quad, l15); CFENCE(); sfrag_load(f1, wsp, hh, es, 1, wave, quad, l15); CFENCE(); sfrag_load(f2, wsp, hh, es, 2, wave, quad, l15); CFENCE();
    sfrag_load(f3, wsp, hh, es, 3, wave, quad, l15); CFENCE(); sfrag_load(f4, wsp, hh, es, 4, wave, quad, l15); CFENCE();
#undef CFENCE
    lds_barrier();
#define S_STEP(cur, n) do { \
        LAS unsigned char* sc = lds + ((n) & 1) * ST_BYTES; LAS unsigned char* sn = lds + (((n) + 1) & 1) * ST_BYTES; \
        const float glv = GLs[(n)]; \
        bf16x8 sfr[2][4]; \
        _Pragma("unroll") for (int et = 0; et < 2; ++et) _Pragma("unroll") for (int ks = 0; ks < 4; ++ks) sfr[et][ks] = lds_frag(sc, 16 * et + l15, 136, 32 * ks + 8 * quad);     \
        *(u32x4*)(SG + (size_t)(n) * 16384) = *(const LAS u32x4*)(sc + srd);                  \
        _Pragma("unroll") for (int et = 0; et < 2; ++et) { \
            f32x4 a; a[0] = Sacc[et][0] * glv + bf_lo(cur.bt[et].x); a[1] = Sacc[et][1] * glv + bf_hi(cur.bt[et].x); a[2] = Sacc[et][2] * glv + bf_lo(cur.bt[et].y); a[3] = Sacc[et][3] * glv + bf_hi(cur.bt[et].y); \
            _Pragma("unroll") for (int ks = 0; ks < 4; ++ks) a = mfma16(cur.af[ks], sfr[et][ks], a);     \
            Sacc[et] = a; \
            u32x2 w; w.x = pk2(a[0], a[1]); w.y = pk2(a[2], a[3]); \
            *(LAS u32x2*)(sn + ((16 * et + l15) * 136 + 16 * wave + 4 * quad) * 2) = w; } \
        lds_barrier(); } while (0)
#define S_LOAD(f, n) sfrag_load(f, wsp, hh, es, (n) < 128 ? (n) : 127, wave, quad, l15)
    for (int n = 0; n < 126; n += 6) {
        S_LOAD(f5, n + 5);  S_STEP(f0, n);
        S_LOAD(f0, n + 6);  S_STEP(f1, n + 1);
        S_LOAD(f1, n + 7);  S_STEP(f2, n + 2);
        S_LOAD(f2, n + 8);  S_STEP(f3, n + 3);
        S_LOAD(f3, n + 9);  S_STEP(f4, n + 4);
        S_LOAD(f4, n + 10); S_STEP(f5, n + 5);
    }
    S_STEP(f0, 126); S_STEP(f1, 127);
#undef S_STEP
#undef S_LOAD
}

DI void ret_scan(unsigned char* wsp, int sb, int tid) {
    const int idx = sb * NTHR + tid;
    const int hr = idx >> 13, off = (idx & 8191) * 4;
    const float cd = exp2f(64.0f * ret_lg2(hr));
    const float* P = (const float*)(wsp + R_P) + (size_t)hr * 128 * 32768 + off;
    bf16_t* RT = (bf16_t*)(wsp + R_RT) + (size_t)hr * 128 * 32768 + off;
    f32x4 R = {0.f, 0.f, 0.f, 0.f};
    for (int n0 = 0; n0 < 128; n0 += 16) {
        f32x4 pv[16];
#pragma unroll
        for (int i = 0; i < 16; ++i) pv[i] = *(const f32x4*)(P + (size_t)(n0 + i) * 32768);
#pragma unroll
        for (int i = 0; i < 16; ++i) { u32x2 w; w.x = pk2(R[0], R[1]); w.y = pk2(R[2], R[3]); *(u32x2*)(RT + (size_t)(n0 + i) * 32768) = w; R = R * cd + pv[i]; }
    }
}

DI void gdn_out_unit(const Params& p, unsigned char* wsp, int l, int hh, int n, LAS unsigned char* lds, int tid) {
    asm volatile("" : "+v"(tid));
    const int lane = tid & 63, wave = tid >> 6, quad = lane >> 4, l15 = lane & 15;
    const size_t ub = (size_t)hh * 128 + n;
    const bf16_t* Sp = (const bf16_t*)(wsp + G_S) + ub * 16384 + (size_t)(wave * 4) * 512 + lane * 8;
    const bf16_t* Cp = (const bf16_t*)(wsp + G_C) + ub * 8192 + lane * 8;
    const bf16_t* Dp = (const bf16_t*)(wsp + G_D) + ub * 8192 + (size_t)((wave * 4) * 64 + lane) * 4;
    bf16x8 sf[4]; f32x4 acc[4];
    const int e0 = 16 * wave + 4 * quad;
    const bf16_t* PROJ = (const bf16_t*)(wsp + WS_PROJ);
    u32x2 zwv[4];
#pragma unroll
    for (int mi = 0; mi < 4; ++mi) zwv[mi] = *(const u32x2*)(PROJ + (size_t)(64 * n + 16 * mi + l15) * PROJ_LD + 3072 + hh * 128 + e0);
    const f32x4 nw = *(const f32x4*)(p.gdn_norm_w + l * 128 + e0);
#pragma unroll
    for (int ks = 0; ks < 4; ++ks) sf[ks] = *(const bf16x8*)(Sp + ks * 512);
#pragma unroll
    for (int mi = 0; mi < 4; ++mi) { const u32x2 dw = *(const u32x2*)(Dp + mi * 256);
        f32x4 a; a[0] = bf_lo(dw.x); a[1] = bf_hi(dw.x); a[2] = bf_lo(dw.y); a[3] = bf_hi(dw.y);
#pragma unroll
        for (int ks = 0; ks < 4; ++ks) a = mfma16(sf[ks], *(const bf16x8*)(Cp + (mi * 4 + ks) * 512), a);
        acc[mi] = a; }
    LAS float* red = (LAS float*)lds;
#pragma unroll
    for (int mi = 0; mi < 4; ++mi) { float s = (acc[mi][0] * acc[mi][0] + acc[mi][1] * acc[mi][1]) + (acc[mi][2] * acc[mi][2] + acc[mi][3] * acc[mi][3]);
        s += __shfl_xor(s, 16); s += __shfl_xor(s, 32);
        if (quad == 0) red[wave * 64 + 16 * mi + l15] = s; }
    lds_barrier();
    bf16_t* ACTA = (bf16_t*)(wsp + WS_ACT);
#pragma unroll
    for (int mi = 0; mi < 4; ++mi) { const int c = 16 * mi + l15; float tot = 0.f;
#pragma unroll
        for (int w8 = 0; w8 < 8; ++w8) tot += red[w8 * 64 + c];
        const float rs = 1.0f / sqrtf(tot * (1.0f / 128.0f) + EPS);
        const size_t t = (size_t)(64 * n + c);
        const u32x2 zw = zwv[mi];
        u32x2 o; o.x = pk2(acc[mi][0] * rs * nw[0] * siluf_(bf_lo(zw.x)), acc[mi][1] * rs * nw[1] * siluf_(bf_hi(zw.x)));
        o.y = pk2(acc[mi][2] * rs * nw[2] * siluf_(bf_lo(zw.y)), acc[mi][3] * rs * nw[3] * siluf_(bf_hi(zw.y)));
        *(u32x2*)(ACTA + t * 1024 + hh * 128 + e0) = o; }
    lds_barrier();
}
DI void ret_out_unit(const Params& p, unsigned char* wsp, int hr, int n, LAS unsigned char* lds, int tid) {
    asm volatile("" : "+v"(tid));
    const int lane = tid & 63, wave = tid >> 6, quad = lane >> 4, l15 = lane & 15;
    const size_t ub = (size_t)hr * 128 + n;
    const bf16_t* Qp = (const bf16_t*)(wsp + R_QI) + ub * 8192 + lane * 8;
    const bf16_t* Sp = (const bf16_t*)(wsp + R_SC) + ub * 4096 + lane * 8;
    const bf16_t* PROJ = (const bf16_t*)(wsp + WS_PROJ);
    u32x2 bgw[2][4];
#pragma unroll
    for (int tt = 0; tt < 2; ++tt)
#pragma unroll
        for (int mi = 0; mi < 4; ++mi) bgw[tt][mi] = *(const u32x2*)(PROJ + (size_t)(64 * n + 16 * mi + l15) * PROJ_LD + 6144 + hr * 256 + 16 * (2 * wave + tt) + 4 * quad);
    f32x4 acc[2][4];
#pragma unroll
    for (int tt = 0; tt < 2; ++tt) { const int et = 2 * wave + tt;
        const bf16_t* Rp = (const bf16_t*)(wsp + R_RT) + ub * 32768 + (size_t)(et * 4) * 512 + lane * 8;
        const bf16_t* Vp = (const bf16_t*)(wsp + R_VT) + ub * 16384 + (size_t)(et * 2) * 512 + lane * 8;
        bf16x8 rf[4], vf[2];
#pragma unroll
        for (int ks = 0; ks < 4; ++ks) rf[ks] = *(const bf16x8*)(Rp + ks * 512);
#pragma unroll
        for (int ks = 0; ks < 2; ++ks) vf[ks] = *(const bf16x8*)(Vp + ks * 512);
#pragma unroll
        for (int mi = 0; mi < 4; ++mi) { f32x4 a = {0.f, 0.f, 0.f, 0.f};
#pragma unroll
            for (int ks = 0; ks < 4; ++ks) a = mfma16(rf[ks], *(const bf16x8*)(Qp + (mi * 4 + ks) * 512), a);
#pragma unroll
            for (int ks = 0; ks < 2; ++ks) a = mfma16(vf[ks], *(const bf16x8*)(Sp + (mi * 2 + ks) * 512), a);
            acc[tt][mi] = a; } }
    LAS float* red = (LAS float*)lds;
#pragma unroll
    for (int mi = 0; mi < 4; ++mi) { float s = 0.f, q = 0.f;
#pragma unroll
        for (int tt = 0; tt < 2; ++tt) { const f32x4 a = acc[tt][mi]; s += (a[0] + a[1]) + (a[2] + a[3]); q += (a[0] * a[0] + a[1] * a[1]) + (a[2] * a[2] + a[3] * a[3]); }
        s += __shfl_xor(s, 16); s += __shfl_xor(s, 32); q += __shfl_xor(q, 16); q += __shfl_xor(q, 32);
        if (quad == 0) { red[(wave * 64 + 16 * mi + l15) * 2] = s; red[(wave * 64 + 16 * mi + l15) * 2 + 1] = q; } }
    lds_barrier();
    bf16_t* ACTB = (bf16_t*)(wsp + WS_ACT) + (size_t)T_ * 1024;
#pragma unroll
    for (int mi = 0; mi < 4; ++mi) { const int c = 16 * mi + l15; float S = 0.f, Q = 0.f;
#pragma unroll
        for (int w8 = 0; w8 < 8; ++w8) { S += red[(w8 * 64 + c) * 2]; Q += red[(w8 * 64 + c) * 2 + 1]; }
        const float mu = S * (1.0f / 256.0f), var = fmaxf(Q * (1.0f / 256.0f) - mu * mu, 0.f), rs = 1.0f / sqrtf(var + 1e-5f);
#pragma unroll
        for (int tt = 0; tt < 2; ++tt) { const f32x4 a = acc[tt][mi]; const u32x2 g = bgw[tt][mi];
            u32x2 o; o.x = pk2((a[0] - mu) * rs * siluf_(bf_lo(g.x)), (a[1] - mu) * rs * siluf_(bf_hi(g.x))); o.y = pk2((a[2] - mu) * rs * siluf_(bf_lo(g.y)), (a[3] - mu) * rs * siluf_(bf_hi(g.y)));
            *(u32x2*)(ACTB + (size_t)(64 * n + c) * 1024 + hr * 256 + 16 * (2 * wave + tt) + 4 * quad) = o; } }
    lds_barrier();
}

DI void sub_barrier(unsigned* cnt, unsigned target) {
    asm volatile("s_waitcnt vmcnt(0)" ::: "memory");
    __syncthreads();
    if (threadIdx.x == 0) {
        __builtin_amdgcn_fence(__ATOMIC_RELEASE, "agent");
        asm volatile("s_waitcnt vmcnt(0)" ::: "memory");
        (void)__hip_atomic_fetch_add(cnt, 1u, __ATOMIC_RELAXED, __HIP_MEMORY_SCOPE_AGENT);
        unsigned sp = 0;
        while (__hip_atomic_load(cnt, __ATOMIC_RELAXED, __HIP_MEMORY_SCOPE_AGENT) < target) { __builtin_amdgcn_s_sleep(24); if (++sp > (1u << 20)) break; }
        __builtin_amdgcn_fence(__ATOMIC_ACQUIRE, "agent");
        asm volatile("s_waitcnt vmcnt(0)" ::: "memory");
    }
    __syncthreads();
}

DI void conv_unit(const Params& p, unsigned char* wsp, int l, int u, LAS unsigned char* lds, int tid) {
    asm volatile("" : "+v"(tid));
    const int tt = u >> 2, cs = u & 3, t0 = 64 * tt;
    const bf16_t* PROJ = (const bf16_t*)(wsp + WS_PROJ);
    LAS float* Ug = (LAS float*)lds;
    {   const int c8 = tid & 31, rg = tid >> 5;
        u32x4 ga[6], gg[6];
#pragma unroll
        for (int i = 0; i < 6; ++i) { const int rr = rg + 16 * i, t = t0 - 30 + rr; ga[i] = (u32x4){0u, 0u, 0u, 0u}; gg[i] = (u32x4){0u, 0u, 0u, 0u};
            if (rr < 94 && t >= 0) { ga[i] = *(const u32x4*)(PROJ + (size_t)t * PROJ_LD + 7168 + 256 * cs + 8 * c8); gg[i] = *(const u32x4*)(PROJ + (size_t)t * PROJ_LD + 8192 + 256 * cs + 8 * c8); } }
#pragma unroll
        for (int i = 0; i < 6; ++i) { const int rr = rg + 16 * i;
            if (rr < 94) { float a[8], g[8], o[8]; unpack8(ga[i], a); unpack8(gg[i], g);
#pragma unroll
                for (int q = 0; q < 8; ++q) o[q] = a[q] * sigmoidf_(g[q]);
                *(LAS f32x4*)(Ug + rr * 256 + 8 * c8) = (f32x4){o[0], o[1], o[2], o[3]}; *(LAS f32x4*)(Ug + rr * 256 + 8 * c8 + 4) = (f32x4){o[4], o[5], o[6], o[7]}; } }
    }
    lds_barrier();
    {   const int ch = tid & 255, half = tid >> 8, cg_ = 256 * cs + ch;
        float w[31];
#pragma unroll
        for (int j = 0; j < 31; ++j) w[j] = p.conv_dw_w[((size_t)l * 31 + j) * 1024 + cg_];
        const float bias = p.conv_dw_b[l * 1024 + cg_];
        float* CV = (float*)(wsp + WS_CV);
        for (int tl = 32 * half; tl < 32 * half + 32; ++tl) { float a = bias;
#pragma unroll
            for (int j = 0; j < 31; ++j) a += w[j] * Ug[(tl + j) * 256 + ch];
            CV[(size_t)(t0 + tl) * 1024 + cg_] = a; }
    }
    lds_barrier();
}

DI void phase_post(const Params& p, unsigned char* wsp, int l, int tid, const int mask, const int b0, const int nblk) {
    const int lane = tid & 63, wave = tid >> 6, gw = ((int)blockIdx.x - b0) * 8 + wave, NGW = nblk * 8;
    const bf16_t* PROJ = (const bf16_t*)(wsp + WS_PROJ);
    const float* OA = (const float*)(wsp + WS_OA); const float* OB = (const float*)(wsp + WS_OB); const float* CV = (const float*)(wsp + WS_CV);
    bf16_t* ACTA = (bf16_t*)(wsp + WS_ACT); bf16_t* ACTB = ACTA + (size_t)T_ * 1024; bf16_t* ACTC = ACTB + (size_t)T_ * 1024;
    for (int t = gw; t < T_; t += NGW) {
        if (mask & 1)
#pragma unroll
        for (int hh = 0; hh < 8; ++hh) { const int cc = hh * 128 + 2 * lane;
            const float o0 = OA[(size_t)t * 1024 + cc], o1 = OA[(size_t)t * 1024 + cc + 1];
            const float ss = wave_sum(o0 * o0 + o1 * o1); const float rs = 1.0f / sqrtf(ss * (1.0f / 128.0f) + EPS);
            const unsigned zw = *(const unsigned*)(PROJ + (size_t)t * PROJ_LD + 3072 + cc);
            const float w0 = p.gdn_norm_w[l * 128 + 2 * lane], w1 = p.gdn_norm_w[l * 128 + 2 * lane + 1];
            *(unsigned*)(ACTA + (size_t)t * 1024 + cc) = pk2(o0 * rs * w0 * siluf_(bf_lo(zw)), o1 * rs * w1 * siluf_(bf_hi(zw))); }
        if (mask & 2)
#pragma unroll
        for (int hr = 0; hr < 4; ++hr) { const int cc = hr * 256 + 4 * lane;
            const f32x4 o = *(const f32x4*)(OB + (size_t)t * 1024 + cc);
            const float mu = wave_sum((o[0] + o[1]) + (o[2] + o[3])) * (1.0f / 256.0f);
            const f32x4 d = o - mu; const float var = wave_sum((d[0] * d[0] + d[1] * d[1]) + (d[2] * d[2] + d[3] * d[3])) * (1.0f / 256.0f);
            const float rs = 1.0f / sqrtf(var + 1e-5f);
            const u32x2 gwd = *(const u32x2*)(PROJ + (size_t)t * PROJ_LD + 6144 + cc);
            u32x2 w; w.x = pk2(d[0] * rs * siluf_(bf_lo(gwd.x)), d[1] * rs * siluf_(bf_hi(gwd.x))); w.y = pk2(d[2] * rs * siluf_(bf_lo(gwd.y)), d[3] * rs * siluf_(bf_hi(gwd.y)));
            *(u32x2*)(ACTB + (size_t)t * 1024 + cc) = w; }
        if (mask & 4)
        {   f32x4 v[4]; float s = 0.f;
#pragma unroll
            for (int j = 0; j < 4; ++j) { v[j] = *(const f32x4*)(CV + (size_t)t * 1024 + (j * 64 + lane) * 4); s += (v[j][0] + v[j][1]) + (v[j][2] + v[j][3]); }
            const float mu = wave_sum(s) * (1.0f / 1024.0f); float q = 0.f;
#pragma unroll
            for (int j = 0; j < 4; ++j) { v[j] = v[j] - mu; q += (v[j][0] * v[j][0] + v[j][1] * v[j][1]) + (v[j][2] * v[j][2] + v[j][3] * v[j][3]); }
            const float rs = 1.0f / sqrtf(wave_sum(q) * (1.0f / 1024.0f) + 1e-5f);
#pragma unroll
            for (int j = 0; j < 4; ++j) { const int cc = (j * 64 + lane) * 4; const f32x4 lw = *(const f32x4*)(p.conv_ln_w + l * 1024 + cc), lb = *(const f32x4*)(p.conv_ln_b + l * 1024 + cc);
                const f32x4 y = v[j] * rs * lw + lb;
                u32x2 w; w.x = pk2(siluf_(y[0]), siluf_(y[1])); w.y = pk2(siluf_(y[2]), siluf_(y[3]));
                *(u32x2*)(ACTC + (size_t)t * 1024 + cc) = w; }
        }
    }
}

template <class Epi> DI void run_gemm(LAS unsigned char* lds, const bf16_t* A, const bf16_t* Bt, int N, int K, const Epi& E) {
    Gemm g{A, Bt, T_, N, K}; StaticOrder S; S.init(T_, N, (int)gridDim.x, (int)blockIdx.x);
    gemm_phase<Epi, StaticOrder, false>(lds, g, S, E, nullptr);
}

DI void run_phase(const Params& p, unsigned char* wsp, int ph, LAS unsigned char* lds, int tid) {
    const int G = gridDim.x, b = blockIdx.x;
#ifndef SUBM
#define SUBM 3
#endif
#ifndef PHM
#define PHM 0xFFF
#endif
    if (ph == 0) { if (PHM & 0x400) phase_prep(p, wsp, lds, tid); return; }
    if (ph == 21) { if (PHM & 0x800) phase_norm((const float*)(wsp + WS_XC), p.final_w, nullptr, nullptr, nullptr, p.out, tid); return; }
    const int l = (ph - 1) / 10, sp = (ph - 1) % 10;
    const float* mod = (const float*)(wsp + WS_MOD) + l * 12288;
    const float* xin = (l == 0) ? p.x : (const float*)(wsp + WS_XC);
    float* XC = (float*)(wsp + WS_XC);
    bf16_t* H = (bf16_t*)(wsp + WS_H);
    bf16_t* PROJ = (bf16_t*)(wsp + WS_PROJ);
    const unsigned char* wl = wsp + WS_W + (size_t)l * SZ_WL;
    const bf16_t* WT_IN = (const bf16_t*)wl; const bf16_t* WT_BR = (const bf16_t*)(wl + SZ_WT_IN); const bf16_t* WT_O = (const bf16_t*)(wl + SZ_WT_IN + 3 * SZ_WT_BR);
    const bf16_t* WT_MI = (const bf16_t*)(wl + SZ_WT_IN + 3 * SZ_WT_BR + SZ_WT_O); const bf16_t* WT_MO = (const bf16_t*)(wl + SZ_WT_IN + 3 * SZ_WT_BR + SZ_WT_O + SZ_WT_M);
    switch (sp) {
    case 0: if (PHM & (1<<0)) phase_norm(xin, p.norm_mix_w + l * D_, mod + 2048, mod, H, nullptr, tid); break;
    case 1: if (PHM & (1<<1)) { EpiProj E{PROJ, (float*)(wsp + WS_BA)}; run_gemm(lds, H, WT_IN, NP1, 2048, E); } break;
    case 2: if (PHM & (1<<2)) for (int u = b; u < 1024; u += G) gdn_prep_unit(p, wsp, l, u >> 7, u & 127, lds, tid); break;
    case 3: if (PHM & (1<<3)) {
        if (b < 32) { gdn_chain(p, wsp, l, b >> 2, b & 3, lds, tid); lds_barrier(); }
        else {
            const int nb = b - 32, NB = G - 32; unsigned* cnt = (unsigned*)(wsp + WS_PROG) + 1024;
            for (int u = nb; u < 1024; u += NB) { if (u < 512) ret_prep_unit(p, wsp, u >> 7, u & 127, lds, tid); else conv_unit(p, wsp, l, u - 512, lds, tid); }
            sub_barrier(cnt, (unsigned)(NB * (l + 1)));
            if (nb < 64) ret_scan(wsp, nb, tid);
        }
    } break;
    case 4: if (PHM & (1<<4)) {
        for (int u = b; u < 1536; u += G) { if (u < 1024) gdn_out_unit(p, wsp, l, u >> 7, u & 127, lds, tid); else ret_out_unit(p, wsp, (u - 1024) >> 7, (u - 1024) & 127, lds, tid); }
        phase_post(p, wsp, l, tid, 4, 0, G);
    } break;
    case 5: if (PHM & (1<<5)) { const bf16_t* ACT = (const bf16_t*)(wsp + WS_ACT); float* MF = (float*)(wsp + WS_MF); bf16_t* MB = (bf16_t*)(wsp + WS_MB);
        { EpiBranch<0> E{PROJ, MF, MB}; run_gemm(lds, ACT, WT_BR, 2048, 1024, E); }
        { EpiBranch<1> E{PROJ, MF, MB}; run_gemm(lds, ACT + (size_t)T_ * 1024, WT_BR + (size_t)2048 * 1024, 2048, 1024, E); }
        { EpiBranch<2> E{PROJ, MF, MB}; run_gemm(lds, ACT + 2 * (size_t)T_ * 1024, WT_BR + 2 * (size_t)2048 * 1024, 2048, 1024, E); }
    } break;
    case 6: if (PHM & (1<<6)) { EpiResid E{xin, XC, mod + 4096}; run_gemm(lds, (const bf16_t*)(wsp + WS_MB), WT_O, 2048, 2048, E); } break;
    case 7: if (PHM & (1<<7)) phase_norm(XC, p.norm_mlp_w + l * D_, mod + 8192, mod + 6144, H, nullptr, tid); break;
    case 8: if (PHM & (1<<8)) { EpiRelu2 E{PROJ}; run_gemm(lds, H, WT_MI, 8192, 2048, E); } break;
    case 9: if (PHM & (1<<9)) { EpiResid E{XC, XC, mod + 10240}; run_gemm(lds, PROJ, WT_MO, 2048, 8192, E); } break;
    }
}

constexpr int NPHASE = 22;
__global__ void __launch_bounds__(NTHR, 2) mega_kernel(Params p) {
    extern __shared__ __attribute__((aligned(16))) unsigned char smem[];
    LAS unsigned char* lds = (LAS unsigned char*)smem;
    const int tid = threadIdx.x;
    volatile LAS unsigned* xbw = (volatile LAS unsigned*)(lds + LDS_BYTES - 16);
    if (tid == 0) { xbw[0] = 0u; xbw[1] = 0u; }
    __syncthreads();
    if (p.ph_hi - p.ph_lo > 1) (void)xcd_barrier_post((unsigned*)(p.ws + WS_BAR), xbw);
#ifndef PROBE_REP
#define PROBE_REP 0
#endif
    int ph = p.ph_lo, rep = 0, nbar = 0;
    while (ph < p.ph_hi) {
        if (nbar >= 1 && p.ph_hi - p.ph_lo == 2) { __threadfence(); cg::this_grid().sync(); }
        else if (nbar >= 1) { XcdBarrier xb; xb.bar = (unsigned*)(p.ws + WS_BAR); xb.x = xb_xcc_id(); xb.st = (volatile LAS unsigned*)(lds + LDS_BYTES - 16); xcd_barrier(xb); }
        ++nbar;
        int t2 = tid; asm volatile("" : "+v"(t2));
        unsigned char* wsp;
        {   int z; asm volatile("v_mov_b32 %0, 0" : "=v"(z)); z = __builtin_amdgcn_readfirstlane(z);
            wsp = p.ws + z; }
        run_phase(p, wsp, ph, lds, t2);
        const int sp_ = (ph == 0) ? 10 : (ph == 21) ? 11 : (ph - 1) % 10;
        if (rep == 0 && ((PROBE_REP >> sp_) & 1)) rep = 1; else { rep = 0; ++ph; }
    }
}

#ifndef ONE_LAUNCH
#define ONE_LAUNCH 1
#endif
extern "C" void kernel_launch(void* const* d_in, const int* in_sizes, int n_in, void* d_out, int out_size, void* d_ws, size_t ws_size, hipStream_t stream) {
    static int grid = 0;
    if (grid == 0) {
        if (n_in != 23 || ws_size < WS_END) { fprintf(stderr, "kernel_launch: bad inputs (n_in %d ws %zu need %zu)\n", n_in, ws_size, (size_t)WS_END); grid = -1; return; }
        int dev = 0, cus = 0, per_cu = 0;
        hipGetDevice(&dev); hipDeviceGetAttribute(&cus, hipDeviceAttributeMultiprocessorCount, dev);
        if (hipFuncSetAttribute((const void*)mega_kernel, hipFuncAttributeMaxDynamicSharedMemorySize, LDS_BYTES) != hipSuccess) { fprintf(stderr, "hipFuncSetAttribute failed\n"); grid = -1; return; }
        if (hipOccupancyMaxActiveBlocksPerMultiprocessor(&per_cu, (const void*)mega_kernel, NTHR, LDS_BYTES) != hipSuccess || per_cu < 1) per_cu = 1;
        (void)hipGetLastError();
        grid = cus * 1;
    }
    if (grid < 0) return;
    Params p{};
    p.x = (const float*)d_in[0]; p.c = (const float*)d_in[1]; p.pos = (const int*)d_in[2]; p.w_ada = (const float*)d_in[3]; p.b_ada = (const float*)d_in[4];
    p.norm_mix_w = (const float*)d_in[5]; p.norm_mlp_w = (const float*)d_in[6]; p.w_in = (const float*)d_in[7]; p.conv_qkv_w = (const float*)d_in[8];
    p.a_log = (const float*)d_in[9]; p.dt_bias = (const float*)d_in[10]; p.gdn_norm_w = (const float*)d_in[11]; p.conv_dw_w = (const float*)d_in[12]; p.conv_dw_b = (const float*)d_in[13];
    p.conv_ln_w = (const float*)d_in[14]; p.conv_ln_b = (const float*)d_in[15]; p.w_a = (const float*)d_in[16]; p.w_b = (const float*)d_in[17]; p.w_c = (const float*)d_in[18];
    p.w_out = (const float*)d_in[19]; p.w_mi = (const float*)d_in[20]; p.w_mo = (const float*)d_in[21]; p.final_w = (const float*)d_in[22];
    p.out = (float*)d_out; p.ws = (unsigned char*)d_ws;
#if ONE_LAUNCH
    p.ph_lo = 0; p.ph_hi = NPHASE;
    if (hipMemsetAsync((char*)d_ws + WS_BAR, 0, 32768, stream) != hipSuccess) { fprintf(stderr, "memset failed\n"); return; }
    void* args[] = {&p};
    hipError_t e = hipLaunchCooperativeKernel((const void*)mega_kernel, dim3(grid), dim3(NTHR), args, LDS_BYTES, stream);
    if (e != hipSuccess) fprintf(stderr, "cooperative launch failed: %s (grid %d)\n", hipGetErrorString(e), grid);
#else
    for (int ph = 0; ph < NPHASE; ++ph) { p.ph_lo = ph; p.ph_hi = ph + 1;
        hipLaunchKernelGGL(mega_kernel, dim3(grid), dim3(NTHR), LDS_BYTES, stream, p); }
#endif
}
```

```cpp
#include <hip/hip_runtime.h>
#include <hip/hip_cooperative_groups.h>
#include <cstdio>
namespace pg8 {
#define PG8_LAS __attribute__((address_space(3)))
typedef unsigned short bf16_t;
typedef short bf16x8 __attribute__((ext_vector_type(8)));
typedef float f32x4 __attribute__((ext_vector_type(4)));
typedef unsigned u32x4 __attribute__((ext_vector_type(4)));
constexpr int BM = 256, BK = 64, HALF = 128, HTB = HALF * BK * 2  , STAGE_BYTES = 8 * HTB, NXCD = 8, WGM = 8;

__host__ __device__ __forceinline__ int lds_byte(int r, int c) { const int st = (r >> 4) * 2 + (c >> 5), rr = r & 15, cc = c & 31, ob = rr * 64 + cc * 2; return st * 1024 + (ob ^ (((ob >> 9) & 1) << 5)); }
__host__ __device__ __forceinline__ void stage_rc(int b, int& R, int& C) { const int st = b / 1024, sb = b % 1024, swz = sb ^ (((sb >> 9) & 1) << 5); R = (st >> 1) * 16 + swz / 64; C = (st & 1) * 32 + (swz % 64) / 2; }
__host__ __device__ __forceinline__ int perm32(int rho) { const int n = rho >> 4, i = rho & 15; return 8 * (i >> 2) + 4 * n + (i & 3); }

struct Unit { int pm, pn; };
struct Gemm { const bf16_t* A; const bf16_t* Bt; int M, N, K; };

struct StaticOrder {
    int nM, nN, nwg, G, c;
    __host__ __device__ void init(int M, int N, int G_, int c_) { nM = M / BM; nN = N / BM; nwg = nM * nN; G = G_; c = c_; }
    __host__ __device__ bool next(int i, Unit& u) const {
        const long L = (long)i * G + c; if (L >= nwg) return false;
        int wgid = (int)L; { const int q = nwg / NXCD, r = nwg % NXCD, xcd = wgid % NXCD, off = wgid / NXCD; wgid = (xcd < r ? xcd * (q + 1) : r * (q + 1) + (xcd - r) * q) + off; }
        const int nig = WGM * nN, gid = wgid / nig, fm = gid * WGM, gsz = (nM - fm) < WGM ? (nM - fm) : WGM;
        u.pm = fm + ((wgid % nig) % gsz); u.pn = (wgid % nig) / gsz; return true;
    }
    __device__ __forceinline__ void a_ready(const Unit&) const {}
    __device__ __forceinline__ void done(const Unit&) const {}
};
typedef float f32x2c_ __attribute__((ext_vector_type(2)));
typedef __bf16 bf16x2c_ __attribute__((ext_vector_type(2)));
__device__ __forceinline__ unsigned cvt_pk_bf16(float lo, float hi) { const f32x2c_ v = {lo, hi}; const bf16x2c_ b = __builtin_convertvector(v, bf16x2c_); return __builtin_bit_cast(unsigned, b); }
typedef unsigned u32x2 __attribute__((ext_vector_type(2)));
__device__ __forceinline__ float bf_lo(unsigned w) { return __uint_as_float(w << 16); }
__device__ __forceinline__ float bf_hi(unsigned w) { return __uint_as_float(w & 0xffff0000u); }
__device__ __forceinline__ float sigmoidf_(float x) { return 1.0f / (1.0f + __expf(-x)); }

constexpr int PROJ_LD = 15360;

struct EpiProj {
    static constexpr bool PERM = true, AFTER_DRAIN = false;
    bf16_t* O; float* BA;
    __device__ __forceinline__ void operator()(const f32x4 (&acc)[2][2][4][2], const Unit& u, int wr, int wc, int fr, int fq) const {
        const int row0 = u.pm * BM + wr * 64 + fr;
        if (u.pn < 60) {
            const int col0 = u.pn * BM + wc * 32 + 8 * fq;
#pragma unroll
            for (int ai = 0; ai < 2; ++ai)
#pragma unroll
                for (int m = 0; m < 4; ++m) { bf16_t* rowp = O + (size_t)(row0 + ai * HALF + m * 16) * PROJ_LD + col0;
#pragma unroll
                    for (int bj = 0; bj < 2; ++bj) { const f32x4 v0 = acc[ai][bj][m][0], v1 = acc[ai][bj][m][1];
                        u32x4 w; w.x = cvt_pk_bf16(v0[0], v0[1]); w.y = cvt_pk_bf16(v0[2], v0[3]); w.z = cvt_pk_bf16(v1[0], v1[1]); w.w = cvt_pk_bf16(v1[2], v1[3]);
                        *(u32x4*)(rowp + bj * HALF) = w; } }
        } else {
            if (wc == 0 && fq < 2) {
#pragma unroll
                for (int ai = 0; ai < 2; ++ai)
#pragma unroll
                    for (int m = 0; m < 4; ++m) { float* rowp = BA + (size_t)(row0 + ai * HALF + m * 16) * 16 + 8 * fq;
#pragma unroll
                        for (int n = 0; n < 2; ++n) *(f32x4*)(rowp + 4 * n) = acc[ai][0][m][n]; }
            }
        }
    }
};
template <int PASS> struct EpiBranch {
    static constexpr bool PERM = true, AFTER_DRAIN = false;
    const bf16_t* PROJ; float* MF; bf16_t* MB;
    __device__ __forceinline__ void operator()(const f32x4 (&acc)[2][2][4][2], const Unit& u, int wr, int wc, int fr, int fq) const {
        const int row0 = u.pm * BM + wr * 64 + fr, col0 = u.pn * BM + wc * 32 + 8 * fq;
        float* mfb = MF + ((size_t)((u.pm * 8 + u.pn) * 8 + wr * 4 + wc) * 32) * 256 + (fq * 16 + fr) * 4;
#pragma unroll
        for (int ai = 0; ai < 2; ++ai)
#pragma unroll
            for (int mp = 0; mp < 2; ++mp) {
                u32x4 gw[2][2]; f32x4 mv[2][2][2];
#pragma unroll
                for (int mm = 0; mm < 2; ++mm) { const int m = 2 * mp + mm; const size_t row = (size_t)(row0 + ai * HALF + m * 16);
#pragma unroll
                    for (int bj = 0; bj < 2; ++bj) { gw[mm][bj] = *(const u32x4*)(PROJ + row * PROJ_LD + 9216 + PASS * 2048 + col0 + bj * HALF);
#pragma unroll
                        for (int n = 0; n < 2; ++n) if (PASS > 0) mv[mm][bj][n] = *(const f32x4*)(mfb + (((ai * 4 + m) * 2 + bj) * 2 + n) * 256); } }
#pragma unroll
                for (int mm = 0; mm < 2; ++mm) { const int m = 2 * mp + mm; const size_t row = (size_t)(row0 + ai * HALF + m * 16);
#pragma unroll
                    for (int bj = 0; bj < 2; ++bj) { const u32x4 g4 = gw[mm][bj];
                        f32x4 g0, g1; g0[0] = sigmoidf_(bf_lo(g4.x)); g0[1] = sigmoidf_(bf_hi(g4.x)); g0[2] = sigmoidf_(bf_lo(g4.y)); g0[3] = sigmoidf_(bf_hi(g4.y));
                        g1[0] = sigmoidf_(bf_lo(g4.z)); g1[1] = sigmoidf_(bf_hi(g4.z)); g1[2] = sigmoidf_(bf_lo(g4.w)); g1[3] = sigmoidf_(bf_hi(g4.w));
                        f32x4 v0 = g0 * acc[ai][bj][m][0], v1 = g1 * acc[ai][bj][m][1];
                        if (PASS > 0) { v0 += mv[mm][bj][0]; v1 += mv[mm][bj][1]; }
                        if (PASS < 2) { *(f32x4*)(mfb + (((ai * 4 + m) * 2 + bj) * 2 + 0) * 256) = v0; *(f32x4*)(mfb + (((ai * 4 + m) * 2 + bj) * 2 + 1) * 256) = v1; }
                        else { u32x4 w; w.x = cvt_pk_bf16(v0[0], v0[1]); w.y = cvt_pk_bf16(v0[2], v0[3]); w.z = cvt_pk_bf16(v1[0], v1[1]); w.w = cvt_pk_bf16(v1[2], v1[3]);
                            *(u32x4*)(MB + row * 2048 + col0 + bj * HALF) = w; } } }
                asm volatile("" ::: "memory"); }
    }
};
struct EpiResid {
    static constexpr bool PERM = false, AFTER_DRAIN = false;
    const float* xin; float* xout; const float* gate;
    __device__ __forceinline__ void operator()(const f32x4 (&acc)[2][2][4][2], const Unit& u, int wr, int wc, int fr, int fq) const {
        const int row0 = u.pm * BM + wr * 64 + fr, col0 = u.pn * BM + wc * 32 + 4 * fq;
        f32x4 gv[2][2];
#pragma unroll
        for (int bj = 0; bj < 2; ++bj)
#pragma unroll
            for (int n = 0; n < 2; ++n) gv[bj][n] = *(const f32x4*)(gate + col0 + bj * HALF + n * 16);
#pragma unroll
        for (int ai = 0; ai < 2; ++ai)
#pragma unroll
            for (int mp = 0; mp < 2; ++mp) { f32x4 bv[2][2][2];
#pragma unroll
                for (int mm = 0; mm < 2; ++mm) { const size_t off = (size_t)(row0 + ai * HALF + (2 * mp + mm) * 16) * 2048 + col0;
#pragma unroll
                    for (int bj = 0; bj < 2; ++bj)
#pragma unroll
                        for (int n = 0; n < 2; ++n) bv[mm][bj][n] = *(const f32x4*)(xin + off + bj * HALF + n * 16); }
#pragma unroll
                for (int mm = 0; mm < 2; ++mm) { const int m = 2 * mp + mm; const size_t off = (size_t)(row0 + ai * HALF + m * 16) * 2048 + col0;
#pragma unroll
                    for (int bj = 0; bj < 2; ++bj)
#pragma unroll
                        for (int n = 0; n < 2; ++n) *(f32x4*)(xout + off + bj * HALF + n * 16) = bv[mm][bj][n] + gv[bj][n] * acc[ai][bj][m][n]; }
                asm volatile("" ::: "memory"); }
    }
};
struct EpiRelu2 {
    static constexpr bool PERM = true, AFTER_DRAIN = false;
    bf16_t* O;
    __device__ __forceinline__ void operator()(const f32x4 (&acc)[2][2][4][2], const Unit& u, int wr, int wc, int fr, int fq) const {
        const int row0 = u.pm * BM + wr * 64 + fr, col0 = u.pn * BM + wc * 32 + 8 * fq;
#pragma unroll
        for (int ai = 0; ai < 2; ++ai)
#pragma unroll
            for (int m = 0; m < 4; ++m) { bf16_t* rowp = O + (size_t)(row0 + ai * HALF + m * 16) * 8192 + col0;
#pragma unroll
                for (int bj = 0; bj < 2; ++bj) { f32x4 v0 = acc[ai][bj][m][0], v1 = acc[ai][bj][m][1];
#pragma unroll
                    for (int j = 0; j < 4; ++j) { const float a = fmaxf(v0[j], 0.f), b = fmaxf(v1[j], 0.f); v0[j] = a * a; v1[j] = b * b; }
                    u32x4 w; w.x = cvt_pk_bf16(v0[0], v0[1]); w.y = cvt_pk_bf16(v0[2], v0[3]); w.z = cvt_pk_bf16(v1[0], v1[1]); w.w = cvt_pk_bf16(v1[2], v1[3]);
                    *(u32x4*)(rowp + bj * HALF) = w; } }
    }
};

template <class Epi, class Sched, bool STAMP = false>
__device__ __forceinline__ void gemm_phase(PG8_LAS unsigned char* lds, const Gemm g, const Sched& S, const Epi& E, unsigned long long* stamps) {
    int tid = threadIdx.x; asm volatile("" : "+v"(tid));
    const int wid = __builtin_amdgcn_readfirstlane(tid >> 6), lane = tid & 63, wr = wid >> 2, wc = wid & 3, fr = lane & 15, fq = lane >> 4;
    const int K = g.K, nt = K / BK;
    int ts_lo = 0, ts_hi = 0, nts = 0; const unsigned long long rt_entry = STAMP ? (unsigned long long)wall_clock64() : 0ull;
#define PG8_STAMP() do { if (STAMP && wid == 0 && nts < 64) { const unsigned long long _c = (unsigned long long)clock64(); \
        ts_lo = (lane == nts) ? (int)(unsigned)_c : ts_lo; ts_hi = (lane == nts) ? (int)(unsigned)(_c >> 32) : ts_hi; ++nts; } } while (0)
    PG8_STAMP();
    unsigned voffA[2], voffB[2];
#pragma unroll
    for (int i = 0; i < 2; ++i) { int R, C; stage_rc(tid * 16 + i * 8192, R, C); const int Rb = Epi::PERM ? ((R & ~31) + perm32(R & 31)) : R;
        voffA[i] = (unsigned)(R * K + C) * 2u; voffB[i] = (unsigned)(Rb * K + C) * 2u; }
    const size_t kstep = (size_t)(BK * 2);
    const size_t hstep = (size_t)HALF * K * 2;
    const size_t tstep = 2 * hstep;
    const unsigned ldsw = (unsigned)wid * 1024u;
    const int aoff = lds_byte(wr * 64 + fr, fq * 8), boff = lds_byte(wc * 32 + fr, fq * 8);
#define PG8_SA(b, h) (((b) * 2 + (h)) * HTB)
#define PG8_SB(b, h) ((4 + (b) * 2 + (h)) * HTB)
#define PG8_STAGE(bufoff, gbase, voff) do { _Pragma("unroll") for (int _i = 0; _i < 2; ++_i) \
        __builtin_amdgcn_global_load_lds((const unsigned*)((const char*)(gbase) + (voff)[_i]), (PG8_LAS unsigned*)(lds + (bufoff) + ldsw + _i * 8192), 16, 0, 0); } while (0)
#define PG8_LDA(dst, b, h) do { _Pragma("unroll") for (int m = 0; m < 4; ++m) _Pragma("unroll") for (int k = 0; k < 2; ++k) dst[m][k] = *(const PG8_LAS bf16x8*)(lds + PG8_SA(b, h) + aoff + m * 2048 + k * 1024); } while (0)
#define PG8_LDB(dst, b, h) do { _Pragma("unroll") for (int n = 0; n < 2; ++n) _Pragma("unroll") for (int k = 0; k < 2; ++k) dst[n][k] = *(const PG8_LAS bf16x8*)(lds + PG8_SB(b, h) + boff + n * 2048 + k * 1024); } while (0)
#define PG8_MMA(ai, bj, At, Bt) do { __builtin_amdgcn_s_setprio(1); _Pragma("unroll") for (int m = 0; m < 4; ++m) _Pragma("unroll") for (int n = 0; n < 2; ++n) _Pragma("unroll") for (int k = 0; k < 2; ++k) \
        acc[ai][bj][m][n] = __builtin_amdgcn_mfma_f32_16x16x32_bf16(Bt[n][k], At[m][k], acc[ai][bj][m][n], 0, 0, 0); __builtin_amdgcn_s_setprio(0); } while (0)
#define PG8_WAIT_V(n) asm volatile("s_waitcnt vmcnt(" #n ")" ::: "memory")
#define PG8_WAIT_L(n) asm volatile("s_waitcnt lgkmcnt(" #n ")" ::: "memory")
#define PG8_BAR __builtin_amdgcn_s_barrier()
#define PG8_SCHED __builtin_amdgcn_sched_barrier(0)
    Unit cur, nxt; int ui = 0;
    if (!S.next(0, cur)) return;
    f32x4 acc[2][2][4][2];
#pragma unroll
    for (int a = 0; a < 2; ++a)
#pragma unroll
        for (int b = 0; b < 2; ++b)
#pragma unroll
            for (int m = 0; m < 4; ++m)
#pragma unroll
                for (int n = 0; n < 2; ++n) acc[a][b][m][n] = (f32x4){0.f, 0.f, 0.f, 0.f};
    bf16x8 At[4][2], B0[2][2], B1[2][2];
    const char* cA = (const char*)g.A + (size_t)cur.pm * tstep; const char* cB = (const char*)g.Bt + (size_t)cur.pn * tstep;
    S.a_ready(cur);
    PG8_STAGE(PG8_SB(0, 0), cB, voffB); PG8_STAGE(PG8_SA(0, 0), cA, voffA); PG8_STAGE(PG8_SB(0, 1), cB + hstep, voffB); PG8_STAGE(PG8_SA(0, 1), cA + hstep, voffA);
    if (wr == 1) PG8_BAR;
    PG8_WAIT_V(4); PG8_BAR;
    PG8_STAGE(PG8_SB(1, 0), cB + kstep, voffB); PG8_STAGE(PG8_SA(1, 0), cA + kstep, voffA); PG8_STAGE(PG8_SB(1, 1), cB + hstep + kstep, voffB);
    PG8_WAIT_V(6); PG8_BAR;
    PG8_STAMP();
    for (;;) {
        const bool has_next = S.next(ui + 1, nxt);
        const char* nA = has_next ? (const char*)g.A + (size_t)nxt.pm * tstep : cA; const char* nB = has_next ? (const char*)g.Bt + (size_t)nxt.pn * tstep : cB;
        for (int t = 0; t < nt; t += 2) {
            const bool last = (t == nt - 2);
            const char* a1 = cA + (size_t)(t + 1) * kstep;
            const char* a2 = last ? nA : cA + (size_t)(t + 2) * kstep; const char* b2 = last ? nB : cB + (size_t)(t + 2) * kstep;
            const char* a3 = a2 + kstep; const char* b3 = b2 + kstep;
            if (last && has_next) S.a_ready(nxt);
            PG8_LDB(B0, 0, 0); PG8_SCHED; PG8_LDA(At, 0, 0); PG8_STAGE(PG8_SA(1, 1), a1 + hstep, voffA);
            PG8_WAIT_L(8); PG8_BAR; PG8_WAIT_L(0); PG8_MMA(0, 0, At, B0); PG8_BAR; PG8_SCHED;
            PG8_LDB(B1, 0, 1); PG8_STAGE(PG8_SB(0, 0), b2, voffB);
            PG8_BAR; PG8_WAIT_L(0); PG8_MMA(0, 1, At, B1); PG8_BAR;
            PG8_LDA(At, 0, 1); PG8_STAGE(PG8_SA(0, 0), a2, voffA);
            PG8_BAR; PG8_WAIT_L(0); PG8_MMA(1, 0, At, B0); PG8_BAR; PG8_SCHED;
            PG8_STAGE(PG8_SB(0, 1), b2 + hstep, voffB);
            PG8_WAIT_V(6); PG8_BAR; PG8_MMA(1, 1, At, B1); PG8_BAR;
            PG8_LDB(B0, 1, 0); PG8_SCHED; PG8_LDA(At, 1, 0); PG8_STAGE(PG8_SA(0, 1), a2 + hstep, voffA);
            PG8_WAIT_L(8); PG8_BAR; PG8_WAIT_L(0); PG8_MMA(0, 0, At, B0); PG8_BAR; PG8_SCHED;
            PG8_LDB(B1, 1, 1); PG8_STAGE(PG8_SB(1, 0), b3, voffB);
            PG8_BAR; PG8_WAIT_L(0); PG8_MMA(0, 1, At, B1); PG8_BAR;
            PG8_LDA(At, 1, 1); PG8_STAGE(PG8_SA(1, 0), a3, voffA);
            PG8_BAR; PG8_WAIT_L(0); PG8_MMA(1, 0, At, B0); PG8_BAR; PG8_SCHED;
            PG8_STAGE(PG8_SB(1, 1), b3 + hstep, voffB);
            PG8_WAIT_V(6); PG8_BAR; PG8_MMA(1, 1, At, B1); PG8_BAR;
        }
        PG8_STAMP();
        if constexpr (!Epi::AFTER_DRAIN) { E(acc, cur, wr, wc, fr, fq); S.done(cur); }
        PG8_STAMP();
        if (!has_next) break;
#pragma unroll
        for (int a = 0; a < 2; ++a)
#pragma unroll
            for (int b = 0; b < 2; ++b)
#pragma unroll
                for (int m = 0; m < 4; ++m)
#pragma unroll
                    for (int n = 0; n < 2; ++n) acc[a][b][m][n] = (f32x4){0.f, 0.f, 0.f, 0.f};
        cur = nxt; cA = nA; cB = nB; ++ui;
    }
    PG8_WAIT_V(0);
    if (wr == 0) PG8_BAR;
    PG8_BAR;
    if constexpr (Epi::AFTER_DRAIN) { E.fused(acc, cur, wr, wc, fr, fq, lds, wid, lane); S.done(cur); }
    PG8_STAMP();
    if (STAMP && wid == 0) { stamps[lane] = lane < nts ? (((unsigned long long)(unsigned)ts_hi << 32) | (unsigned)ts_lo) : 0ull;
        if (lane == 62) stamps[62] = rt_entry; if (lane == 63) stamps[63] = (unsigned long long)wall_clock64(); }
#undef PG8_STAMP
#undef PG8_SA
#undef PG8_SB
#undef PG8_STAGE
#undef PG8_LDA
#undef PG8_LDB
#undef PG8_MMA
#undef PG8_WAIT_V
#undef PG8_WAIT_L
#undef PG8_BAR
#undef PG8_SCHED
}
}
using namespace pg8;
namespace cg = cooperative_groups;
#define LAS PG8_LAS
#define DI __device__ __forceinline__

constexpr int T_ = 8192, D_ = 2048, INW = 15376, NP1 = 15616, DFF = 8192;
constexpr int LDS_BYTES = 147456;
constexpr int NTHR = 512;
constexpr float EPS = 1e-6f;

constexpr size_t SZ_WT_IN = (size_t)NP1 * 2048 * 2, SZ_WT_BR = (size_t)2048 * 1024 * 2, SZ_WT_O = (size_t)2048 * 2048 * 2, SZ_WT_M = (size_t)8192 * 2048 * 2;
constexpr size_t SZ_WL = SZ_WT_IN + 3 * SZ_WT_BR + SZ_WT_O + 2 * SZ_WT_M;
constexpr size_t WS_W = 0;
constexpr size_t WS_MOD = WS_W + 2 * SZ_WL;
constexpr size_t WS_XC = WS_MOD + 2 * 12288 * 4;
constexpr size_t WS_H = WS_XC + (size_t)T_ * D_ * 4;
constexpr size_t WS_PROJ = WS_H + (size_t)T_ * D_ * 2;
constexpr size_t WS_BA = WS_PROJ + (size_t)T_ * 15360 * 2;
constexpr size_t WS_R2 = WS_BA + (size_t)T_ * 16 * 4;
constexpr size_t G_A = WS_R2;
constexpr size_t G_BT = G_A + (size_t)T_ * 2048 * 2;
constexpr size_t G_C = G_BT + (size_t)T_ * 2048 * 2;
constexpr size_t G_D = G_C + (size_t)T_ * 1024 * 2;
constexpr size_t G_GL = G_D + (size_t)T_ * 1024 * 2;
constexpr size_t R_SC = G_GL + 4096;
constexpr size_t R_QI = R_SC + (size_t)T_ * 256 * 2;
constexpr size_t R_VT = R_QI + (size_t)T_ * 512 * 2;
constexpr size_t WS_R3 = R_VT + (size_t)T_ * 1024 * 2;
constexpr size_t WS_OA = WS_R3;
constexpr size_t WS_OB = WS_OA + (size_t)T_ * 1024 * 4;
constexpr size_t WS_CV = WS_OB + (size_t)T_ * 1024 * 4;
constexpr size_t WS_ACT = WS_CV + (size_t)T_ * 1024 * 4;
constexpr size_t WS_MB = WS_ACT + 3 * (size_t)T_ * 1024 * 2;
constexpr size_t WS_BAR = WS_MB + (size_t)T_ * D_ * 2;
constexpr size_t WS_PROG = WS_BAR + 16384;
constexpr size_t WS_END = WS_PROG + 16384;
constexpr size_t R_P = WS_OA;
constexpr size_t G_S = WS_H;
constexpr size_t R_RT = WS_MB;
constexpr size_t WS_MF = WS_R2;
static_assert(WS_MF + (size_t)T_ * D_ * 4 <= WS_R3, "merged f32 alias");

struct Params {
    const float* x; const float* c; const int* pos; const float* w_ada; const float* b_ada; const float* norm_mix_w; const float* norm_mlp_w; const float* w_in;
    const float* conv_qkv_w; const float* a_log; const float* dt_bias; const float* gdn_norm_w; const float* conv_dw_w; const float* conv_dw_b; const float* conv_ln_w; const float* conv_ln_b;
    const float* w_a; const float* w_b; const float* w_c; const float* w_out; const float* w_mi; const float* w_mo; const float* final_w;
    float* out; unsigned char* ws; int ph_lo, ph_hi;
};

DI unsigned pk2(float lo, float hi) { return cvt_pk_bf16(lo, hi); }
DI bf16_t f2bf(float f) { return (bf16_t)(cvt_pk_bf16(f, 0.f) & 0xffffu); }
DI float siluf_(float x) { return x / (1.0f + __expf(-x)); }
DI float ret_lg2(int hr) { return hr == 0 ? -0.04580368961312479f : hr == 1 ? -0.02272007650008353f : hr == 2 ? -0.011315313227834146f : -0.005646563141142063f; }
DI float wave_sum(float v) {
#pragma unroll
    for (int o = 1; o < 64; o <<= 1) v += __shfl_xor(v, o);
    return v;
}
DI void lds_barrier() { asm volatile("s_waitcnt lgkmcnt(0)" ::: "memory"); __builtin_amdgcn_s_barrier(); asm volatile("" ::: "memory"); }
DI void full_barrier() { asm volatile("s_waitcnt vmcnt(0) lgkmcnt(0)" ::: "memory"); __builtin_amdgcn_s_barrier(); asm volatile("" ::: "memory"); }
DI f32x4 mfma16(bf16x8 a, bf16x8 b, f32x4 c) { return __builtin_amdgcn_mfma_f32_16x16x32_bf16(a, b, c, 0, 0, 0); }
DI bf16x8 lds_frag(LAS unsigned char* base, int row, int stride_el, int k0) { return *(const LAS bf16x8*)(base + ((size_t)row * stride_el + k0) * 2); }
DI void unpack8(const u32x4 w, float (&f)[8]) { f[0] = bf_lo(w.x); f[1] = bf_hi(w.x); f[2] = bf_lo(w.y); f[3] = bf_hi(w.y); f[4] = bf_lo(w.z); f[5] = bf_hi(w.z); f[6] = bf_lo(w.w); f[7] = bf_hi(w.w); }
DI u32x4 pack8(const float* f) { u32x4 w; w.x = pk2(f[0], f[1]); w.y = pk2(f[2], f[3]); w.z = pk2(f[4], f[5]); w.w = pk2(f[6], f[7]); return w; }

#define XB_TMO      128
#define XB_XCNT(j)  (256  + 64 * (j))
#define XB_XSUB(j)  (1280 + 64 * (j))
#define XB_XGEN(j)  (2304 + 64 * (j))
#define XB_TOP      3328
#define XB_TOPGEN   3392
#define XCD_BAR_WORDS 3456
#define XB_SPIN_CAP (1u << 18)


__device__ __forceinline__ unsigned xb_ld(unsigned* p)              { return __hip_atomic_load(p, __ATOMIC_RELAXED, __HIP_MEMORY_SCOPE_AGENT); }
__device__ __forceinline__ unsigned xb_add(unsigned* p, unsigned v) { return __hip_atomic_fetch_add(p, v, __ATOMIC_RELAXED, __HIP_MEMORY_SCOPE_AGENT); }
__device__ __forceinline__ unsigned xb_xcc_id() { return (unsigned)__builtin_amdgcn_s_getreg((3 << 11) | 20) & 0xFu; }
#define XB_SPIN(cond, bar) do { unsigned _sp = 0; while (cond) { __builtin_amdgcn_s_sleep(1); \
    if ((++_sp & 255u) == 0u) { if (xb_ld(&(bar)[XB_TMO])) break; if (_sp > XB_SPIN_CAP) { atomicAdd(&(bar)[XB_TMO], 1u); break; } } } } while (0)

struct XcdBarrier {
    unsigned* bar; unsigned x;
    volatile LAS unsigned* st;
};

__device__ __forceinline__ XcdBarrier xcd_barrier_post(unsigned* bar, volatile LAS unsigned* st) {
    XcdBarrier b; b.bar = bar; b.x = xb_xcc_id(); b.st = st;
    if (threadIdx.x == 0) (void)xb_add(&bar[XB_XCNT(b.x)], 1u);
    return b;
}
__device__ __forceinline__ void xcd_barrier_complete(unsigned* bar, unsigned x, unsigned& nloc, unsigned& nx) {
    const unsigned G = gridDim.x * gridDim.y * gridDim.z;
    unsigned sum, cnt, mine, sp = 0u;
    for (;;) {
        sum = 0u; cnt = 0u; mine = 0u;
#pragma unroll
        for (unsigned j = 0; j < 16; ++j) { const unsigned c = xb_ld(&bar[XB_XCNT(j)]); sum += c; cnt += (c > 0u) ? 1u : 0u; mine = (j == x) ? c : mine; }
        if (sum == G) break;
        __builtin_amdgcn_s_sleep(1);
        if ((++sp & 255u) == 0u) { if (xb_ld(&bar[XB_TMO])) break; if (sp > XB_SPIN_CAP) { atomicAdd(&bar[XB_TMO], 1u); break; } }
    }
    nloc = mine > 0u ? mine : 1u; nx = cnt > 0u ? cnt : 1u;
}

__device__ __forceinline__ void xcd_barrier(const XcdBarrier& b) {
    asm volatile("s_waitcnt vmcnt(0)" ::: "memory");
    __syncthreads();
    if (threadIdx.x == 0) {
        unsigned* bar = b.bar;
        __builtin_amdgcn_s_waitcnt(0);
        unsigned nloc = b.st[0], nx = b.st[1];
        if (nloc == 0u) { xcd_barrier_complete(bar, b.x, nloc, nx); b.st[0] = nloc; b.st[1] = nx; }
        const unsigned old = xb_add(&bar[XB_XSUB(b.x)], 1u);
        const unsigned gen = old / nloc;
        if (old + 1u == (gen + 1u) * nloc) {
            __builtin_amdgcn_fence(__ATOMIC_RELEASE, "agent");
            asm volatile("s_waitcnt vmcnt(0)" ::: "memory");
            const unsigned og = xb_add(&bar[XB_TOP], 1u);
            const unsigned tg = og / nx;
            if (og + 1u == (tg + 1u) * nx) xb_add(&bar[XB_TOPGEN], 1u);
            else XB_SPIN(xb_ld(&bar[XB_TOPGEN]) == tg, bar);
            __builtin_amdgcn_fence(__ATOMIC_ACQUIRE, "agent");
            xb_add(&bar[XB_XGEN(b.x)], 1u);
            asm volatile("s_waitcnt vmcnt(0)" ::: "memory");
        } else {
            XB_SPIN(xb_ld(&bar[XB_XGEN(b.x)]) == gen, bar);
            __builtin_amdgcn_fence(__ATOMIC_ACQUIRE, "agent");
            asm volatile("s_waitcnt vmcnt(0)" ::: "memory");
        }
    }
    __syncthreads();
}


DI void transpose_item(const float* W, int ldw, int K, int src_col0, int valid, bf16_t* WT, int dst_row0, int k0, LAS float* scr, int lane) {
    const int nn = lane & 31;
    float tv[64];
#pragma unroll
    for (int i = 0; i < 64; ++i) { const int kk = 2 * i + (lane >> 5);
        tv[i] = 0.f; if (nn < valid) tv[i] = W[(size_t)(k0 + kk) * ldw + src_col0 + nn]; }
#pragma unroll
    for (int i = 0; i < 64; ++i) { const int kk = 2 * i + (lane >> 5); scr[kk * 33 + nn] = tv[i]; }
    asm volatile("s_waitcnt lgkmcnt(0)" ::: "memory");
    const int c = lane & 15;
#pragma unroll
    for (int j = 0; j < 8; ++j) { const int n = (lane >> 4) + 4 * j; const LAS float* s = scr + (8 * c) * 33 + n;
        u32x4 o; o.x = pk2(s[0 * 33], s[1 * 33]); o.y = pk2(s[2 * 33], s[3 * 33]); o.z = pk2(s[4 * 33], s[5 * 33]); o.w = pk2(s[6 * 33], s[7 * 33]);
        *(u32x4*)(WT + (size_t)(dst_row0 + n) * K + k0 + 8 * c) = o; }
    asm volatile("s_waitcnt lgkmcnt(0)" ::: "memory");
}

DI void phase_prep(const Params& p, unsigned char* wsp, LAS unsigned char* lds, int tid) {
    const int lane = tid & 63, wave = tid >> 6, G = gridDim.x, b = blockIdx.x;
    float* mod = (float*)(wsp + WS_MOD);
    for (int u = b; u < 192; u += G) {
        const int l = u / 96, strip = u % 96, kg = tid >> 5, cl = tid & 31, col = 128 * strip + 4 * cl;
        f32x4 acc = {0.f, 0.f, 0.f, 0.f};
        const float* wp = p.w_ada + (size_t)l * 2048 * 12288 + col;
#pragma unroll 16
        for (int k = kg; k < 2048; k += 16) { const float s = siluf_(p.c[k]); const f32x4 w = *(const f32x4*)(wp + (size_t)k * 12288); acc += s * w; }
        LAS f32x4* red = (LAS f32x4*)lds;
        red[kg * 32 + cl] = acc;
        lds_barrier();
        if (tid < 128) { float s = 0.f; const LAS float* rf = (const LAS float*)lds;
#pragma unroll
            for (int g = 0; g < 16; ++g) s += rf[g * 128 + tid];
            mod[l * 12288 + 128 * strip + tid] = s + p.b_ada[l * 12288 + 128 * strip + tid]; }
        lds_barrier();
    }
    LAS float* scr = (LAS float*)(lds + wave * 17408);
    const int gw = b * 8 + wave, NGW = G * 8;
    constexpr int I_IN = 488 * 16, I_BR = 64 * 8, I_O = 64 * 16, I_MI = 256 * 16, I_MO = 64 * 64, I_L = I_IN + 3 * I_BR + I_O + I_MI + I_MO;
    for (int it = gw; it < 2 * I_L; it += NGW) {
        const int l = it / I_L; int r = it % I_L;
        unsigned char* wl = wsp + WS_W + (size_t)l * SZ_WL;
        if (r < I_IN) { const int kb = r / 488, nb = r % 488, d0 = 32 * nb; int src, valid;
            if (d0 < 4096) { src = d0; valid = 32; } else if (d0 < 15360) { src = d0 + 16; valid = 32; } else if (d0 == 15360) { src = 4096; valid = 16; } else { src = 0; valid = 0; }
            transpose_item(p.w_in + (size_t)l * 2048 * INW, INW, 2048, src, valid, (bf16_t*)wl, d0, 128 * kb, scr, lane); continue; }
        r -= I_IN;
        if (r < 3 * I_BR) { const int which = r / I_BR, q = r % I_BR, kb = q / 64, nb = q % 64;
            const float* W = (which == 0 ? p.w_a : which == 1 ? p.w_b : p.w_c) + (size_t)l * 1024 * 2048;
            transpose_item(W, 2048, 1024, 32 * nb, 32, (bf16_t*)(wl + SZ_WT_IN + which * SZ_WT_BR), 32 * nb, 128 * kb, scr, lane); continue; }
        r -= 3 * I_BR;
        if (r < I_O) { const int kb = r / 64, nb = r % 64;
            transpose_item(p.w_out + (size_t)l * 2048 * 2048, 2048, 2048, 32 * nb, 32, (bf16_t*)(wl + SZ_WT_IN + 3 * SZ_WT_BR), 32 * nb, 128 * kb, scr, lane); continue; }
        r -= I_O;
        if (r < I_MI) { const int kb = r / 256, nb = r % 256;
            transpose_item(p.w_mi + (size_t)l * 2048 * 8192, 8192, 2048, 32 * nb, 32, (bf16_t*)(wl + SZ_WT_IN + 3 * SZ_WT_BR + SZ_WT_O), 32 * nb, 128 * kb, scr, lane); continue; }
        r -= I_MI;
        { const int kb = r / 64, nb = r % 64;
            transpose_item(p.w_mo + (size_t)l * 8192 * 2048, 2048, 8192, 32 * nb, 32, (bf16_t*)(wl + SZ_WT_IN + 3 * SZ_WT_BR + SZ_WT_O + SZ_WT_M), 32 * nb, 128 * kb, scr, lane); }
    }
}

DI void phase_norm(const float* xin, const float* nw, const float* scale, const float* shift, bf16_t* H, float* outf, int tid) {
    const int lane = tid & 63, wave = tid >> 6, gw = blockIdx.x * 8 + wave, NGW = gridDim.x * 8;
    for (int row0 = gw; row0 < T_; row0 += 2 * NGW) {
        const int row1 = (row0 + NGW < T_) ? row0 + NGW : row0;
        f32x4 v[2][8]; float ss[2] = {0.f, 0.f};
#pragma unroll
        for (int r = 0; r < 2; ++r) { const float* xr = xin + (size_t)(r ? row1 : row0) * D_;
#pragma unroll
            for (int j = 0; j < 8; ++j) v[r][j] = *(const f32x4*)(xr + (j * 64 + lane) * 4); }
#pragma unroll
        for (int r = 0; r < 2; ++r) {
#pragma unroll
            for (int j = 0; j < 8; ++j) ss[r] += (v[r][j][0] * v[r][j][0] + v[r][j][1] * v[r][j][1]) + (v[r][j][2] * v[r][j][2] + v[r][j][3] * v[r][j][3]);
            ss[r] = wave_sum(ss[r]); }
#pragma unroll
        for (int r = 0; r < 2; ++r) { const int row = r ? row1 : row0; if (r == 1 && row1 == row0) break;
            const float rstd = 1.0f / sqrtf(ss[r] * (1.0f / D_) + EPS);
#pragma unroll
            for (int j = 0; j < 8; ++j) { const int c = (j * 64 + lane) * 4; const f32x4 w = *(const f32x4*)(nw + c);
                f32x4 y = v[r][j] * rstd * w;
                if (H) { const f32x4 sc = *(const f32x4*)(scale + c), sh = *(const f32x4*)(shift + c); y = y * (1.0f + sc) + sh;
                    u32x2 o; o.x = pk2(y[0], y[1]); o.y = pk2(y[2], y[3]); *(u32x2*)(H + (size_t)row * D_ + c) = o; }
                else *(f32x4*)(outf + (size_t)row * D_ + c) = y; } }
    }
}

DI void gdn_prep_unit(const Params& p, unsigned char* wsp, int l, int hh, int n, LAS unsigned char* lds, int tid) {
    asm volatile("" : "+v"(tid));
    const int lane = tid & 63, wave = tid >> 6, quad = lane >> 4, l15 = lane & 15;
    const int r = tid >> 3, cgp = tid & 7, t = 64 * n + r;
    constexpr int K_OFF = 0, KB_OFF = 17408, Q_OFF = 34816, VBT_OFF = 52224, KBGT_OFF = 70656, KDT_OFF = 89088, T_OFF = 107520, L_OFF = 116736, SG_OFF = 134144, SB_OFF = SG_OFF + 256, GC_OFF = SB_OFF + 256;
    constexpr int ATTI_OFF = 135168, WT_OFF = K_OFF, UT_OFF = KB_OFF;
    static_assert(ATTI_OFF + 9216 <= LDS_BYTES - 16, "lds");
    const bf16_t* PROJ = (const bf16_t*)(wsp + WS_PROJ); const float* BA = (const float*)(wsp + WS_BA);
    const size_t ub = (size_t)hh * 128 + n;
    u32x4 pa[3][4][2];
#pragma unroll
    for (int X = 0; X < 3; ++X) { const int ch = X * 1024 + hh * 128 + 16 * cgp;
#pragma unroll
        for (int j = 0; j < 4; ++j) { const int tt = t - 3 + j; pa[X][j][0] = (u32x4){0u, 0u, 0u, 0u}; pa[X][j][1] = (u32x4){0u, 0u, 0u, 0u};
            if (tt >= 0) { pa[X][j][0] = *(const u32x4*)(PROJ + (size_t)tt * PROJ_LD + ch); pa[X][j][1] = *(const u32x4*)(PROJ + (size_t)tt * PROJ_LD + ch + 8); } } }
    float ba_b = 0.f, ba_a = 0.f;
    if (cgp == 0) { ba_b = BA[(size_t)t * 16 + hh]; ba_a = BA[(size_t)t * 16 + 8 + hh]; }
    {   LAS float* CW = (LAS float*)lds;
#pragma unroll
        for (int i = 0; i < 3; ++i) { const int f = tid + 512 * i, X = f >> 9, j = (f >> 7) & 3, c = f & 127;
            CW[f] = p.conv_qkv_w[((size_t)l * 4 + j) * 3072 + X * 1024 + hh * 128 + c]; } }
    lds_barrier();
    float val[3][16];
#pragma unroll
    for (int X = 0; X < 3; ++X) {
#pragma unroll
        for (int i = 0; i < 16; ++i) val[X][i] = 0.f;
#pragma unroll
        for (int j = 0; j < 4; ++j) { float xa[8], xb[8]; unpack8(pa[X][j][0], xa); unpack8(pa[X][j][1], xb);
            const LAS float* cw = (const LAS float*)lds + X * 512 + j * 128 + 16 * cgp;
#pragma unroll
            for (int q4 = 0; q4 < 4; ++q4) { const f32x4 w = *(const LAS f32x4*)(cw + 4 * q4);
#pragma unroll
                for (int e = 0; e < 4; ++e) { const int i = 4 * q4 + e; val[X][i] += w[e] * (i < 8 ? xa[i] : xb[i - 8]); } } }
#pragma unroll
        for (int i = 0; i < 16; ++i) val[X][i] = siluf_(val[X][i]);
    }
    {   float sq = 0.f, sk = 0.f;
#pragma unroll
        for (int i = 0; i < 16; ++i) { sq += val[0][i] * val[0][i]; sk += val[1][i] * val[1][i]; }
        sq += __shfl_xor(sq, 1); sq += __shfl_xor(sq, 2); sq += __shfl_xor(sq, 4);
        sk += __shfl_xor(sk, 1); sk += __shfl_xor(sk, 2); sk += __shfl_xor(sk, 4);
        const float rq = (1.0f / sqrtf(sq + 1e-6f)) * 0.08838834764831845f, rk = 1.0f / sqrtf(sk + 1e-6f);
#pragma unroll
        for (int i = 0; i < 16; ++i) { val[0][i] *= rq; val[1][i] *= rk; }
    }
    LAS float* SG = (LAS float*)(lds + SG_OFF); LAS float* SB = (LAS float*)(lds + SB_OFF); LAS float* GC = (LAS float*)(lds + GC_OFF);
    if (cgp == 0) { const float ab = ba_b, aa = ba_a;
        const float xx = aa + p.dt_bias[l * 8 + hh]; const float sp = xx > 20.f ? xx : __logf(1.0f + __expf(xx));
        SG[r] = -expf(p.a_log[l * 8 + hh]) * sp; SB[r] = 1.0f / (1.0f + expf(-ab)); }
    lds_barrier();
    if (wave == 0) { float xg = SG[lane];
#pragma unroll
        for (int o = 1; o < 64; o <<= 1) { const float y = __shfl_up(xg, o); if (lane >= o) xg += y; }
        GC[lane] = xg; }
    lds_barrier();
    {   const float bta = SB[r], gcr = GC[r], glast = GC[63], eg = expf(gcr), ekd = expf(glast - gcr);
        float tq[16], tk[16], tkb[16];
#pragma unroll
        for (int i = 0; i < 16; ++i) { tq[i] = val[0][i]; tk[i] = val[1][i]; tkb[i] = val[1][i] * bta; }
        *(LAS u32x4*)(lds + K_OFF + (r * 136 + 16 * cgp) * 2) = pack8(tk); *(LAS u32x4*)(lds + K_OFF + (r * 136 + 16 * cgp + 8) * 2) = pack8(tk + 8);
        *(LAS u32x4*)(lds + KB_OFF + (r * 136 + 16 * cgp) * 2) = pack8(tkb); *(LAS u32x4*)(lds + KB_OFF + (r * 136 + 16 * cgp + 8) * 2) = pack8(tkb + 8);
        *(LAS u32x4*)(lds + Q_OFF + (r * 136 + 16 * cgp) * 2) = pack8(tq); *(LAS u32x4*)(lds + Q_OFF + (r * 136 + 16 * cgp + 8) * 2) = pack8(tq + 8);
#pragma unroll
        for (int i = 0; i < 16; ++i) { const int e = 16 * cgp + i;
            const int rs = (((r >> 3) ^ cgp) << 3) + (r & 7);
            *(LAS bf16_t*)(lds + VBT_OFF + (e * 72 + rs) * 2) = f2bf(val[2][i] * bta);
            *(LAS bf16_t*)(lds + KBGT_OFF + (e * 72 + rs) * 2) = f2bf(tkb[i] * eg);
            *(LAS bf16_t*)(lds + KDT_OFF + (e * 72 + rs) * 2) = f2bf(tk[i] * ekd); }
        if (tid == 0) ((float*)(wsp + G_GL))[ub] = expf(glast);
    }
    lds_barrier();
    LAS float* Lm = (LAS float*)(lds + L_OFF);
#pragma unroll
    for (int tt = 0; tt < 2; ++tt) { const int id = 2 * wave + tt, mi = id >> 2, ni = id & 3;
        f32x4 aK = {0.f, 0.f, 0.f, 0.f}, aA = {0.f, 0.f, 0.f, 0.f};
#pragma unroll
        for (int ks = 0; ks < 4; ++ks) { const bf16x8 kf = lds_frag(lds + K_OFF, 16 * ni + l15, 136, 32 * ks + 8 * quad);
            const bf16x8 kbf = lds_frag(lds + KB_OFF, 16 * mi + l15, 136, 32 * ks + 8 * quad), qf = lds_frag(lds + Q_OFF, 16 * mi + l15, 136, 32 * ks + 8 * quad);
            aK = mfma16(kbf, kf, aK);
            aA = mfma16(kf, qf, aA); }
        { const int s = 16 * ni + l15; const float gs = GC[s];
#pragma unroll
            for (int j = 0; j < 4; ++j) { const int c = 16 * mi + 4 * quad + j; Lm[c * 68 + s] = (c > s) ? aK[j] * expf(GC[c] - gs) : 0.f; } }
        { const int c = 16 * mi + l15; const float gcc = GC[c]; float o[4];
#pragma unroll
            for (int j = 0; j < 4; ++j) { const int s = 16 * ni + 4 * quad + j; o[j] = (c >= s) ? aA[j] * expf(gcc - GC[s]) : 0.f; }
            u32x2 w; w.x = pk2(o[0], o[1]); w.y = pk2(o[2], o[3]);
            *(LAS u32x2*)(lds + ATTI_OFF + (c * 72 + 16 * ni + 4 * quad) * 2) = w; }
    }
    lds_barrier();
    if (wave == 0) {
        float Tc[64];
        int zoff; asm volatile("v_mov_b32 %0, 0" : "=v"(zoff));
        const LAS float* Lz = Lm + zoff;
#pragma unroll
        for (int i = 0; i < 64; ++i) { float a = (lane == i) ? 1.f : 0.f;
#pragma unroll
            for (int j4 = 0; j4 < (i + 3) / 4; ++j4) { const f32x4 lv = *(const LAS f32x4*)(Lz + i * 68 + 4 * j4);
#pragma unroll
                for (int jj = 0; jj < 4; ++jj) if (4 * j4 + jj < i) a -= lv[jj] * Tc[4 * j4 + jj]; }
            Tc[i] = a; if ((i & 3) == 3) asm volatile("" ::: "memory"); }
#pragma unroll
        for (int i = 0; i < 64; ++i) *(LAS bf16_t*)(lds + T_OFF + (i * 72 + lane) * 2) = f2bf(Tc[i]);
    }
    lds_barrier();
    {   bf16x8 vf[2], gf[2];
#pragma unroll
        for (int ks = 0; ks < 2; ++ks) { vf[ks] = lds_frag(lds + VBT_OFF, 16 * wave + l15, 72, 8 * ((4 * ks + quad) ^ wave)); gf[ks] = lds_frag(lds + KBGT_OFF, 16 * wave + l15, 72, 8 * ((4 * ks + quad) ^ wave)); }
#pragma unroll
        for (int mi = 0; mi < 4; ++mi) { f32x4 aU = {0.f, 0.f, 0.f, 0.f}, aW = {0.f, 0.f, 0.f, 0.f};
#pragma unroll
            for (int ks = 0; ks < 2; ++ks) { const bf16x8 tf = lds_frag(lds + T_OFF, 16 * mi + l15, 72, 32 * ks + 8 * quad);
                aU = mfma16(tf, vf[ks], aU); aW = mfma16(tf, gf[ks], aW); }
            u32x2 wu; wu.x = pk2(aU[0], aU[1]); wu.y = pk2(aU[2], aU[3]);
            u32x2 ww; ww.x = pk2(aW[0], aW[1]); ww.y = pk2(aW[2], aW[3]);
            *(LAS u32x2*)(lds + UT_OFF + ((16 * wave + l15) * 64 + 16 * mi + 4 * quad) * 2) = wu;
            *(LAS u32x2*)(lds + WT_OFF + ((16 * wave + l15) * 64 + 16 * mi + 4 * quad) * 2) = ww; }
    }
    lds_barrier();
    {   bf16x8 kdf[2], wtf[2], utf[2];
#pragma unroll
        for (int ks = 0; ks < 2; ++ks) { kdf[ks] = lds_frag(lds + KDT_OFF, 16 * wave + l15, 72, 8 * ((4 * ks + quad) ^ wave));
            wtf[ks] = lds_frag(lds + WT_OFF, 16 * wave + l15, 64, 32 * ks + 8 * quad); utf[ks] = lds_frag(lds + UT_OFF, 16 * wave + l15, 64, 32 * ks + 8 * quad); }
        bf16_t* GA = (bf16_t*)(wsp + G_A) + ub * 16384; bf16_t* GB = (bf16_t*)(wsp + G_BT) + ub * 16384;
        bf16_t* GCp = (bf16_t*)(wsp + G_C) + ub * 8192; bf16_t* GD = (bf16_t*)(wsp + G_D) + ub * 8192;
#pragma unroll
        for (int t2 = 0; t2 < 8; ++t2) {
            f32x4 aA = {0.f, 0.f, 0.f, 0.f}, aB = {0.f, 0.f, 0.f, 0.f};
#pragma unroll
            for (int ks = 0; ks < 2; ++ks) { const bf16x8 wx = lds_frag(lds + WT_OFF, 16 * t2 + l15, 64, 32 * ks + 8 * quad), kx = lds_frag(lds + KDT_OFF, 16 * t2 + l15, 72, 8 * ((4 * ks + quad) ^ t2));
                aA = mfma16(wx, kdf[ks], aA);
                aB = mfma16(kx, utf[ks], aB); }
            u32x2 wa; wa.x = pk2(-aA[0], -aA[1]); wa.y = pk2(-aA[2], -aA[3]);
            *(u32x2*)(GA + ((wave * 4 + (t2 >> 1)) * 64 + (2 * (t2 & 1) + (quad >> 1)) * 16 + l15) * 8 + 4 * (quad & 1)) = wa;
            u32x2 wb; wb.x = pk2(aB[0], aB[1]); wb.y = pk2(aB[2], aB[3]);
            *(u32x2*)(GB + ((((wave >> 1) * 8 + t2) * 64 + quad * 16 + l15) * 2 + (wave & 1)) * 4) = wb; }
#pragma unroll
        for (int mi = 0; mi < 4; ++mi) {
            f32x4 aC = {0.f, 0.f, 0.f, 0.f}, aD = {0.f, 0.f, 0.f, 0.f};
#pragma unroll
            for (int ks = 0; ks < 2; ++ks) { const bf16x8 af = lds_frag(lds + ATTI_OFF, 16 * mi + l15, 72, 32 * ks + 8 * quad);
                aC = mfma16(wtf[ks], af, aC);
                aD = mfma16(utf[ks], af, aD); }
            const int c = 16 * mi + l15; const float egc = expf(GC[c]);
            const u32x2 qw = *(const LAS u32x2*)(lds + Q_OFF + (c * 136 + 16 * wave + 4 * quad) * 2);
            u32x2 wc; wc.x = pk2(bf_lo(qw.x) * egc - aC[0], bf_hi(qw.x) * egc - aC[1]); wc.y = pk2(bf_lo(qw.y) * egc - aC[2], bf_hi(qw.y) * egc - aC[3]);
            *(u32x2*)(GCp + ((mi * 4 + (wave >> 1)) * 64 + (2 * (wave & 1) + (quad >> 1)) * 16 + l15) * 8 + 4 * (quad & 1)) = wc;
            u32x2 wd; wd.x = pk2(aD[0], aD[1]); wd.y = pk2(aD[2], aD[3]);
            *(u32x2*)(GD + ((wave * 4 + mi) * 64 + quad * 16 + l15) * 4) = wd; }
    }
    lds_barrier();
}

DI void ret_prep_unit(const Params& p, unsigned char* wsp, int hr, int n, LAS unsigned char* lds, int tid) {
    asm volatile("" : "+v"(tid));
    const int lane = tid & 63, wave = tid >> 6, quad = lane >> 4, l15 = lane & 15;
    const int r = tid >> 3, cgp = tid & 7, t = 64 * n + r;
    constexpr int RQ_OFF = 0, RK_OFF = 17408, KTT_OFF = 34816, VT_OFF = 53248;
    const bf16_t* PROJ = (const bf16_t*)(wsp + WS_PROJ);
    const size_t ub = (size_t)hr * 128 + n;
    const float lg2 = ret_lg2(hr);
    const float xi = exp2f((float)(r + 1) * lg2), zeta = exp2f((float)(63 - r) * lg2);
    const float posf = (float)p.pos[t];
    {   const bf16_t* pq = PROJ + (size_t)t * PROJ_LD + 4096 + hr * 128 + 8 * cgp; const bf16_t* pk = PROJ + (size_t)t * PROJ_LD + 4608 + hr * 128 + 8 * cgp;
        float q1[8], q2[8], k1[8], k2[8];
        unpack8(*(const u32x4*)pq, q1); unpack8(*(const u32x4*)(pq + 64), q2); unpack8(*(const u32x4*)pk, k1); unpack8(*(const u32x4*)(pk + 64), k2);
        float rq1[8], rq2[8], rk1[8], rk2[8];
#pragma unroll
        for (int ii = 0; ii < 8; ++ii) { const int i = 8 * cgp + ii;
            const float invf = expf(-(float)i * (9.210340371976184f / 64.0f)); const float ang = posf * invf; const float trev = ang * 0.15915494309189535f; const float fr = trev - rintf(trev);
            const float cs = __builtin_amdgcn_cosf(fr), sn = __builtin_amdgcn_sinf(fr);
            rq1[ii] = q1[ii] * cs - q2[ii] * sn; rq2[ii] = q1[ii] * sn + q2[ii] * cs;
            rk1[ii] = (k1[ii] * cs - k2[ii] * sn) * 0.08838834764831845f; rk2[ii] = (k1[ii] * sn + k2[ii] * cs) * 0.08838834764831845f; }
        *(LAS u32x4*)(lds + RQ_OFF + (r * 136 + 8 * cgp) * 2) = pack8(rq1); *(LAS u32x4*)(lds + RQ_OFF + (r * 136 + 64 + 8 * cgp) * 2) = pack8(rq2);
        *(LAS u32x4*)(lds + RK_OFF + (r * 136 + 8 * cgp) * 2) = pack8(rk1); *(LAS u32x4*)(lds + RK_OFF + (r * 136 + 64 + 8 * cgp) * 2) = pack8(rk2);
#pragma unroll
        for (int ii = 0; ii < 8; ++ii) { *(LAS bf16_t*)(lds + KTT_OFF + ((8 * cgp + ii) * 72 + r) * 2) = f2bf(rk1[ii] * zeta); *(LAS bf16_t*)(lds + KTT_OFF + ((64 + 8 * cgp + ii) * 72 + r) * 2) = f2bf(rk2[ii] * zeta);
            rq1[ii] *= xi; rq2[ii] *= xi; }
        bf16_t* QI = (bf16_t*)(wsp + R_QI) + ub * 8192 + (size_t)((((r >> 4) * 4 + (cgp >> 2)) * 64 + (cgp & 3) * 16 + (r & 15)) * 8);
        *(u32x4*)QI = pack8(rq1); *(u32x4*)(QI + 2 * 512) = pack8(rq2);
    }
    {   const bf16_t* pv = PROJ + (size_t)t * PROJ_LD + 5120 + hr * 256 + 32 * cgp;
#pragma unroll
        for (int q = 0; q < 4; ++q) { float vv[8]; unpack8(*(const u32x4*)(pv + 8 * q), vv);
#pragma unroll
            for (int i = 0; i < 8; ++i) *(LAS bf16_t*)(lds + VT_OFF + ((32 * cgp + 8 * q + i) * 72 + r) * 2) = f2bf(vv[i]); }
    }
    lds_barrier();
#pragma unroll
    for (int tt = 0; tt < 2; ++tt) { const int id = 2 * wave + tt, mi = id >> 2, ni = id & 3;
        f32x4 aA = {0.f, 0.f, 0.f, 0.f};
#pragma unroll
        for (int ks = 0; ks < 4; ++ks) { const bf16x8 kf = lds_frag(lds + RK_OFF, 16 * ni + l15, 136, 32 * ks + 8 * quad), qf = lds_frag(lds + RQ_OFF, 16 * mi + l15, 136, 32 * ks + 8 * quad);
            aA = mfma16(kf, qf, aA); }
        const int c = 16 * mi + l15; float o[4];
#pragma unroll
        for (int j = 0; j < 4; ++j) { const int s = 16 * ni + 4 * quad + j; o[j] = (c >= s) ? aA[j] * exp2f((float)(c - s) * lg2) : 0.f; }
        u32x2 w; w.x = pk2(o[0], o[1]); w.y = pk2(o[2], o[3]);
        *(u32x2*)((bf16_t*)(wsp + R_SC) + ub * 4096 + ((mi * 2 + (ni >> 1)) * 64 + (2 * (ni & 1) + (quad >> 1)) * 16 + l15) * 8 + 4 * (quad & 1)) = w; }
    {
        bf16x8 kf[2];
#pragma unroll
        for (int ks = 0; ks < 2; ++ks) kf[ks] = lds_frag(lds + KTT_OFF, 16 * wave + l15, 72, 32 * ks + 8 * quad);
        float* PT = (float*)(wsp + R_P) + ub * 32768;
#pragma unroll 4
        for (int et = 0; et < 16; ++et) { f32x4 a = {0.f, 0.f, 0.f, 0.f};
#pragma unroll
            for (int ks = 0; ks < 2; ++ks) a = mfma16(kf[ks], lds_frag(lds + VT_OFF, 16 * et + l15, 72, 32 * ks + 8 * quad), a);
            *(f32x4*)(PT + ((et * 4 + (wave >> 1)) * 64 + (2 * (wave & 1) + (quad >> 1)) * 16 + l15) * 8 + 4 * (quad & 1)) = a; }
    }
#pragma unroll
    for (int i = 0; i < 4; ++i) { const int id = tid + 512 * i, blk = id >> 6, row = 16 * (blk >> 1) + (id & 15), chn = 4 * (blk & 1) + ((id >> 4) & 3);
        *(u32x4*)((bf16_t*)(wsp + R_VT) + ub * 16384 + (size_t)id * 8) = *(const LAS u32x4*)(lds + VT_OFF + (row * 72 + 8 * chn) * 2); }
    lds_barrier();
}

struct SFrag { bf16x8 af[4]; u32x2 bt[2]; };
DI void sfrag_load(SFrag& f, const unsigned char* ws, int hh, int es, int n, int wave, int quad, int l15) {
    const size_t ub = (size_t)hh * 128 + n;
    const int lane = quad * 16 + l15;
    const bf16_t* Ap = (const bf16_t*)(ws + G_A) + ub * 16384 + (size_t)(wave * 4) * 512 + lane * 8;
    const bf16_t* Bp = (const bf16_t*)(ws + G_BT) + ub * 16384 + (size_t)((es * 8 + wave) * 64 + lane) * 8;
#pragma unroll
    for (int ks = 0; ks < 4; ++ks) f.af[ks] = *(const bf16x8*)(Ap + ks * 512);
    {   const u32x4 b4 = *(const u32x4*)Bp; f.bt[0] = (u32x2){b4.x, b4.y}; f.bt[1] = (u32x2){b4.z, b4.w}; }
}
DI void gdn_chain(const Params& p, unsigned char* wsp, int l, int hh, int es, LAS unsigned char* lds, int tid) {
    asm volatile("" : "+v"(tid));
    const int lane = tid & 63, wave = tid >> 6, quad = lane >> 4, l15 = lane & 15;
    constexpr int ST_BYTES = 8704;
    for (int i = tid; i < 2 * ST_BYTES / 4; i += NTHR) ((LAS unsigned*)lds)[i] = 0u;
    LAS float* GLs = (LAS float*)(lds + 2 * ST_BYTES);
    if (tid < 128) GLs[tid] = ((const float*)(wsp + G_GL))[hh * 128 + tid];
    f32x4 Sacc[2] = {{0.f, 0.f, 0.f, 0.f}, {0.f, 0.f, 0.f, 0.f}};
    bf16_t* SG = (bf16_t*)(wsp + G_S) + ((size_t)hh * 128) * 16384 + (size_t)(((2 * es + (wave >> 2)) * 4 + (wave & 3)) * 64 + lane) * 8;
    const int srd = ((16 * (wave >> 2) + l15) * 136 + 32 * (wave & 3) + 8 * quad) * 2;
    SFrag f0, f1, f2, f3, f4, f5;
#define CFENCE() asm volatile("" ::: "memory")
    sfrag_load(f0, wsp, hh, es, 0, wave, quad, l15); CFENCE(); sfrag_load(f1, wsp, hh, es, 1, wave, quad, l15); CFENCE(); sfrag_load(f2, wsp, hh, es, 2, wave, quad, l15); CFENCE();
    sfrag_load(f3, wsp, hh, es, 3, wave, quad, l15); CFENCE(); sfrag_load(f4, wsp, hh, es, 4, wave, quad, l15); CFENCE();
#undef CFENCE
    lds_barrier();
#define S_STEP(cur, n) do { \
        LAS unsigned char* sc = lds + ((n) & 1) * ST_BYTES; LAS unsigned char* sn = lds + (((n) + 1) & 1) * ST_BYTES; \
        const float glv = GLs[(n)]; \
        bf16x8 sfr[2][4]; \
        _Pragma("unroll") for (int et = 0; et < 2; ++et) _Pragma("unroll") for (int ks = 0; ks < 4; ++ks) sfr[et][ks] = lds_frag(sc, 16 * et + l15, 136, 32 * ks + 8 * quad);     \
        *(u32x4*)(SG + (size_t)(n) * 16384) = *(const LAS u32x4*)(sc + srd);                  \
        _Pragma("unroll") for (int et = 0; et < 2; ++et) { \
            f32x4 a; a[0] = Sacc[et][0] * glv + bf_lo(cur.bt[et].x); a[1] = Sacc[et][1] * glv + bf_hi(cur.bt[et].x); a[2] = Sacc[et][2] * glv + bf_lo(cur.bt[et].y); a[3] = Sacc[et][3] * glv + bf_hi(cur.bt[et].y); \
            _Pragma("unroll") for (int ks = 0; ks < 4; ++ks) a = mfma16(cur.af[ks], sfr[et][ks], a);     \
            Sacc[et] = a; \
            u32x2 w; w.x = pk2(a[0], a[1]); w.y = pk2(a[2], a[3]); \
            *(LAS u32x2*)(sn + ((16 * et + l15) * 136 + 16 * wave + 4 * quad) * 2) = w; } \
        lds_barrier(); } while (0)
#define S_LOAD(f, n) sfrag_load(f, wsp, hh, es, (n) < 128 ? (n) : 127, wave, quad, l15)
    for (int n = 0; n < 126; n += 6) {
        S_LOAD(f5, n + 5);  S_STEP(f0, n);
        S_LOAD(f0, n + 6);  S_STEP(f1, n + 1);
        S_LOAD(f1, n + 7);  S_STEP(f2, n + 2);
        S_LOAD(f2, n + 8);  S_STEP(f3, n + 3);
        S_LOAD(f3, n + 9);  S_STEP(f4, n + 4);
        S_LOAD(f4, n + 10); S_STEP(f5, n + 5);
    }
    S_STEP(f0, 126); S_STEP(f1, 127);
#undef S_STEP
#undef S_LOAD
}

DI void ret_scan(unsigned char* wsp, int sb, int tid) {
    const int idx = sb * NTHR + tid;
    const int hr = idx >> 13, off = (idx & 8191) * 4;
    const float cd = exp2f(64.0f * ret_lg2(hr));
    const float* P = (const float*)(wsp + R_P) + (size_t)hr * 128 * 32768 + off;
    bf16_t* RT = (bf16_t*)(wsp + R_RT) + (size_t)hr * 128 * 32768 + off;
    f32x4 R = {0.f, 0.f, 0.f, 0.f};
    for (int n0 = 0; n0 < 128; n0 += 16) {
        f32x4 pv[16];
#pragma unroll
        for (int i = 0; i < 16; ++i) pv[i] = *(const f32x4*)(P + (size_t)(n0 + i) * 32768);
#pragma unroll
        for (int i = 0; i < 16; ++i) { u32x2 w; w.x = pk2(R[0], R[1]); w.y = pk2(R[2], R[3]); *(u32x2*)(RT + (size_t)(n0 + i) * 32768) = w; R = R * cd + pv[i]; }
    }
}

DI void gdn_out_unit(const Params& p, unsigned char* wsp, int l, int hh, int n, LAS unsigned char* lds, int tid) {
    asm volatile("" : "+v"(tid));
    const int lane = tid & 63, wave = tid >> 6, quad = lane >> 4, l15 = lane & 15;
    const size_t ub = (size_t)hh * 128 + n;
    const bf16_t* Sp = (const bf16_t*)(wsp + G_S) + ub * 16384 + (size_t)(wave * 4) * 512 + lane * 8;
    const bf16_t* Cp = (const bf16_t*)(wsp + G_C) + ub * 8192 + lane * 8;
    const bf16_t* Dp = (const bf16_t*)(wsp + G_D) + ub * 8192 + (size_t)((wave * 4) * 64 + lane) * 4;
    bf16x8 sf[4]; f32x4 acc[4];
    const int e0 = 16 * wave + 4 * quad;
    const bf16_t* PROJ = (const bf16_t*)(wsp + WS_PROJ);
    u32x2 zwv[4];
#pragma unroll
    for (int mi = 0; mi < 4; ++mi) zwv[mi] = *(const u32x2*)(PROJ + (size_t)(64 * n + 16 * mi + l15) * PROJ_LD + 3072 + hh * 128 + e0);
    const f32x4 nw = *(const f32x4*)(p.gdn_norm_w + l * 128 + e0);
#pragma unroll
    for (int ks = 0; ks < 4; ++ks) sf[ks] = *(const bf16x8*)(Sp + ks * 512);
#pragma unroll
    for (int mi = 0; mi < 4; ++mi) { const u32x2 dw = *(const u32x2*)(Dp + mi * 256);
        f32x4 a; a[0] = bf_lo(dw.x); a[1] = bf_hi(dw.x); a[2] = bf_lo(dw.y); a[3] = bf_hi(dw.y);
#pragma unroll
        for (int ks = 0; ks < 4; ++ks) a = mfma16(sf[ks], *(const bf16x8*)(Cp + (mi * 4 + ks) * 512), a);
        acc[mi] = a; }
    LAS float* red = (LAS float*)lds;
#pragma unroll
    for (int mi = 0; mi < 4; ++mi) { float s = (acc[mi][0] * acc[mi][0] + acc[mi][1] * acc[mi][1]) + (acc[mi][2] * acc[mi][2] + acc[mi][3] * acc[mi][3]);
        s += __shfl_xor(s, 16); s += __shfl_xor(s, 32);
        if (quad == 0) red[wave * 64 + 16 * mi + l15] = s; }
    lds_barrier();
    bf16_t* ACTA = (bf16_t*)(wsp + WS_ACT);
#pragma unroll
    for (int mi = 0; mi < 4; ++mi) { const int c = 16 * mi + l15; float tot = 0.f;
#pragma unroll
        for (int w8 = 0; w8 < 8; ++w8) tot += red[w8 * 64 + c];
        const float rs = 1.0f / sqrtf(tot * (1.0f / 128.0f) + EPS);
        const size_t t = (size_t)(64 * n + c);
        const u32x2 zw = zwv[mi];
        u32x2 o; o.x = pk2(acc[mi][0] * rs * nw[0] * siluf_(bf_lo(zw.x)), acc[mi][1] * rs * nw[1] * siluf_(bf_hi(zw.x)));
        o.y = pk2(acc[mi][2] * rs * nw[2] * siluf_(bf_lo(zw.y)), acc[mi][3] * rs * nw[3] * siluf_(bf_hi(zw.y)));
        *(u32x2*)(ACTA + t * 1024 + hh * 128 + e0) = o; }
    lds_barrier();
}
DI void ret_out_unit(const Params& p, unsigned char* wsp, int hr, int n, LAS unsigned char* lds, int tid) {
    asm volatile("" : "+v"(tid));
    const int lane = tid & 63, wave = tid >> 6, quad = lane >> 4, l15 = lane & 15;
    const size_t ub = (size_t)hr * 128 + n;
    const bf16_t* Qp = (const bf16_t*)(wsp + R_QI) + ub * 8192 + lane * 8;
    const bf16_t* Sp = (const bf16_t*)(wsp + R_SC) + ub * 4096 + lane * 8;
    const bf16_t* PROJ = (const bf16_t*)(wsp + WS_PROJ);
    u32x2 bgw[2][4];
#pragma unroll
    for (int tt = 0; tt < 2; ++tt)
#pragma unroll
        for (int mi = 0; mi < 4; ++mi) bgw[tt][mi] = *(const u32x2*)(PROJ + (size_t)(64 * n + 16 * mi + l15) * PROJ_LD + 6144 + hr * 256 + 16 * (2 * wave + tt) + 4 * quad);
    f32x4 acc[2][4];
#pragma unroll
    for (int tt = 0; tt < 2; ++tt) { const int et = 2 * wave + tt;
        const bf16_t* Rp = (const bf16_t*)(wsp + R_RT) + ub * 32768 + (size_t)(et * 4) * 512 + lane * 8;
        const bf16_t* Vp = (const bf16_t*)(wsp + R_VT) + ub * 16384 + (size_t)(et * 2) * 512 + lane * 8;
        bf16x8 rf[4], vf[2];
#pragma unroll
        for (int ks = 0; ks < 4; ++ks) rf[ks] = *(const bf16x8*)(Rp + ks * 512);
#pragma unroll
        for (int ks = 0; ks < 2; ++ks) vf[ks] = *(const bf16x8*)(Vp + ks * 512);
#pragma unroll
        for (int mi = 0; mi < 4; ++mi) { f32x4 a = {0.f, 0.f, 0.f, 0.f};
#pragma unroll
            for (int ks = 0; ks < 4; ++ks) a = mfma16(rf[ks], *(const bf16x8*)(Qp + (mi * 4 + ks) * 512), a);
#pragma unroll
            for (int ks = 0; ks < 2; ++ks) a = mfma16(vf[ks], *(const bf16x8*)(Sp + (mi * 2 + ks) * 512), a);
            acc[tt][mi] = a; } }
    LAS float* red = (LAS float*)lds;
#pragma unroll
    for (int mi = 0; mi < 4; ++mi) { float s = 0.f, q = 0.f;
#pragma unroll
        for (int tt = 0; tt < 2; ++tt) { const f32x4 a = acc[tt][mi]; s += (a[0] + a[1]) + (a[2] + a[3]); q += (a[0] * a[0] + a[1] * a[1]) + (a[2] * a[2] + a[3] * a[3]); }
        s += __shfl_xor(s, 16); s += __shfl_xor(s, 32); q += __shfl_xor(q, 16); q += __shfl_xor(q, 32);
        if (quad == 0) { red[(wave * 64 + 16 * mi + l15) * 2] = s; red[(wave * 64 + 16 * mi + l15) * 2 + 1] = q; } }
    lds_barrier();
    bf16_t* ACTB = (bf16_t*)(wsp + WS_ACT) + (size_t)T_ * 1024;
#pragma unroll
    for (int mi = 0; mi < 4; ++mi) { const int c = 16 * mi + l15; float S = 0.f, Q = 0.f;
#pragma unroll
        for (int w8 = 0; w8 < 8; ++w8) { S += red[(w8 * 64 + c) * 2]; Q += red[(w8 * 64 + c) * 2 + 1]; }
        const float mu = S * (1.0f / 256.0f), var = fmaxf(Q * (1.0f / 256.0f) - mu * mu, 0.f), rs = 1.0f / sqrtf(var + 1e-5f);
#pragma unroll
        for (int tt = 0; tt < 2; ++tt) { const f32x4 a = acc[tt][mi]; const u32x2 g = bgw[tt][mi];
            u32x2 o; o.x = pk2((a[0] - mu) * rs * siluf_(bf_lo(g.x)), (a[1] - mu) * rs * siluf_(bf_hi(g.x))); o.y = pk2((a[2] - mu) * rs * siluf_(bf_lo(g.y)), (a[3] - mu) * rs * siluf_(bf_hi(g.y)));
            *(u32x2*)(ACTB + (size_t)(64 * n + c) * 1024 + hr * 256 + 16 * (2 * wave + tt) + 4 * quad) = o; } }
    lds_barrier();
}

DI void sub_barrier(unsigned* cnt, unsigned target) {
    asm volatile("s_waitcnt vmcnt(0)" ::: "memory");
    __syncthreads();
    if (threadIdx.x == 0) {
        __builtin_amdgcn_fence(__ATOMIC_RELEASE, "agent");
        asm volatile("s_waitcnt vmcnt(0)" ::: "memory");
        (void)__hip_atomic_fetch_add(cnt, 1u, __ATOMIC_RELAXED, __HIP_MEMORY_SCOPE_AGENT);
        unsigned sp = 0;
        while (__hip_atomic_load(cnt, __ATOMIC_RELAXED, __HIP_MEMORY_SCOPE_AGENT) < target) { __builtin_amdgcn_s_sleep(24); if (++sp > (1u << 20)) break; }
        __builtin_amdgcn_fence(__ATOMIC_ACQUIRE, "agent");
        asm volatile("s_waitcnt vmcnt(0)" ::: "memory");
    }
    __syncthreads();
}

DI void conv_unit(const Params& p, unsigned char* wsp, int l, int u, LAS unsigned char* lds, int tid) {
    asm volatile("" : "+v"(tid));
    const int tt = u >> 2, cs = u & 3, t0 = 64 * tt;
    const bf16_t* PROJ = (const bf16_t*)(wsp + WS_PROJ);
    LAS float* Ug = (LAS float*)lds;
    {   const int c8 = tid & 31, rg = tid >> 5;
        u32x4 ga[6], gg[6];
#pragma unroll
        for (int i = 0; i < 6; ++i) { const int rr = rg + 16 * i, t = t0 - 30 + rr; ga[i] = (u32x4){0u, 0u, 0u, 0u}; gg[i] = (u32x4){0u, 0u, 0u, 0u};
            if (rr < 94 && t >= 0) { ga[i] = *(const u32x4*)(PROJ + (size_t)t * PROJ_LD + 7168 + 256 * cs + 8 * c8); gg[i] = *(const u32x4*)(PROJ + (size_t)t * PROJ_LD + 8192 + 256 * cs + 8 * c8); } }
#pragma unroll
        for (int i = 0; i < 6; ++i) { const int rr = rg + 16 * i;
            if (rr < 94) { float a[8], g[8], o[8]; unpack8(ga[i], a); unpack8(gg[i], g);
#pragma unroll
                for (int q = 0; q < 8; ++q) o[q] = a[q] * sigmoidf_(g[q]);
                *(LAS f32x4*)(Ug + rr * 256 + 8 * c8) = (f32x4){o[0], o[1], o[2], o[3]}; *(LAS f32x4*)(Ug + rr * 256 + 8 * c8 + 4) = (f32x4){o[4], o[5], o[6], o[7]}; } }
    }
    lds_barrier();
    {   const int ch = tid & 255, half = tid >> 8, cg_ = 256 * cs + ch;
        float w[31];
#pragma unroll
        for (int j = 0; j < 31; ++j) w[j] = p.conv_dw_w[((size_t)l * 31 + j) * 1024 + cg_];
        const float bias = p.conv_dw_b[l * 1024 + cg_];
        float* CV = (float*)(wsp + WS_CV);
        for (int tl = 32 * half; tl < 32 * half + 32; ++tl) { float a = bias;
#pragma unroll
            for (int j = 0; j < 31; ++j) a += w[j] * Ug[(tl + j) * 256 + ch];
            CV[(size_t)(t0 + tl) * 1024 + cg_] = a; }
    }
    lds_barrier();
}

DI void phase_post(const Params& p, unsigned char* wsp, int l, int tid, const int mask, const int b0, const int nblk) {
    const int lane = tid & 63, wave = tid >> 6, gw = ((int)blockIdx.x - b0) * 8 + wave, NGW = nblk * 8;
    const bf16_t* PROJ = (const bf16_t*)(wsp + WS_PROJ);
    const float* OA = (const float*)(wsp + WS_OA); const float* OB = (const float*)(wsp + WS_OB); const float* CV = (const float*)(wsp + WS_CV);
    bf16_t* ACTA = (bf16_t*)(wsp + WS_ACT); bf16_t* ACTB = ACTA + (size_t)T_ * 1024; bf16_t* ACTC = ACTB + (size_t)T_ * 1024;
    for (int t = gw; t < T_; t += NGW) {
        if (mask & 1)
#pragma unroll
        for (int hh = 0; hh < 8; ++hh) { const int cc = hh * 128 + 2 * lane;
            const float o0 = OA[(size_t)t * 1024 + cc], o1 = OA[(size_t)t * 1024 + cc + 1];
            const float ss = wave_sum(o0 * o0 + o1 * o1); const float rs = 1.0f / sqrtf(ss * (1.0f / 128.0f) + EPS);
            const unsigned zw = *(const unsigned*)(PROJ + (size_t)t * PROJ_LD + 3072 + cc);
            const float w0 = p.gdn_norm_w[l * 128 + 2 * lane], w1 = p.gdn_norm_w[l * 128 + 2 * lane + 1];
            *(unsigned*)(ACTA + (size_t)t * 1024 + cc) = pk2(o0 * rs * w0 * siluf_(bf_lo(zw)), o1 * rs * w1 * siluf_(bf_hi(zw))); }
        if (mask & 2)
#pragma unroll
        for (int hr = 0; hr < 4; ++hr) { const int cc = hr * 256 + 4 * lane;
            const f32x4 o = *(const f32x4*)(OB + (size_t)t * 1024 + cc);
            const float mu = wave_sum((o[0] + o[1]) + (o[2] + o[3])) * (1.0f / 256.0f);
            const f32x4 d = o - mu; const float var = wave_sum((d[0] * d[0] + d[1] * d[1]) + (d[2] * d[2] + d[3] * d[3])) * (1.0f / 256.0f);
            const float rs = 1.0f / sqrtf(var + 1e-5f);
            const u32x2 gwd = *(const u32x2*)(PROJ + (size_t)t * PROJ_LD + 6144 + cc);
            u32x2 w; w.x = pk2(d[0] * rs * siluf_(bf_lo(gwd.x)), d[1] * rs * siluf_(bf_hi(gwd.x))); w.y = pk2(d[2] * rs * siluf_(bf_lo(gwd.y)), d[3] * rs * siluf_(bf_hi(gwd.y)));
            *(u32x2*)(ACTB + (size_t)t * 1024 + cc) = w; }
        if (mask & 4)
        {   f32x4 v[4]; float s = 0.f;
#pragma unroll
            for (int j = 0; j < 4; ++j) { v[j] = *(const f32x4*)(CV + (size_t)t * 1024 + (j * 64 + lane) * 4); s += (v[j][0] + v[j][1]) + (v[j][2] + v[j][3]); }
            const float mu = wave_sum(s) * (1.0f / 1024.0f); float q = 0.f;
#pragma unroll
            for (int j = 0; j < 4; ++j) { v[j] = v[j] - mu; q += (v[j][0] * v[j][0] + v[j][1] * v[j][1]) + (v[j][2] * v[j][2] + v[j][3] * v[j][3]); }
            const float rs = 1.0f / sqrtf(wave_sum(q) * (1.0f / 1024.0f) + 1e-5f);
#pragma unroll
            for (int j = 0; j < 4; ++j) { const int cc = (j * 64 + lane) * 4; const f32x4 lw = *(const f32x4*)(p.conv_ln_w + l * 1024 + cc), lb = *(const f32x4*)(p.conv_ln_b + l * 1024 + cc);
                const f32x4 y = v[j] * rs * lw + lb;
                u32x2 w; w.x = pk2(siluf_(y[0]), siluf_(y[1])); w.y = pk2(siluf_(y[2]), siluf_(y[3]));
                *(u32x2*)(ACTC + (size_t)t * 1024 + cc) = w; }
        }
    }
}

template <class Epi> DI void run_gemm(LAS unsigned char* lds, const bf16_t* A, const bf16_t* Bt, int N, int K, const Epi& E) {
    Gemm g{A, Bt, T_, N, K}; StaticOrder S; S.init(T_, N, (int)gridDim.x, (int)blockIdx.x);
    gemm_phase<Epi, StaticOrder, false>(lds, g, S, E, nullptr);
}

DI void run_phase(const Params& p, unsigned char* wsp, int ph, LAS unsigned char* lds, int tid) {
    const int G = gridDim.x, b = blockIdx.x;
#ifndef SUBM
#define SUBM 3
#endif
#ifndef PHM
#define PHM 0xFFF
#endif
    if (ph == 0) { if (PHM & 0x400) phase_prep(p, wsp, lds, tid); return; }
    if (ph == 21) { if (PHM & 0x800) phase_norm((const float*)(wsp + WS_XC), p.final_w, nullptr, nullptr, nullptr, p.out, tid); return; }
    const int l = (ph - 1) / 10, sp = (ph - 1) % 10;
    const float* mod = (const float*)(wsp + WS_MOD) + l * 12288;
    const float* xin = (l == 0) ? p.x : (const float*)(wsp + WS_XC);
    float* XC = (float*)(wsp + WS_XC);
    bf16_t* H = (bf16_t*)(wsp + WS_H);
    bf16_t* PROJ = (bf16_t*)(wsp + WS_PROJ);
    const unsigned char* wl = wsp + WS_W + (size_t)l * SZ_WL;
    const bf16_t* WT_IN = (const bf16_t*)wl; const bf16_t* WT_BR = (const bf16_t*)(wl + SZ_WT_IN); const bf16_t* WT_O = (const bf16_t*)(wl + SZ_WT_IN + 3 * SZ_WT_BR);
    const bf16_t* WT_MI = (const bf16_t*)(wl + SZ_WT_IN + 3 * SZ_WT_BR + SZ_WT_O); const bf16_t* WT_MO = (const bf16_t*)(wl + SZ_WT_IN + 3 * SZ_WT_BR + SZ_WT_O + SZ_WT_M);
    switch (sp) {
    case 0: if (PHM & (1<<0)) phase_norm(xin, p.norm_mix_w + l * D_, mod + 2048, mod, H, nullptr, tid); break;
    case 1: if (PHM & (1<<1)) { EpiProj E{PROJ, (float*)(wsp + WS_BA)}; run_gemm(lds, H, WT_IN, NP1, 2048, E); } break;
    case 2: if (PHM & (1<<2)) for (int u = b; u < 1024; u += G) gdn_prep_unit(p, wsp, l, u >> 7, u & 127, lds, tid); break;
    case 3: if (PHM & (1<<3)) {
        if (b < 32) { gdn_chain(p, wsp, l, b >> 2, b & 3, lds, tid); lds_barrier(); }
        else {
            const int nb = b - 32, NB = G - 32; unsigned* cnt = (unsigned*)(wsp + WS_PROG) + 1024;
            for (int u = nb; u < 1024; u += NB) { if (u < 512) ret_prep_unit(p, wsp, u >> 7, u & 127, lds, tid); else conv_unit(p, wsp, l, u - 512, lds, tid); }
            sub_barrier(cnt, (unsigned)(NB * (l + 1)));
            if (nb < 64) ret_scan(wsp, nb, tid);
        }
    } break;
    case 4: if (PHM & (1<<4)) {
        for (int u = b; u < 1536; u += G) { if (u < 1024) gdn_out_unit(p, wsp, l, u >> 7, u & 127, lds, tid); else ret_out_unit(p, wsp, (u - 1024) >> 7, (u - 1024) & 127, lds, tid); }
        phase_post(p, wsp, l, tid, 4, 0, G);
    } break;
    case 5: if (PHM & (1<<5)) { const bf16_t* ACT = (const bf16_t*)(wsp + WS_ACT); float* MF = (float*)(wsp + WS_MF); bf16_t* MB = (bf16_t*)(wsp + WS_MB);
        { EpiBranch<0> E{PROJ, MF, MB}; run_gemm(lds, ACT, WT_BR, 2048, 1024, E); }
        { EpiBranch<1> E{PROJ, MF, MB}; run_gemm(lds, ACT + (size_t)T_ * 1024, WT_BR + (size_t)2048 * 1024, 2048, 1024, E); }
        { EpiBranch<2> E{PROJ, MF, MB}; run_gemm(lds, ACT + 2 * (size_t)T_ * 1024, WT_BR + 2 * (size_t)2048 * 1024, 2048, 1024, E); }
    } break;
    case 6: if (PHM & (1<<6)) { EpiResid E{xin, XC, mod + 4096}; run_gemm(lds, (const bf16_t*)(wsp + WS_MB), WT_O, 2048, 2048, E); } break;
    case 7: if (PHM & (1<<7)) phase_norm(XC, p.norm_mlp_w + l * D_, mod + 8192, mod + 6144, H, nullptr, tid); break;
    case 8: if (PHM & (1<<8)) { EpiRelu2 E{PROJ}; run_gemm(lds, H, WT_MI, 8192, 2048, E); } break;
    case 9: if (PHM & (1<<9)) { EpiResid E{XC, XC, mod + 10240}; run_gemm(lds, PROJ, WT_MO, 2048, 8192, E); } break;
    }
}

constexpr int NPHASE = 22;
__global__ void __launch_bounds__(NTHR, 2) mega_kernel(Params p) {
    extern __shared__ __attribute__((aligned(16))) unsigned char smem[];
    LAS unsigned char* lds = (LAS unsigned char*)smem;
    const int tid = threadIdx.x;
    volatile LAS unsigned* xbw = (volatile LAS unsigned*)(lds + LDS_BYTES - 16);
    if (tid == 0) { xbw[0] = 0u; xbw[1] = 0u; }
    __syncthreads();
    if (p.ph_hi - p.ph_lo > 1) (void)xcd_barrier_post((unsigned*)(p.ws + WS_BAR), xbw);
#ifndef PROBE_REP
#define PROBE_REP 0
#endif
    int ph = p.ph_lo, rep = 0, nbar = 0;
    while (ph < p.ph_hi) {
        if (nbar >= 1 && p.ph_hi - p.ph_lo == 2) { __threadfence(); cg::this_grid().sync(); }
        else if (nbar >= 1) { XcdBarrier xb; xb.bar = (unsigned*)(p.ws + WS_BAR); xb.x = xb_xcc_id(); xb.st = (volatile LAS unsigned*)(lds + LDS_BYTES - 16); xcd_barrier(xb); }
        ++nbar;
        int t2 = tid; asm volatile("" : "+v"(t2));
        unsigned char* wsp;
        {   int z; asm volatile("v_mov_b32 %0, 0" : "=v"(z)); z = __builtin_amdgcn_readfirstlane(z);
            wsp = p.ws + z; }
        run_phase(p, wsp, ph, lds, t2);
        const int sp_ = (ph == 0) ? 10 : (ph == 21) ? 11 : (ph - 1) % 10;
        if (rep == 0 && ((PROBE_REP >> sp_) & 1)) rep = 1; else { rep = 0; ++ph; }
    }
}

#ifndef ONE_LAUNCH
#define ONE_LAUNCH 1
#endif
extern "C" void kernel_launch(void* const* d_in, const int* in_sizes, int n_in, void* d_out, int out_size, void* d_ws, size_t ws_size, hipStream_t stream) {
    static int grid = 0;
    if (grid == 0) {
        if (n_in != 23 || ws_size < WS_END) { fprintf(stderr, "kernel_launch: bad inputs (n_in %d ws %zu need %zu)\n", n_in, ws_size, (size_t)WS_END); grid = -1; return; }
        int dev = 0, cus = 0, per_cu = 0;
        hipGetDevice(&dev); hipDeviceGetAttribute(&cus, hipDeviceAttributeMultiprocessorCount, dev);
        if (hipFuncSetAttribute((const void*)mega_kernel, hipFuncAttributeMaxDynamicSharedMemorySize, LDS_BYTES) != hipSuccess) { fprintf(stderr, "hipFuncSetAttribute failed\n"); grid = -1; return; }
        if (hipOccupancyMaxActiveBlocksPerMultiprocessor(&per_cu, (const void*)mega_kernel, NTHR, LDS_BYTES) != hipSuccess || per_cu < 1) per_cu = 1;
        (void)hipGetLastError();
        grid = cus * 1;
    }
    if (grid < 0) return;
    Params p{};
    p.x = (const float*)d_in[0]; p.c = (const float*)d_in[1]; p.pos = (const int*)d_in[2]; p.w_ada = (const float*)d_in[3]; p.b_ada = (const float*)d_in[4];
    p.norm_mix_w = (const float*)d_in[5]; p.norm_mlp_w = (const float*)d_in[6]; p.w_in = (const float*)d_in[7]; p.conv_qkv_w = (const float*)d_in[8];
    p.a_log = (const float*)d_in[9]; p.dt_bias = (const float*)d_in[10]; p.gdn_norm_w = (const float*)d_in[11]; p.conv_dw_w = (const float*)d_in[12]; p.conv_dw_b = (const float*)d_in[13];
    p.conv_ln_w = (const float*)d_in[14]; p.conv_ln_b = (const float*)d_in[15]; p.w_a = (const float*)d_in[16]; p.w_b = (const float*)d_in[17]; p.w_c = (const float*)d_in[18];
    p.w_out = (const float*)d_in[19]; p.w_mi = (const float*)d_in[20]; p.w_mo = (const float*)d_in[21]; p.final_w = (const float*)d_in[22];
    p.out = (float*)d_out; p.ws = (unsigned char*)d_ws;
#if ONE_LAUNCH
    p.ph_lo = 0; p.ph_hi = NPHASE;
    if (hipMemsetAsync((char*)d_ws + WS_BAR, 0, 32768, stream) != hipSuccess) { fprintf(stderr, "memset failed\n"); return; }
    void* args[] = {&p};
    hipError_t e = hipLaunchCooperativeKernel((const void*)mega_kernel, dim3(grid), dim3(NTHR), args, LDS_BYTES, stream);
    if (e != hipSuccess) fprintf(stderr, "cooperative launch failed: %s (grid %d)\n", hipGetErrorString(e), grid);
#else
    for (int ph = 0; ph < NPHASE; ++ph) { p.ph_lo = ph; p.ph_hi = ph + 1;
        hipLaunchKernelGGL(mega_kernel, dim3(grid), dim3(NTHR), LDS_BYTES, stream, p); }
#endif
}
```

```cpp
#include <hip/hip_runtime.h>
#include <hip/hip_cooperative_groups.h>
#include <cstdio>
namespace pg8 {
#define PG8_LAS __attribute__((address_space(3)))
typedef unsigned short bf16_t;
typedef short bf16x8 __attribute__((ext_vector_type(8)));
typedef float f32x4 __attribute__((ext_vector_type(4)));
typedef unsigned u32x4 __attribute__((ext_vector_type(4)));
constexpr int BM = 256, BK = 64, HALF = 128, HTB = HALF * BK * 2  , STAGE_BYTES = 8 * HTB, NXCD = 8, WGM = 8;

__host__ __device__ __forceinline__ int lds_byte(int r, int c) { const int st = (r >> 4) * 2 + (c >> 5), rr = r & 15, cc = c & 31, ob = rr * 64 + cc * 2; return st * 1024 + (ob ^ (((ob >> 9) & 1) << 5)); }
__host__ __device__ __forceinline__ void stage_rc(int b, int& R, int& C) { const int st = b / 1024, sb = b % 1024, swz = sb ^ (((sb >> 9) & 1) << 5); R = (st >> 1) * 16 + swz / 64; C = (st & 1) * 32 + (swz % 64) / 2; }
__host__ __device__ __forceinline__ int perm32(int rho) { const int n = rho >> 4, i = rho & 15; return 8 * (i >> 2) + 4 * n + (i & 3); }

struct Unit { int pm, pn; };
struct Gemm { const bf16_t* A; const bf16_t* Bt; int M, N, K; };

struct StaticOrder {
    int nM, nN, nwg, G, c;
    __host__ __device__ void init(int M, int N, int G_, int c_) { nM = M / BM; nN = N / BM; nwg = nM * nN; G = G_; c = c_; }
    __host__ __device__ bool next(int i, Unit& u) const {
        const long L = (long)i * G + c; if (L >= nwg) return false;
        int wgid = (int)L; { const int q = nwg / NXCD, r = nwg % NXCD, xcd = wgid % NXCD, off = wgid / NXCD; wgid = (xcd < r ? xcd * (q + 1) : r * (q + 1) + (xcd - r) * q) + off; }
        const int nig = WGM * nN, gid = wgid / nig, fm = gid * WGM, gsz = (nM - fm) < WGM ? (nM - fm) : WGM;
        u.pm = fm + ((wgid % nig) % gsz); u.pn = (wgid % nig) / gsz; return true;
    }
    __device__ __forceinline__ void a_ready(const Unit&) const {}
    __device__ __forceinline__ void done(const Unit&) const {}
};
typedef float f32x2c_ __attribute__((ext_vector_type(2)));
typedef __bf16 bf16x2c_ __attribute__((ext_vector_type(2)));
__device__ __forceinline__ unsigned cvt_pk_bf16(float lo, float hi) { const f32x2c_ v = {lo, hi}; const bf16x2c_ b = __builtin_convertvector(v, bf16x2c_); return __builtin_bit_cast(unsigned, b); }
typedef unsigned u32x2 __attribute__((ext_vector_type(2)));
__device__ __forceinline__ float bf_lo(unsigned w) { return __uint_as_float(w << 16); }
__device__ __forceinline__ float bf_hi(unsigned w) { return __uint_as_float(w & 0xffff0000u); }
__device__ __forceinline__ float sigmoidf_(float x) { return 1.0f / (1.0f + __expf(-x)); }

constexpr int PROJ_LD = 15360;

struct EpiProj {
    static constexpr bool PERM = true, AFTER_DRAIN = false;
    bf16_t* O; float* BA;
    __device__ __forceinline__ void operator()(const f32x4 (&acc)[2][2][4][2], const Unit& u, int wr, int wc, int fr, int fq) const {
        const int row0 = u.pm * BM + wr * 64 + fr;
        if (u.pn < 60) {
            const int col0 = u.pn * BM + wc * 32 + 8 * fq;
#pragma unroll
            for (int ai = 0; ai < 2; ++ai)
#pragma unroll
                for (int m = 0; m < 4; ++m) { bf16_t* rowp = O + (size_t)(row0 + ai * HALF + m * 16) * PROJ_LD + col0;
#pragma unroll
                    for (int bj = 0; bj < 2; ++bj) { const f32x4 v0 = acc[ai][bj][m][0], v1 = acc[ai][bj][m][1];
                        u32x4 w; w.x = cvt_pk_bf16(v0[0], v0[1]); w.y = cvt_pk_bf16(v0[2], v0[3]); w.z = cvt_pk_bf16(v1[0], v1[1]); w.w = cvt_pk_bf16(v1[2], v1[3]);
                        *(u32x4*)(rowp + bj * HALF) = w; } }
        } else {
            if (wc == 0 && fq < 2) {
#pragma unroll
                for (int ai = 0; ai < 2; ++ai)
#pragma unroll
                    for (int m = 0; m < 4; ++m) { float* rowp = BA + (size_t)(row0 + ai * HALF + m * 16) * 16 + 8 * fq;
#pragma unroll
                        for (int n = 0; n < 2; ++n) *(f32x4*)(rowp + 4 * n) = acc[ai][0][m][n]; }
            }
        }
    }
};
template <int PASS> struct EpiBranch {
    static constexpr bool PERM = true, AFTER_DRAIN = false;
    const bf16_t* PROJ; float* MF; bf16_t* MB;
    __device__ __forceinline__ void operator()(const f32x4 (&acc)[2][2][4][2], const Unit& u, int wr, int wc, int fr, int fq) const {
        const int row0 = u.pm * BM + wr * 64 + fr, col0 = u.pn * BM + wc * 32 + 8 * fq;
        float* mfb = MF + ((size_t)((u.pm * 8 + u.pn) * 8 + wr * 4 + wc) * 32) * 256 + (fq * 16 + fr) * 4;
#pragma unroll
        for (int ai = 0; ai < 2; ++ai)
#pragma unroll
            for (int mp = 0; mp < 2; ++mp) {
                u32x4 gw[2][2]; f32x4 mv[2][2][2];
#pragma unroll
                for (int mm = 0; mm < 2; ++mm) { const int m = 2 * mp + mm; const size_t row = (size_t)(row0 + ai * HALF + m * 16);
#pragma unroll
                    for (int bj = 0; bj < 2; ++bj) { gw[mm][bj] = *(const u32x4*)(PROJ + row * PROJ_LD + 9216 + PASS * 2048 + col0 + bj * HALF);
#pragma unroll
                        for (int n = 0; n < 2; ++n) if (PASS > 0) mv[mm][bj][n] = *(const f32x4*)(mfb + (((ai * 4 + m) * 2 + bj) * 2 + n) * 256); } }
#pragma unroll
                for (int mm = 0; mm < 2; ++mm) { const int m = 2 * mp + mm; const size_t row = (size_t)(row0 + ai * HALF + m * 16);
#pragma unroll
                    for (int bj = 0; bj < 2; ++bj) { const u32x4 g4 = gw[mm][bj];
                        f32x4 g0, g1; g0[0] = sigmoidf_(bf_lo(g4.x)); g0[1] = sigmoidf_(bf_hi(g4.x)); g0[2] = sigmoidf_(bf_lo(g4.y)); g0[3] = sigmoidf_(bf_hi(g4.y));
                        g1[0] = sigmoidf_(bf_lo(g4.z)); g1[1] = sigmoidf_(bf_hi(g4.z)); g1[2] = sigmoidf_(bf_lo(g4.w)); g1[3] = sigmoidf_(bf_hi(g4.w));
                        f32x4 v0 = g0 * acc[ai][bj][m][0], v1 = g1 * acc[ai][bj][m][1];
                        if (PASS > 0) { v0 += mv[mm][bj][0]; v1 += mv[mm][bj][1]; }
                        if (PASS < 2) { *(f32x4*)(mfb + (((ai * 4 + m) * 2 + bj) * 2 + 0) * 256) = v0; *(f32x4*)(mfb + (((ai * 4 + m) * 2 + bj) * 2 + 1) * 256) = v1; }
                        else { u32x4 w; w.x = cvt_pk_bf16(v0[0], v0[1]); w.y = cvt_pk_bf16(v0[2], v0[3]); w.z = cvt_pk_bf16(v1[0], v1[1]); w.w = cvt_pk_bf16(v1[2], v1[3]);
                            *(u32x4*)(MB + row * 2048 + col0 + bj * HALF) = w; } } }
                asm volatile("" ::: "memory"); }
    }
};
struct EpiResid {
    static constexpr bool PERM = false, AFTER_DRAIN = false;
    const float* xin; float* xout; const float* gate;
    __device__ __forceinline__ void operator()(const f32x4 (&acc)[2][2][4][2], const Unit& u, int wr, int wc, int fr, int fq) const {
        const int row0 = u.pm * BM + wr * 64 + fr, col0 = u.pn * BM + wc * 32 + 4 * fq;
        f32x4 gv[2][2];
#pragma unroll
        for (int bj = 0; bj < 2; ++bj)
#pragma unroll
            for (int n = 0; n < 2; ++n) gv[bj][n] = *(const f32x4*)(gate + col0 + bj * HALF + n * 16);
#pragma unroll
        for (int ai = 0; ai < 2; ++ai)
#pragma unroll
            for (int mp = 0; mp < 2; ++mp) { f32x4 bv[2][2][2];
#pragma unroll
                for (int mm = 0; mm < 2; ++mm) { const size_t off = (size_t)(row0 + ai * HALF + (2 * mp + mm) * 16) * 2048 + col0;
#pragma unroll
                    for (int bj = 0; bj < 2; ++bj)
#pragma unroll
                        for (int n = 0; n < 2; ++n) bv[mm][bj][n] = *(const f32x4*)(xin + off + bj * HALF + n * 16); }
#pragma unroll
                for (int mm = 0; mm < 2; ++mm) { const int m = 2 * mp + mm; const size_t off = (size_t)(row0 + ai * HALF + m * 16) * 2048 + col0;
#pragma unroll
                    for (int bj = 0; bj < 2; ++bj)
#pragma unroll
                        for (int n = 0; n < 2; ++n) *(f32x4*)(xout + off + bj * HALF + n * 16) = bv[mm][bj][n] + gv[bj][n] * acc[ai][bj][m][n]; }
                asm volatile("" ::: "memory"); }
    }
};
struct EpiRelu2 {
    static constexpr bool PERM = true, AFTER_DRAIN = false;
    bf16_t* O;
    __device__ __forceinline__ void operator()(const f32x4 (&acc)[2][2][4][2], const Unit& u, int wr, int wc, int fr, int fq) const {
        const int row0 = u.pm * BM + wr * 64 + fr, col0 = u.pn * BM + wc * 32 + 8 * fq;
#pragma unroll
        for (int ai = 0; ai < 2; ++ai)
#pragma unroll
            for (int m = 0; m < 4; ++m) { bf16_t* rowp = O + (size_t)(row0 + ai * HALF + m * 16) * 8192 + col0;
#pragma unroll
                for (int bj = 0; bj < 2; ++bj) { f32x4 v0 = acc[ai][bj][m][0], v1 = acc[ai][bj][m][1];
#pragma unroll
                    for (int j = 0; j < 4; ++j) { const float a = fmaxf(v0[j], 0.f), b = fmaxf(v1[j], 0.f); v0[j] = a * a; v1[j] = b * b; }
                    u32x4 w; w.x = cvt_pk_bf16(v0[0], v0[1]); w.y = cvt_pk_bf16(v0[2], v0[3]); w.z = cvt_pk_bf16(v1[0], v1[1]); w.w = cvt_pk_bf16(v1[2], v1[3]);
                    *(u32x4*)(rowp + bj * HALF) = w; } }
    }
};

template <class Epi, class Sched, bool STAMP = false>
__device__ __forceinline__ void gemm_phase(PG8_LAS unsigned char* lds, const Gemm g, const Sched& S, const Epi& E, unsigned long long* stamps) {
    int tid = threadIdx.x; asm volatile("" : "+v"(tid));
    const int wid = __builtin_amdgcn_readfirstlane(tid >> 6), lane = tid & 63, wr = wid >> 2, wc = wid & 3, fr = lane & 15, fq = lane >> 4;
    const int K = g.K, nt = K / BK;
    int ts_lo = 0, ts_hi = 0, nts = 0; const unsigned long long rt_entry = STAMP ? (unsigned long long)wall_clock64() : 0ull;
#define PG8_STAMP() do { if (STAMP && wid == 0 && nts < 64) { const unsigned long long _c = (unsigned long long)clock64(); \
        ts_lo = (lane == nts) ? (int)(unsigned)_c : ts_lo; ts_hi = (lane == nts) ? (int)(unsigned)(_c >> 32) : ts_hi; ++nts; } } while (0)
    PG8_STAMP();
    unsigned voffA[2], voffB[2];
#pragma unroll
    for (int i = 0; i < 2; ++i) { int R, C; stage_rc(tid * 16 + i * 8192, R, C); const int Rb = Epi::PERM ? ((R & ~31) + perm32(R & 31)) : R;
        voffA[i] = (unsigned)(R * K + C) * 2u; voffB[i] = (unsigned)(Rb * K + C) * 2u; }
    const size_t kstep = (size_t)(BK * 2);
    const size_t hstep = (size_t)HALF * K * 2;
    const size_t tstep = 2 * hstep;
    const unsigned ldsw = (unsigned)wid * 1024u;
    const int aoff = lds_byte(wr * 64 + fr, fq * 8), boff = lds_byte(wc * 32 + fr, fq * 8);
#define PG8_SA(b, h) (((b) * 2 + (h)) * HTB)
#define PG8_SB(b, h) ((4 + (b) * 2 + (h)) * HTB)
#define PG8_STAGE(bufoff, gbase, voff) do { _Pragma("unroll") for (int _i = 0; _i < 2; ++_i) \
        __builtin_amdgcn_global_load_lds((const unsigned*)((const char*)(gbase) + (voff)[_i]), (PG8_LAS unsigned*)(lds + (bufoff) + ldsw + _i * 8192), 16, 0, 0); } while (0)
#define PG8_LDA(dst, b, h) do { _Pragma("unroll") for (int m = 0; m < 4; ++m) _Pragma("unroll") for (int k = 0; k < 2; ++k) dst[m][k] = *(const PG8_LAS bf16x8*)(lds + PG8_SA(b, h) + aoff + m * 2048 + k * 1024); } while (0)
#define PG8_LDB(dst, b, h) do { _Pragma("unroll") for (int n = 0; n < 2; ++n) _Pragma("unroll") for (int k = 0; k < 2; ++k) dst[n][k] = *(const PG8_LAS bf16x8*)(lds + PG8_SB(b, h) + boff + n * 2048 + k * 1024); } while (0)
#define PG8_MMA(ai, bj, At, Bt) do { __builtin_amdgcn_s_setprio(1); _Pragma("unroll") for (int m = 0; m < 4; ++m) _Pragma("unroll") for (int n = 0; n < 2; ++n) _Pragma("unroll") for (int k = 0; k < 2; ++k) \
        acc[ai][bj][m][n] = __builtin_amdgcn_mfma_f32_16x16x32_bf16(Bt[n][k], At[m][k], acc[ai][bj][m][n], 0, 0, 0); __builtin_amdgcn_s_setprio(0); } while (0)
#define PG8_WAIT_V(n) asm volatile("s_waitcnt vmcnt(" #n ")" ::: "memory")
#define PG8_WAIT_L(n) asm volatile("s_waitcnt lgkmcnt(" #n ")" ::: "memory")
#define PG8_BAR __builtin_amdgcn_s_barrier()
#define PG8_SCHED __builtin_amdgcn_sched_barrier(0)
    Unit cur, nxt; int ui = 0;
    if (!S.next(0, cur)) return;
    f32x4 acc[2][2][4][2];
#pragma unroll
    for (int a = 0; a < 2; ++a)
#pragma unroll
        for (int b = 0; b < 2; ++b)
#pragma unroll
            for (int m = 0; m < 4; ++m)
#pragma unroll
                for (int n = 0; n < 2; ++n) acc[a][b][m][n] = (f32x4){0.f, 0.f, 0.f, 0.f};
    bf16x8 At[4][2], B0[2][2], B1[2][2];
    const char* cA = (const char*)g.A + (size_t)cur.pm * tstep; const char* cB = (const char*)g.Bt + (size_t)cur.pn * tstep;
    S.a_ready(cur);
    PG8_STAGE(PG8_SB(0, 0), cB, voffB); PG8_STAGE(PG8_SA(0, 0), cA, voffA); PG8_STAGE(PG8_SB(0, 1), cB + hstep, voffB); PG8_STAGE(PG8_SA(0, 1), cA + hstep, voffA);
    if (wr == 1) PG8_BAR;
    PG8_WAIT_V(4); PG8_BAR;
    PG8_STAGE(PG8_SB(1, 0), cB + kstep, voffB); PG8_STAGE(PG8_SA(1, 0), cA + kstep, voffA); PG8_STAGE(PG8_SB(1, 1), cB + hstep + kstep, voffB);
    PG8_WAIT_V(6); PG8_BAR;
    PG8_STAMP();
    for (;;) {
        const bool has_next = S.next(ui + 1, nxt);
        const char* nA = has_next ? (const char*)g.A + (size_t)nxt.pm * tstep : cA; const char* nB = has_next ? (const char*)g.Bt + (size_t)nxt.pn * tstep : cB;
        for (int t = 0; t < nt; t += 2) {
            const bool last = (t == nt - 2);
            const char* a1 = cA + (size_t)(t + 1) * kstep;
            const char* a2 = last ? nA : cA + (size_t)(t + 2) * kstep; const char* b2 = last ? nB : cB + (size_t)(t + 2) * kstep;
            const char* a3 = a2 + kstep; const char* b3 = b2 + kstep;
            if (last && has_next) S.a_ready(nxt);
            PG8_LDB(B0, 0, 0); PG8_SCHED; PG8_LDA(At, 0, 0); PG8_STAGE(PG8_SA(1, 1), a1 + hstep, voffA);
            PG8_WAIT_L(8); PG8_BAR; PG8_WAIT_L(0); PG8_MMA(0, 0, At, B0); PG8_BAR; PG8_SCHED;
            PG8_LDB(B1, 0, 1); PG8_STAGE(PG8_SB(0, 0), b2, voffB);
            PG8_BAR; PG8_WAIT_L(0); PG8_MMA(0, 1, At, B1); PG8_BAR;
            PG8_LDA(At, 0, 1); PG8_STAGE(PG8_SA(0, 0), a2, voffA);
            PG8_BAR; PG8_WAIT_L(0); PG8_MMA(1, 0, At, B0); PG8_BAR; PG8_SCHED;
            PG8_STAGE(PG8_SB(0, 1), b2 + hstep, voffB);
            PG8_WAIT_V(6); PG8_BAR; PG8_MMA(1, 1, At, B1); PG8_BAR;
            PG8_LDB(B0, 1, 0); PG8_SCHED; PG8_LDA(At, 1, 0); PG8_STAGE(PG8_SA(0, 1), a2 + hstep, voffA);
            PG8_WAIT_L(8); PG8_BAR; PG8_WAIT_L(0); PG8_MMA(0, 0, At, B0); PG8_BAR; PG8_SCHED;
            PG8_LDB(B1, 1, 1); PG8_STAGE(PG8_SB(1, 0), b3, voffB);
            PG8_BAR; PG8_WAIT_L(0); PG8_MMA(0, 1, At, B1); PG8_BAR;
            PG8_LDA(At, 1, 1); PG8_STAGE(PG8_SA(1, 0), a3, voffA);
            PG8_BAR; PG8_WAIT_L(0); PG8_MMA(1, 0, At, B0); PG8_BAR; PG8_SCHED;
            PG8_STAGE(PG8_SB(1, 1), b3 + hstep, voffB);
            PG8_WAIT_V(6); PG8_BAR; PG8_MMA(1, 1, At, B1); PG8_BAR;
        }
        PG8_STAMP();
        if constexpr (!Epi::AFTER_DRAIN) { E(acc, cur, wr, wc, fr, fq); S.done(cur); }
        PG8_STAMP();
        if (!has_next) break;
#pragma unroll
        for (int a = 0; a < 2; ++a)
#pragma unroll
            for (int b = 0; b < 2; ++b)
#pragma unroll
                for (int m = 0; m < 4; ++m)
#pragma unroll
                    for (int n = 0; n < 2; ++n) acc[a][b][m][n] = (f32x4){0.f, 0.f, 0.f, 0.f};
        cur = nxt; cA = nA; cB = nB; ++ui;
    }
    PG8_WAIT_V(0);
    if (wr == 0) PG8_BAR;
    PG8_BAR;
    if constexpr (Epi::AFTER_DRAIN) { E.fused(acc, cur, wr, wc, fr, fq, lds, wid, lane); S.done(cur); }
    PG8_STAMP();
    if (STAMP && wid == 0) { stamps[lane] = lane < nts ? (((unsigned long long)(unsigned)ts_hi << 32) | (unsigned)ts_lo) : 0ull;
        if (lane == 62) stamps[62] = rt_entry; if (lane == 63) stamps[63] = (unsigned long long)wall_clock64(); }
#undef PG8_STAMP
#undef PG8_SA
#undef PG8_SB
#undef PG8_STAGE
#undef PG8_LDA
#undef PG8_LDB
#undef PG8_MMA
#undef PG8_WAIT_V
#undef PG8_WAIT_L
#undef PG8_BAR
#undef PG8_SCHED
}
}
using namespace pg8;
namespace cg = cooperative_groups;
#define LAS PG8_LAS
#define DI __device__ __forceinline__

constexpr int T_ = 8192, D_ = 2048, INW = 15376, NP1 = 15616, DFF = 8192;
constexpr int LDS_BYTES = 147456;
constexpr int NTHR = 512;
constexpr float EPS = 1e-6f;

constexpr size_t SZ_WT_IN = (size_t)NP1 * 2048 * 2, SZ_WT_BR = (size_t)2048 * 1024 * 2, SZ_WT_O = (size_t)2048 * 2048 * 2, SZ_WT_M = (size_t)8192 * 2048 * 2;
constexpr size_t SZ_WL = SZ_WT_IN + 3 * SZ_WT_BR + SZ_WT_O + 2 * SZ_WT_M;
constexpr size_t WS_W = 0;
constexpr size_t WS_MOD = WS_W + 2 * SZ_WL;
constexpr size_t WS_XC = WS_MOD + 2 * 12288 * 4;
constexpr size_t WS_H = WS_XC + (size_t)T_ * D_ * 4;
constexpr size_t WS_PROJ = WS_H + (size_t)T_ * D_ * 2;
constexpr size_t WS_BA = WS_PROJ + (size_t)T_ * 15360 * 2;
constexpr size_t WS_R2 = WS_BA + (size_t)T_ * 16 * 4;
constexpr size_t G_A = WS_R2;
constexpr size_t G_BT = G_A + (size_t)T_ * 2048 * 2;
constexpr size_t G_C = G_BT + (size_t)T_ * 2048 * 2;
constexpr size_t G_D = G_C + (size_t)T_ * 1024 * 2;
constexpr size_t G_GL = G_D + (size_t)T_ * 1024 * 2;
constexpr size_t R_SC = G_GL + 4096;
constexpr size_t R_QI = R_SC + (size_t)T_ * 256 * 2;
constexpr size_t R_VT = R_QI + (size_t)T_ * 512 * 2;
constexpr size_t WS_R3 = R_VT + (size_t)T_ * 1024 * 2;
constexpr size_t WS_OA = WS_R3;
constexpr size_t WS_OB = WS_OA + (size_t)T_ * 1024 * 4;
constexpr size_t WS_CV = WS_OB + (size_t)T_ * 1024 * 4;
constexpr size_t WS_ACT = WS_CV + (size_t)T_ * 1024 * 4;
constexpr size_t WS_MB = WS_ACT + 3 * (size_t)T_ * 1024 * 2;
constexpr size_t WS_BAR = WS_MB + (size_t)T_ * D_ * 2;
constexpr size_t WS_PROG = WS_BAR + 16384;
constexpr size_t WS_END = WS_PROG + 16384;
constexpr size_t R_P = WS_OA;
constexpr size_t G_S = WS_H;
constexpr size_t R_RT = WS_MB;
constexpr size_t WS_MF = WS_R2;
static_assert(WS_MF + (size_t)T_ * D_ * 4 <= WS_R3, "merged f32 alias");

struct Params {
    const float* x; const float* c; const int* pos; const float* w_ada; const float* b_ada; const float* norm_mix_w; const float* norm_mlp_w; const float* w_in;
    const float* conv_qkv_w; const float* a_log; const float* dt_bias; const float* gdn_norm_w; const float* conv_dw_w; const float* conv_dw_b; const float* conv_ln_w; const float* conv_ln_b;
    const float* w_a; const float* w_b; const float* w_c; const float* w_out; const float* w_mi; const float* w_mo; const float* final_w;
    float* out; unsigned char* ws; int ph_lo, ph_hi;
};

DI unsigned pk2(float lo, float hi) { return cvt_pk_bf16(lo, hi); }
DI bf16_t f2bf(float f) { return (bf16_t)(cvt_pk_bf16(f, 0.f) & 0xffffu); }
DI float siluf_(float x) { return x / (1.0f + __expf(-x)); }
DI float ret_lg2(int hr) { return hr == 0 ? -0.04580368961312479f : hr == 1 ? -0.02272007650008353f : hr == 2 ? -0.011315313227834146f : -0.005646563141142063f; }
DI float wave_sum(float v) {
#pragma unroll
    for (int o = 1; o < 64; o <<= 1) v += __shfl_xor(v, o);
    return v;
}
DI void lds_barrier() { asm volatile("s_waitcnt lgkmcnt(0)" ::: "memory"); __builtin_amdgcn_s_barrier(); asm volatile("" ::: "memory"); }
DI void full_barrier() { asm volatile("s_waitcnt vmcnt(0) lgkmcnt(0)" ::: "memory"); __builtin_amdgcn_s_barrier(); asm volatile("" ::: "memory"); }
DI f32x4 mfma16(bf16x8 a, bf16x8 b, f32x4 c) { return __builtin_amdgcn_mfma_f32_16x16x32_bf16(a, b, c, 0, 0, 0); }
DI bf16x8 lds_frag(LAS unsigned char* base, int row, int stride_el, int k0) { return *(const LAS bf16x8*)(base + ((size_t)row * stride_el + k0) * 2); }
DI void unpack8(const u32x4 w, float (&f)[8]) { f[0] = bf_lo(w.x); f[1] = bf_hi(w.x); f[2] = bf_lo(w.y); f[3] = bf_hi(w.y); f[4] = bf_lo(w.z); f[5] = bf_hi(w.z); f[6] = bf_lo(w.w); f[7] = bf_hi(w.w); }
DI u32x4 pack8(const float* f) { u32x4 w; w.x = pk2(f[0], f[1]); w.y = pk2(f[2], f[3]); w.z = pk2(f[4], f[5]); w.w = pk2(f[6], f[7]); return w; }

#define XB_TMO      128
#define XB_XCNT(j)  (256  + 64 * (j))
#define XB_XSUB(j)  (1280 + 64 * (j))
#define XB_XGEN(j)  (2304 + 64 * (j))
#define XB_TOP      3328
#define XB_TOPGEN   3392
#define XCD_BAR_WORDS 3456
#define XB_SPIN_CAP (1u << 18)


__device__ __forceinline__ unsigned xb_ld(unsigned* p)              { return __hip_atomic_load(p, __ATOMIC_RELAXED, __HIP_MEMORY_SCOPE_AGENT); }
__device__ __forceinline__ unsigned xb_add(unsigned* p, unsigned v) { return __hip_atomic_fetch_add(p, v, __ATOMIC_RELAXED, __HIP_MEMORY_SCOPE_AGENT); }
__device__ __forceinline__ unsigned xb_xcc_id() { return (unsigned)__builtin_amdgcn_s_getreg((3 << 11) | 20) & 0xFu; }
#define XB_SPIN(cond, bar) do { unsigned _sp = 0; while (cond) { __builtin_amdgcn_s_sleep(1); \
    if ((++_sp & 255u) == 0u) { if (xb_ld(&(bar)[XB_TMO])) break; if (_sp > XB_SPIN_CAP) { atomicAdd(&(bar)[XB_TMO], 1u); break; } } } } while (0)

struct XcdBarrier {
    unsigned* bar; unsigned x;
    volatile LAS unsigned* st;
};

__device__ __forceinline__ XcdBarrier xcd_barrier_post(unsigned* bar, volatile LAS unsigned* st) {
    XcdBarrier b; b.bar = bar; b.x = xb_xcc_id(); b.st = st;
    if (threadIdx.x == 0) (void)xb_add(&bar[XB_XCNT(b.x)], 1u);
    return b;
}
__device__ __forceinline__ void xcd_barrier_complete(unsigned* bar, unsigned x, unsigned& nloc, unsigned& nx) {
    const unsigned G = gridDim.x * gridDim.y * gridDim.z;
    unsigned sum, cnt, mine, sp = 0u;
    for (;;) {
        sum = 0u; cnt = 0u; mine = 0u;
#pragma unroll
        for (unsigned j = 0; j < 16; ++j) { const unsigned c = xb_ld(&bar[XB_XCNT(j)]); sum += c; cnt += (c > 0u) ? 1u : 0u; mine = (j == x) ? c : mine; }
        if (sum == G) break;
        __builtin_amdgcn_s_sleep(1);
        if ((++sp & 255u) == 0u) { if (xb_ld(&bar[XB_TMO])) break; if (sp > XB_SPIN_CAP) { atomicAdd(&bar[XB_TMO], 1u); break; } }
    }
    nloc = mine > 0u ? mine : 1u; nx = cnt > 0u ? cnt : 1u;
}

__device__ __forceinline__ void xcd_barrier(const XcdBarrier& b) {
    asm volatile("s_waitcnt vmcnt(0)" ::: "memory");
    __syncthreads();
    if (threadIdx.x == 0) {
        unsigned* bar = b.bar;
        __builtin_amdgcn_s_waitcnt(0);
        unsigned nloc = b.st[0], nx = b.st[1];
        if (nloc == 0u) { xcd_barrier_complete(bar, b.x, nloc, nx); b.st[0] = nloc; b.st[1] = nx; }
        const unsigned old = xb_add(&bar[XB_XSUB(b.x)], 1u);
        const unsigned gen = old / nloc;
        if (old + 1u == (gen + 1u) * nloc) {
            __builtin_amdgcn_fence(__ATOMIC_RELEASE, "agent");
            asm volatile("s_waitcnt vmcnt(0)" ::: "memory");
            const unsigned og = xb_add(&bar[XB_TOP], 1u);
            const unsigned tg = og / nx;
            if (og + 1u == (tg + 1u) * nx) xb_add(&bar[XB_TOPGEN], 1u);
            else XB_SPIN(xb_ld(&bar[XB_TOPGEN]) == tg, bar);
            __builtin_amdgcn_fence(__ATOMIC_ACQUIRE, "agent");
            xb_add(&bar[XB_XGEN(b.x)], 1u);
            asm volatile("s_waitcnt vmcnt(0)" ::: "memory");
        } else {
            XB_SPIN(xb_ld(&bar[XB_XGEN(b.x)]) == gen, bar);
            __builtin_amdgcn_fence(__ATOMIC_ACQUIRE, "agent");
            asm volatile("s_waitcnt vmcnt(0)" ::: "memory");
        }
    }
    __syncthreads();
}


DI void transpose_item(const float* W, int ldw, int K, int src_col0, int valid, bf16_t* WT, int dst_row0, int k0, LAS float* scr, int lane) {
    const int nn = lane & 31;
    float tv[64];
#pragma unroll
    for (int i = 0; i < 64; ++i) { const int kk = 2 * i + (lane >> 5);
        tv[i] = 0.f; if (nn < valid) tv[i] = W[(size_t)(k0 + kk) * ldw + src_col0 + nn]; }
#pragma unroll
    for (int i = 0; i < 64; ++i) { const int kk = 2 * i + (lane >> 5); scr[kk * 33 + nn] = tv[i]; }
    asm volatile("s_waitcnt lgkmcnt(0)" ::: "memory");
    const int c = lane & 15;
#pragma unroll
    for (int j = 0; j < 8; ++j) { const int n = (lane >> 4) + 4 * j; const LAS float* s = scr + (8 * c) * 33 + n;
        u32x4 o; o.x = pk2(s[0 * 33], s[1 * 33]); o.y = pk2(s[2 * 33], s[3 * 33]); o.z = pk2(s[4 * 33], s[5 * 33]); o.w = pk2(s[6 * 33], s[7 * 33]);
        *(u32x4*)(WT + (size_t)(dst_row0 + n) * K + k0 + 8 * c) = o; }
    asm volatile("s_waitcnt lgkmcnt(0)" ::: "memory");
}

DI void phase_prep(const Params& p, unsigned char* wsp, LAS unsigned char* lds, int tid) {
    const int lane = tid & 63, wave = tid >> 6, G = gridDim.x, b = blockIdx.x;
    float* mod = (float*)(wsp + WS_MOD);
    for (int u = b; u < 192; u += G) {
        const int l = u / 96, strip = u % 96, kg = tid >> 5, cl = tid & 31, col = 128 * strip + 4 * cl;
        f32x4 acc = {0.f, 0.f, 0.f, 0.f};
        const float* wp = p.w_ada + (size_t)l * 2048 * 12288 + col;
#pragma unroll 16
        for (int k = kg; k < 2048; k += 16) { const float s = siluf_(p.c[k]); const f32x4 w = *(const f32x4*)(wp + (size_t)k * 12288); acc += s * w; }
        LAS f32x4* red = (LAS f32x4*)lds;
        red[kg * 32 + cl] = acc;
        lds_barrier();
        if (tid < 128) { float s = 0.f; const LAS float* rf = (const LAS float*)lds;
#pragma unroll
            for (int g = 0; g < 16; ++g) s += rf[g * 128 + tid];
            mod[l * 12288 + 128 * strip + tid] = s + p.b_ada[l * 12288 + 128 * strip + tid]; }
        lds_barrier();
    }
    LAS float* scr = (LAS float*)(lds + wave * 17408);
    const int gw = b * 8 + wave, NGW = G * 8;
    constexpr int I_IN = 488 * 16, I_BR = 64 * 8, I_O = 64 * 16, I_MI = 256 * 16, I_MO = 64 * 64, I_L = I_IN + 3 * I_BR + I_O + I_MI + I_MO;
    for (int it = gw; it < 2 * I_L; it += NGW) {
        const int l = it / I_L; int r = it % I_L;
        unsigned char* wl = wsp + WS_W + (size_t)l * SZ_WL;
        if (r < I_IN) { const int kb = r / 488, nb = r % 488, d0 = 32 * nb; int src, valid;
            if (d0 < 4096) { src = d0; valid = 32; } else if (d0 < 15360) { src = d0 + 16; valid = 32; } else if (d0 == 15360) { src = 4096; valid = 16; } else { src = 0; valid = 0; }
            transpose_item(p.w_in + (size_t)l * 2048 * INW, INW, 2048, src, valid, (bf16_t*)wl, d0, 128 * kb, scr, lane); continue; }
        r -= I_IN;
        if (r < 3 * I_BR) { const int which = r / I_BR, q = r % I_BR, kb = q / 64, nb = q % 64;
            const float* W = (which == 0 ? p.w_a : which == 1 ? p.w_b : p.w_c) + (size_t)l * 1024 * 2048;
            transpose_item(W, 2048, 1024, 32 * nb, 32, (bf16_t*)(wl + SZ_WT_IN + which * SZ_WT_BR), 32 * nb, 128 * kb, scr, lane); continue; }
        r -= 3 * I_BR;
        if (r < I_O) { const int kb = r / 64, nb = r % 64;
            transpose_item(p.w_out + (size_t)l * 2048 * 2048, 2048, 2048, 32 * nb, 32, (bf16_t*)(wl + SZ_WT_IN + 3 * SZ_WT_BR), 32 * nb, 128 * kb, scr, lane); continue; }
        r -= I_O;
        if (r < I_MI) { const int kb = r / 256, nb = r % 256;
            transpose_item(p.w_mi + (size_t)l * 2048 * 8192, 8192, 2048, 32 * nb, 32, (bf16_t*)(wl + SZ_WT_IN + 3 * SZ_WT_BR + SZ_WT_O), 32 * nb, 128 * kb, scr, lane); continue; }
        r -= I_MI;
        { const int kb = r / 64, nb = r % 64;
            transpose_item(p.w_mo + (size_t)l * 8192 * 2048, 2048, 8192, 32 * nb, 32, (bf16_t*)(wl + SZ_WT_IN + 3 * SZ_WT_BR + SZ_WT_O + SZ_WT_M), 32 * nb, 128 * kb, scr, lane); }
    }
}

DI void phase_norm(const float* xin, const float* nw, const float* scale, const float* shift, bf16_t* H, float* outf, int tid) {
    const int lane = tid & 63, wave = tid >> 6, gw = blockIdx.x * 8 + wave, NGW = gridDim.x * 8;
    for (int row0 = gw; row0 < T_; row0 += 2 * NGW) {
        const int row1 = (row0 + NGW < T_) ? row0 + NGW : row0;
        f32x4 v[2][8]; float ss[2] = {0.f, 0.f};
#pragma unroll
        for (int r = 0; r < 2; ++r) { const float* xr = xin + (size_t)(r ? row1 : row0) * D_;
#pragma unroll
            for (int j = 0; j < 8; ++j) v[r][j] = *(const f32x4*)(xr + (j * 64 + lane) * 4); }
#pragma unroll
        for (int r = 0; r < 2; ++r) {
#pragma unroll
            for (int j = 0; j < 8; ++j) ss[r] += (v[r][j][0] * v[r][j][0] + v[r][j][1] * v[r][j][1]) + (v[r][j][2] * v[r][j][2] + v[r][j][3] * v[r][j][3]);
            ss[r] = wave_sum(ss[r]); }
#pragma unroll
        for (int r = 0; r < 2; ++r) { const int row = r ? row1 : row0; if (r == 1 && row1 == row0) break;
            const float rstd = 1.0f / sqrtf(ss[r] * (1.0f / D_) + EPS);
#pragma unroll
            for (int j = 0; j < 8; ++j) { const int c = (j * 64 + lane) * 4; const f32x4 w = *(const f32x4*)(nw + c);
                f32x4 y = v[r][j] * rstd * w;
                if (H) { const f32x4 sc = *(const f32x4*)(scale + c), sh = *(const f32x4*)(shift + c); y = y * (1.0f + sc) + sh;
                    u32x2 o; o.x = pk2(y[0], y[1]); o.y = pk2(y[2], y[3]); *(u32x2*)(H + (size_t)row * D_ + c) = o; }
                else *(f32x4*)(outf + (size_t)row * D_ + c) = y; } }
    }
}

DI void gdn_prep_unit(const Params& p, unsigned char* wsp, int l, int hh, int n, LAS unsigned char* lds, int tid) {
    asm volatile("" : "+v"(tid));
    const int lane = tid & 63, wave = tid >> 6, quad = lane >> 4, l15 = lane & 15;
    const int r = tid >> 3, cgp = tid & 7, t = 64 * n + r;
    constexpr int K_OFF = 0, KB_OFF = 17408, Q_OFF = 34816, VBT_OFF = 52224, KBGT_OFF = 70656, KDT_OFF = 89088, T_OFF = 107520, L_OFF = 116736, SG_OFF = 134144, SB_OFF = SG_OFF + 256, GC_OFF = SB_OFF + 256;
    constexpr int ATTI_OFF = 135168, WT_OFF = K_OFF, UT_OFF = KB_OFF;
    static_assert(ATTI_OFF + 9216 <= LDS_BYTES - 16, "lds");
    const bf16_t* PROJ = (const bf16_t*)(wsp + WS_PROJ); const float* BA = (const float*)(wsp + WS_BA);
    const size_t ub = (size_t)hh * 128 + n;
    u32x4 pa[3][4][2];
#pragma unroll
    for (int X = 0; X < 3; ++X) { const int ch = X * 1024 + hh * 128 + 16 * cgp;
#pragma unroll
        for (int j = 0; j < 4; ++j) { const int tt = t - 3 + j; pa[X][j][0] = (u32x4){0u, 0u, 0u, 0u}; pa[X][j][1] = (u32x4){0u, 0u, 0u, 0u};
            if (tt >= 0) { pa[X][j][0] = *(const u32x4*)(PROJ + (size_t)tt * PROJ_LD + ch); pa[X][j][1] = *(const u32x4*)(PROJ + (size_t)tt * PROJ_LD + ch + 8); } } }
    float ba_b = 0.f, ba_a = 0.f;
    if (cgp == 0) { ba_b = BA[(size_t)t * 16 + hh]; ba_a = BA[(size_t)t * 16 + 8 + hh]; }
    {   LAS float* CW = (LAS float*)lds;
#pragma unroll
        for (int i = 0; i < 3; ++i) { const int f = tid + 512 * i, X = f >> 9, j = (f >> 7) & 3, c = f & 127;
            CW[f] = p.conv_qkv_w[((size_t)l * 4 + j) * 3072 + X * 1024 + hh * 128 + c]; } }
    lds_barrier();
    float val[3][16];
#pragma unroll
    for (int X = 0; X < 3; ++X) {
#pragma unroll
        for (int i = 0; i < 16; ++i) val[X][i] = 0.f;
#pragma unroll
        for (int j = 0; j < 4; ++j) { float xa[8], xb[8]; unpack8(pa[X][j][0], xa); unpack8(pa[X][j][1], xb);
            const LAS float* cw = (const LAS float*)lds + X * 512 + j * 128 + 16 * cgp;
#pragma unroll
            for (int q4 = 0; q4 < 4; ++q4) { const f32x4 w = *(const LAS f32x4*)(cw + 4 * q4);
#pragma unroll
                for (int e = 0; e < 4; ++e) { const int i = 4 * q4 + e; val[X][i] += w[e] * (i < 8 ? xa[i] : xb[i - 8]); } } }
#pragma unroll
        for (int i = 0; i < 16; ++i) val[X][i] = siluf_(val[X][i]);
    }
    {   float sq = 0.f, sk = 0.f;
#pragma unroll
        for (int i = 0; i < 16; ++i) { sq += val[0][i] * val[0][i]; sk += val[1][i] * val[1][i]; }
        sq += __shfl_xor(sq, 1); sq += __shfl_xor(sq, 2); sq += __shfl_xor(sq, 4);
        sk += __shfl_xor(sk, 1); sk += __shfl_xor(sk, 2); sk += __shfl_xor(sk, 4);
        const float rq = (1.0f / sqrtf(sq + 1e-6f)) * 0.08838834764831845f, rk = 1.0f / sqrtf(sk + 1e-6f);
#pragma unroll
        for (int i = 0; i < 16; ++i) { val[0][i] *= rq; val[1][i] *= rk; }
    }
    LAS float* SG = (LAS float*)(lds + SG_OFF); LAS float* SB = (LAS float*)(lds + SB_OFF); LAS float* GC = (LAS float*)(lds + GC_OFF);
    if (cgp == 0) { const float ab = ba_b, aa = ba_a;
        const float xx = aa + p.dt_bias[l * 8 + hh]; const float sp = xx > 20.f ? xx : __logf(1.0f + __expf(xx));
        SG[r] = -expf(p.a_log[l * 8 + hh]) * sp; SB[r] = 1.0f / (1.0f + expf(-ab)); }
    lds_barrier();
    if (wave == 0) { float xg = SG[lane];
#pragma unroll
        for (int o = 1; o < 64; o <<= 1) { const float y = __shfl_up(xg, o); if (lane >= o) xg += y; }
        GC[lane] = xg; }
    lds_barrier();
    {   const float bta = SB[r], gcr = GC[r], glast = GC[63], eg = expf(gcr), ekd = expf(glast - gcr);
        float tq[16], tk[16], tkb[16];
#pragma unroll
        for (int i = 0; i < 16; ++i) { tq[i] = val[0][i]; tk[i] = val[1][i]; tkb[i] = val[1][i] * bta; }
        *(LAS u32x4*)(lds + K_OFF + (r * 136 + 16 * cgp) * 2) = pack8(tk); *(LAS u32x4*)(lds + K_OFF + (r * 136 + 16 * cgp + 8) * 2) = pack8(tk + 8);
        *(LAS u32x4*)(lds + KB_OFF + (r * 136 + 16 * cgp) * 2) = pack8(tkb); *(LAS u32x4*)(lds + KB_OFF + (r * 136 + 16 * cgp + 8) * 2) = pack8(tkb + 8);
        *(LAS u32x4*)(lds + Q_OFF + (r * 136 + 16 * cgp) * 2) = pack8(tq); *(LAS u32x4*)(lds + Q_OFF + (r * 136 + 16 * cgp + 8) * 2) = pack8(tq + 8);
#pragma unroll
        for (int i = 0; i < 16; ++i) { const int e = 16 * cgp + i;
            const int rs = (((r >> 3) ^ cgp) << 3) + (r & 7);
            *(LAS bf16_t*)(lds + VBT_OFF + (e * 72 + rs) * 2) = f2bf(val[2][i] * bta);
            *(LAS bf16_t*)(lds + KBGT_OFF + (e * 72 + rs) * 2) = f2bf(tkb[i] * eg);
            *(LAS bf16_t*)(lds + KDT_OFF + (e * 72 + rs) * 2) = f2bf(tk[i] * ekd); }
        if (tid == 0) ((float*)(wsp + G_GL))[ub] = expf(glast);
    }
    lds_barrier();
    LAS float* Lm = (LAS float*)(lds + L_OFF);
#pragma unroll
    for (int tt = 0; tt < 2; ++tt) { const int id = 2 * wave + tt, mi = id >> 2, ni = id & 3;
        f32x4 aK = {0.f, 0.f, 0.f, 0.f}, aA = {0.f, 0.f, 0.f, 0.f};
#pragma unroll
        for (int ks = 0; ks < 4; ++ks) { const bf16x8 kf = lds_frag(lds + K_OFF, 16 * ni + l15, 136, 32 * ks + 8 * quad);
            const bf16x8 kbf = lds_frag(lds + KB_OFF, 16 * mi + l15, 136, 32 * ks + 8 * quad), qf = lds_frag(lds + Q_OFF, 16 * mi + l15, 136, 32 * ks + 8 * quad);
            aK = mfma16(kbf, kf, aK);
            aA = mfma16(kf, qf, aA); }
        { const int s = 16 * ni + l15; const float gs = GC[s];
#pragma unroll
            for (int j = 0; j < 4; ++j) { const int c = 16 * mi + 4 * quad + j; Lm[c * 68 + s] = (c > s) ? aK[j] * expf(GC[c] - gs) : 0.f; } }
        { const int c = 16 * mi + l15; const float gcc = GC[c]; float o[4];
#pragma unroll
            for (int j = 0; j < 4; ++j) { const int s = 16 * ni + 4 * quad + j; o[j] = (c >= s) ? aA[j] * expf(gcc - GC[s]) : 0.f; }
            u32x2 w; w.x = pk2(o[0], o[1]); w.y = pk2(o[2], o[3]);
            *(LAS u32x2*)(lds + ATTI_OFF + (c * 72 + 16 * ni + 4 * quad) * 2) = w; }
    }
    lds_barrier();
    if (wave == 0) {
        float Tc[64];
        int zoff; asm volatile("v_mov_b32 %0, 0" : "=v"(zoff));
        const LAS float* Lz = Lm + zoff;
#pragma unroll
        for (int i = 0; i < 64; ++i) { float a = (lane == i) ? 1.f : 0.f;
#pragma unroll
            for (int j4 = 0; j4 < (i + 3) / 4; ++j4) { const f32x4 lv = *(const LAS f32x4*)(Lz + i * 68 + 4 * j4);
#pragma unroll
                for (int jj = 0; jj < 4; ++jj) if (4 * j4 + jj < i) a -= lv[jj] * Tc[4 * j4 + jj]; }
            Tc[i] = a; if ((i & 3) == 3) asm volatile("" ::: "memory"); }
#pragma unroll
        for (int i = 0; i < 64; ++i) *(LAS bf16_t*)(lds + T_OFF + (i * 72 + lane) * 2) = f2bf(Tc[i]);
    }
    lds_barrier();
    {   bf16x8 vf[2], gf[2];
#pragma unroll
        for (int ks = 0; ks < 2; ++ks) { vf[ks] = lds_frag(lds + VBT_OFF, 16 * wave + l15, 72, 8 * ((4 * ks + quad) ^ wave)); gf[ks] = lds_frag(lds + KBGT_OFF, 16 * wave + l15, 72, 8 * ((4 * ks + quad) ^ wave)); }
#pragma unroll
        for (int mi = 0; mi < 4; ++mi) { f32x4 aU = {0.f, 0.f, 0.f, 0.f}, aW = {0.f, 0.f, 0.f, 0.f};
#pragma unroll
            for (int ks = 0; ks < 2; ++ks) { const bf16x8 tf = lds_frag(lds + T_OFF, 16 * mi + l15, 72, 32 * ks + 8 * quad);
                aU = mfma16(tf, vf[ks], aU); aW = mfma16(tf, gf[ks], aW); }
            u32x2 wu; wu.x = pk2(aU[0], aU[1]); wu.y = pk2(aU[2], aU[3]);
            u32x2 ww; ww.x = pk2(aW[0], aW[1]); ww.y = pk2(aW[2], aW[3]);
            *(LAS u32x2*)(lds + UT_OFF + ((16 * wave + l15) * 64 + 16 * mi + 4 * quad) * 2) = wu;
            *(LAS u32x2*)(lds + WT_OFF + ((16 * wave + l15) * 64 + 16 * mi + 4 * quad) * 2) = ww; }
    }
    lds_barrier();
    {   bf16x8 kdf[2], wtf[2], utf[2];
#pragma unroll
        for (int ks = 0; ks < 2; ++ks) { kdf[ks] = lds_frag(lds + KDT_OFF, 16 * wave + l15, 72, 8 * ((4 * ks + quad) ^ wave));
            wtf[ks] = lds_frag(lds + WT_OFF, 16 * wave + l15, 64, 32 * ks + 8 * quad); utf[ks] = lds_frag(lds + UT_OFF, 16 * wave + l15, 64, 32 * ks + 8 * quad); }
        bf16_t* GA = (bf16_t*)(wsp + G_A) + ub * 16384; bf16_t* GB = (bf16_t*)(wsp + G_BT) + ub * 16384;
        bf16_t* GCp = (bf16_t*)(wsp + G_C) + ub * 8192; bf16_t* GD = (bf16_t*)(wsp + G_D) + ub * 8192;
#pragma unroll
        for (int t2 = 0; t2 < 8; ++t2) {
            f32x4 aA = {0.f, 0.f, 0.f, 0.f}, aB = {0.f, 0.f, 0.f, 0.f};
#pragma unroll
            for (int ks = 0; ks < 2; ++ks) { const bf16x8 wx = lds_frag(lds + WT_OFF, 16 * t2 + l15, 64, 32 * ks + 8 * quad), kx = lds_frag(lds + KDT_OFF, 16 * t2 + l15, 72, 8 * ((4 * ks + quad) ^ t2));
                aA = mfma16(wx, kdf[ks], aA);
                aB = mfma16(kx, utf[ks], aB); }
            u32x2 wa; wa.x = pk2(-aA[0], -aA[1]); wa.y = pk2(-aA[2], -aA[3]);
            *(u32x2*)(GA + ((wave * 4 + (t2 >> 1)) * 64 + (2 * (t2 & 1) + (quad >> 1)) * 16 + l15) * 8 + 4 * (quad & 1)) = wa;
            u32x2 wb; wb.x = pk2(aB[0], aB[1]); wb.y = pk2(aB[2], aB[3]);
            *(u32x2*)(GB + ((((wave >> 1) * 8 + t2) * 64 + quad * 16 + l15) * 2 + (wave & 1)) * 4) = wb; }
#pragma unroll
        for (int mi = 0; mi < 4; ++mi) {
            f32x4 aC = {0.f, 0.f, 0.f, 0.f}, aD = {0.f, 0.f, 0.f, 0.f};
#pragma unroll
            for (int ks = 0; ks < 2; ++ks) { const bf16x8 af = lds_frag(lds + ATTI_OFF, 16 * mi + l15, 72, 32 * ks + 8 * quad);
                aC = mfma16(wtf[ks], af, aC);
                aD = mfma16(utf[ks], af, aD); }
            const int c = 16 * mi + l15; const float egc = expf(GC[c]);
            const u32x2 qw = *(const LAS u32x2*)(lds + Q_OFF + (c * 136 + 16 * wave + 4 * quad) * 2);
            u32x2 wc; wc.x = pk2(bf_lo(qw.x) * egc - aC[0], bf_hi(qw.x) * egc - aC[1]); wc.y = pk2(bf_lo(qw.y) * egc - aC[2], bf_hi(qw.y) * egc - aC[3]);
            *(u32x2*)(GCp + ((mi * 4 + (wave >> 1)) * 64 + (2 * (wave & 1) + (quad >> 1)) * 16 + l15) * 8 + 4 * (quad & 1)) = wc;
            u32x2 wd; wd.x = pk2(aD[0], aD[1]); wd.y = pk2(aD[2], aD[3]);
            *(u32x2*)(GD + ((wave * 4 + mi) * 64 + quad * 16 + l15) * 4) = wd; }
    }
    lds_barrier();
}

DI void ret_prep_unit(const Params& p, unsigned char* wsp, int hr, int n, LAS unsigned char* lds, int tid) {
    asm volatile("" : "+v"(tid));
    const int lane = tid & 63, wave = tid >> 6, quad = lane >> 4, l15 = lane & 15;
    const int r = tid >> 3, cgp = tid & 7, t = 64 * n + r;
    constexpr int RQ_OFF = 0, RK_OFF = 17408, KTT_OFF = 34816, VT_OFF = 53248;
    const bf16_t* PROJ = (const bf16_t*)(wsp + WS_PROJ);
    const size_t ub = (size_t)hr * 128 + n;
    const float lg2 = ret_lg2(hr);
    const float xi = exp2f((float)(r + 1) * lg2), zeta = exp2f((float)(63 - r) * lg2);
    const float posf = (float)p.pos[t];
    {   const bf16_t* pq = PROJ + (size_t)t * PROJ_LD + 4096 + hr * 128 + 8 * cgp; const bf16_t* pk = PROJ + (size_t)t * PROJ_LD + 4608 + hr * 128 + 8 * cgp;
        float q1[8], q2[8], k1[8], k2[8];
        unpack8(*(const u32x4*)pq, q1); unpack8(*(const u32x4*)(pq + 64), q2); unpack8(*(const u32x4*)pk, k1); unpack8(*(const u32x4*)(pk + 64), k2);
        float rq1[8], rq2[8], rk1[8], rk2[8];
#pragma unroll
        for (int ii = 0; ii < 8; ++ii) { const int i = 8 * cgp + ii;
            const float invf = expf(-(float)i * (9.210340371976184f / 64.0f)); const float ang = posf * invf; const float trev = ang * 0.15915494309189535f; const float fr = trev - rintf(trev);
            const float cs = __builtin_amdgcn_cosf(fr), sn = __builtin_amdgcn_sinf(fr);
            rq1[ii] = q1[ii] * cs - q2[ii] * sn; rq2[ii] = q1[ii] * sn + q2[ii] * cs;
            rk1[ii] = (k1[ii] * cs - k2[ii] * sn) * 0.08838834764831845f; rk2[ii] = (k1[ii] * sn + k2[ii] * cs) * 0.08838834764831845f; }
        *(LAS u32x4*)(lds + RQ_OFF + (r * 136 + 8 * cgp) * 2) = pack8(rq1); *(LAS u32x4*)(lds + RQ_OFF + (r * 136 + 64 + 8 * cgp) * 2) = pack8(rq2);
        *(LAS u32x4*)(lds + RK_OFF + (r * 136 + 8 * cgp) * 2) = pack8(rk1); *(LAS u32x4*)(lds + RK_OFF + (r * 136 + 64 + 8 * cgp) * 2) = pack8(rk2);
#pragma unroll
        for (int ii = 0; ii < 8; ++ii) { *(LAS bf16_t*)(lds + KTT_OFF + ((8 * cgp + ii) * 72 + r) * 2) = f2bf(rk1[ii] * zeta); *(LAS bf16_t*)(lds + KTT_OFF + ((64 + 8 * cgp + ii) * 72 + r) * 2) = f2bf(rk2[ii] * zeta);
            rq1[ii] *= xi; rq2[ii] *= xi; }
        bf16_t* QI = (bf16_t*)(wsp + R_QI) + ub * 8192 + (size_t)((((r >> 4) * 4 + (cgp >> 2)) * 64 + (cgp & 3) * 16 + (r & 15)) * 8);
        *(u32x4*)QI = pack8(rq1); *(u32x4*)(QI + 2 * 512) = pack8(rq2);
    }
    {   const bf16_t* pv = PROJ + (size_t)t * PROJ_LD + 5120 + hr * 256 + 32 * cgp;
#pragma unroll
        for (int q = 0; q < 4; ++q) { float vv[8]; unpack8(*(const u32x4*)(pv + 8 * q), vv);
#pragma unroll
            for (int i = 0; i < 8; ++i) *(LAS bf16_t*)(lds + VT_OFF + ((32 * cgp + 8 * q + i) * 72 + r) * 2) = f2bf(vv[i]); }
    }
    lds_barrier();
#pragma unroll
    for (int tt = 0; tt < 2; ++tt) { const int id = 2 * wave + tt, mi = id >> 2, ni = id & 3;
        f32x4 aA = {0.f, 0.f, 0.f, 0.f};
#pragma unroll
        for (int ks = 0; ks < 4; ++ks) { const bf16x8 kf = lds_frag(lds + RK_OFF, 16 * ni + l15, 136, 32 * ks + 8 * quad), qf = lds_frag(lds + RQ_OFF, 16 * mi + l15, 136, 32 * ks + 8 * quad);
            aA = mfma16(kf, qf, aA); }
        const int c = 16 * mi + l15; float o[4];
#pragma unroll
        for (int j = 0; j < 4; ++j) { const int s = 16 * ni + 4 * quad + j; o[j] = (c >= s) ? aA[j] * exp2f((float)(c - s) * lg2) : 0.f; }
        u32x2 w; w.x = pk2(o[0], o[1]); w.y = pk2(o[2], o[3]);
        *(u32x2*)((bf16_t*)(wsp + R_SC) + ub * 4096 + ((mi * 2 + (ni >> 1)) * 64 + (2 * (ni & 1) + (quad >> 1)) * 16 + l15) * 8 + 4 * (quad & 1)) = w; }
    {
        bf16x8 kf[2];
#pragma unroll
        for (int ks = 0; ks < 2; ++ks) kf[ks] = lds_frag(lds + KTT_OFF, 16 * wave + l15, 72, 32 * ks + 8 * quad);
        float* PT = (float*)(wsp + R_P) + ub * 32768;
#pragma unroll 4
        for (int et = 0; et < 16; ++et) { f32x4 a = {0.f, 0.f, 0.f, 0.f};
#pragma unroll
            for (int ks = 0; ks < 2; ++ks) a = mfma16(kf[ks], lds_frag(lds + VT_OFF, 16 * et + l15, 72, 32 * ks + 8 * quad), a);
            *(f32x4*)(PT + ((et * 4 + (wave >> 1)) * 64 + (2 * (wave & 1) + (quad >> 1)) * 16 + l15) * 8 + 4 * (quad & 1)) = a; }
    }
#pragma unroll
    for (int i = 0; i < 4; ++i) { const int id = tid + 512 * i, blk = id >> 6, row = 16 * (blk >> 1) + (id & 15), chn = 4 * (blk & 1) + ((id >> 4) & 3);
        *(u32x4*)((bf16_t*)(wsp + R_VT) + ub * 16384 + (size_t)id * 8) = *(const LAS u32x4*)(lds + VT_OFF + (row * 72 + 8 * chn) * 2); }
    lds_barrier();
}

struct SFrag { bf16x8 af[4]; u32x2 bt[2]; };
DI void sfrag_load(SFrag& f, const unsigned char* ws, int hh, int es, int n, int wave, int quad, int l15) {
    const size_t ub = (size_t)hh * 128 + n;
    const int lane = quad * 16 + l15;
    const bf16_t* Ap = (const bf16_t*)(ws + G_A) + ub * 16384 + (size_t)(wave * 4) * 512 + lane * 8;
    const bf16_t* Bp = (const bf16_t*)(ws + G_BT) + ub * 16384 + (size_t)((es * 8 + wave) * 64 + lane) * 8;
#pragma unroll
    for (int ks = 0; ks < 4; ++ks) f.af[ks] = *(const bf16x8*)(Ap + ks * 512);
    {   const u32x4 b4 = *(const u32x4*)Bp; f.bt[0] = (u32x2){b4.x, b4.y}; f.bt[1] = (u32x2){b4.z, b4.w}; }
}
DI void gdn_chain(const Params& p, unsigned char* wsp, int l, int hh, int es, LAS unsigned char* lds, int tid) {
    asm volatile("" : "+v"(tid));
    const int lane = tid & 63, wave = tid >> 6, quad = lane >> 4, l15 = lane & 15;
    constexpr int ST_BYTES = 8704;
    for (int i = tid; i < 2 * ST_BYTES / 4; i += NTHR) ((LAS unsigned*)lds)[i] = 0u;
    LAS float* GLs = (LAS float*)(lds + 2 * ST_BYTES);
    if (tid < 128) GLs[tid] = ((const float*)(wsp + G_GL))[hh * 128 + tid];
    f32x4 Sacc[2] = {{0.f, 0.f, 0.f, 0.f}, {0.f, 0.f, 0.f, 0.f}};
    bf16_t* SG = (bf16_t*)(wsp + G_S) + ((size_t)hh * 128) * 16384 + (size_t)(((2 * es + (wave >> 2)) * 4 + (wave & 3)) * 64 + lane) * 8;
    const int srd = ((16 * (wave >> 2) + l15) * 136 + 32 * (wave & 3) + 8 * quad) * 2;
    SFrag f0, f1, f2, f3, f4, f5;
#define CFENCE() asm volatile("" ::: "memory")
    sfrag_load(f0, wsp, hh, es, 0, wave, quad, l15); CFENCE(); sfrag_load(f1, wsp, hh, es, 1, wave, quad, l15); CFENCE(); sfrag_load(f2, wsp, hh, es, 2, wave, quad, l15); CFENCE();
    sfrag_load(f3, wsp, hh, es, 3, wave, quad, l15); CFENCE(); sfrag_load(f4, wsp, hh, es, 4, wave, quad, l15); CFENCE();
#undef CFENCE
    lds_barrier();
#define S_STEP(cur, n) do { \
        LAS unsigned char* sc = lds + ((n) & 1) * ST_BYTES; LAS unsigned char* sn = lds + (((n) + 1) & 1) * ST_BYTES; \
        const float glv = GLs[(n)]; \
        bf16x8 sfr[2][4]; \
        _Pragma("unroll") for (int et = 0; et < 2; ++et) _Pragma("unroll") for (int ks = 0; ks < 4; ++ks) sfr[et][ks] = lds_frag(sc, 16 * et + l15, 136, 32 * ks + 8 * quad);     \
        *(u32x4*)(SG + (size_t)(n) * 16384) = *(const LAS u32x4*)(sc + srd);                  \
        _Pragma("unroll") for (int et = 0; et < 2; ++et) { \
            f32x4 a; a[0] = Sacc[et][0] * glv + bf_lo(cur.bt[et].x); a[1] = Sacc[et][1] * glv + bf_hi(cur.bt[et].x); a[2] = Sacc[et][2] * glv + bf_lo(cur.bt[et].y); a[3] = Sacc[et][3] * glv + bf_hi(cur.bt[et].y); \
            _Pragma("unroll") for (int ks = 0; ks < 4; ++ks) a = mfma16(cur.af[ks], sfr[et][ks], a);     \
            Sacc[et] = a; \
            u32x2 w; w.x = pk2(a[0], a[1]); w.y = pk2(a[2], a[3]); \
            *(LAS u32x2*)(sn + ((16 * et + l15) * 136 + 16 * wave + 4 * quad) * 2) = w; } \
        lds_barrier(); } while (0)
#define S_LOAD(f, n) sfrag_load(f, wsp, hh, es, (n) < 128 ? (n) : 127, wave, quad, l15)
    for (int n = 0; n < 126; n += 6) {
        S_LOAD(f5, n + 5);  S_STEP(f0, n);
        S_LOAD(f0, n + 6);  S_STEP(f1, n + 1);
        S_LOAD(f1, n + 7);  S_STEP(f2, n + 2);
        S_LOAD(f2, n + 8);  S_STEP(f3, n + 3);
        S_LOAD(f3, n + 9);  S_STEP(f4, n + 4);
        S_LOAD(f4, n + 10); S_STEP(f5, n + 5);
    }
    S_STEP(f0, 126); S_STEP(f1, 127);
#undef S_STEP
#undef S_LOAD
}

DI void ret_scan(unsigned char* wsp, int sb, int tid) {
    const int idx = sb * NTHR + tid;
    const int hr = idx >> 13, off = (idx & 8191) * 4;
    const float cd = exp2f(64.0f * ret_lg2(hr));
    const float* P = (const float*)(wsp + R_P) + (size_t)hr * 128 * 32768 + off;
    bf16_t* RT = (bf16_t*)(wsp + R_RT) + (size_t)hr * 128 * 32768 + off;
    f32x4 R = {0.f, 0.f, 0.f, 0.f};
    for (int n0 = 0; n0 < 128; n0 += 16) {
        f32x4 pv[16];
#pragma unroll
        for (int i = 0; i < 16; ++i) pv[i] = *(const f32x4*)(P + (size_t)(n0 + i) * 32768);
#pragma unroll
        for (int i = 0; i < 16; ++i) { u32x2 w; w.x = pk2(R[0], R[1]); w.y = pk2(R[2], R[3]); *(u32x2*)(RT + (size_t)(n0 + i) * 32768) = w; R = R * cd + pv[i]; }
    }
}

DI void gdn_out_unit(const Params& p, unsigned char* wsp, int l, int hh, int n, LAS unsigned char* lds, int tid) {
    asm volatile("" : "+v"(tid));
    const int lane = tid & 63, wave = tid >> 6, quad = lane >> 4, l15 = lane & 15;
    const size_t ub = (size_t)hh * 128 + n;
    const bf16_t* Sp = (const bf16_t*)(wsp + G_S) + ub * 16384 + (size_t)(wave * 4) * 512 + lane * 8;
    const bf16_t* Cp = (const bf16_t*)(wsp + G_C) + ub * 8192 + lane * 8;
    const bf16_t* Dp = (const bf16_t*)(wsp + G_D) + ub * 8192 + (size_t)((wave * 4) * 64 + lane) * 4;
    bf16x8 sf[4]; f32x4 acc[4];
    const int e0 = 16 * wave + 4 * quad;
    const bf16_t* PROJ = (const bf16_t*)(wsp + WS_PROJ);
    u32x2 zwv[4];
#pragma unroll
    for (int mi = 0; mi < 4; ++mi) zwv[mi] = *(const u32x2*)(PROJ + (size_t)(64 * n + 16 * mi + l15) * PROJ_LD + 3072 + hh * 128 + e0);
    const f32x4 nw = *(const f32x4*)(p.gdn_norm_w + l * 128 + e0);
#pragma unroll
    for (int ks = 0; ks < 4; ++ks) sf[ks] = *(const bf16x8*)(Sp + ks * 512);
#pragma unroll
    for (int mi = 0; mi < 4; ++mi) { const u32x2 dw = *(const u32x2*)(Dp + mi * 256);
        f32x4 a; a[0] = bf_lo(dw.x); a[1] = bf_hi(dw.x); a[2] = bf_lo(dw.y); a[3] = bf_hi(dw.y);
#pragma unroll
        for (int ks = 0; ks < 4; ++ks) a = mfma16(sf[ks], *(const bf16x8*)(Cp + (mi * 4 + ks) * 512), a);
        acc[mi] = a; }
    LAS float* red = (LAS float*)lds;
#pragma unroll
    for (int mi = 0; mi < 4; ++mi) { float s = (acc[mi][0] * acc[mi][0] + acc[mi][1] * acc[mi][1]) + (acc[mi][2] * acc[mi][2] + acc[mi][3] * acc[mi][3]);
        s += __shfl_xor(s, 16); s += __shfl_xor(s, 32);
        if (quad == 0) red[wave * 64 + 16 * mi + l15] = s; }
    lds_barrier();
    bf16_t* ACTA = (bf16_t*)(wsp + WS_ACT);
#pragma unroll
    for (int mi = 0; mi < 4; ++mi) { const int c = 16 * mi + l15; float tot = 0.f;
#pragma unroll
        for (int w8 = 0; w8 < 8; ++w8) tot += red[w8 * 64 + c];
        const float rs = 1.0f / sqrtf(tot * (1.0f / 128.0f) + EPS);
        const size_t t = (size_t)(64 * n + c);
        const u32x2 zw = zwv[mi];
        u32x2 o; o.x = pk2(acc[mi][0] * rs * nw[0] * siluf_(bf_lo(zw.x)), acc[mi][1] * rs * nw[1] * siluf_(bf_hi(zw.x)));
        o.y = pk2(acc[mi][2] * rs * nw[2] * siluf_(bf_lo(zw.y)), acc[mi][3] * rs * nw[3] * siluf_(bf_hi(zw.y)));
        *(u32x2*)(ACTA + t * 1024 + hh * 128 + e0) = o; }
    lds_barrier();
}
DI void ret_out_unit(const Params& p, unsigned char* wsp, int hr, int n, LAS unsigned char* lds, int tid) {
    asm volatile("" : "+v"(tid));
    const int lane = tid & 63, wave = tid >> 6, quad = lane >> 4, l15 = lane & 15;
    const size_t ub = (size_t)hr * 128 + n;
    const bf16_t* Qp = (const bf16_t*)(wsp + R_QI) + ub * 8192 + lane * 8;
    const bf16_t* Sp = (const bf16_t*)(wsp + R_SC) + ub * 4096 + lane * 8;
    const bf16_t* PROJ = (const bf16_t*)(wsp + WS_PROJ);
    u32x2 bgw[2][4];
#pragma unroll
    for (int tt = 0; tt < 2; ++tt)
#pragma unroll
        for (int mi = 0; mi < 4; ++mi) bgw[tt][mi] = *(const u32x2*)(PROJ + (size_t)(64 * n + 16 * mi + l15) * PROJ_LD + 6144 + hr * 256 + 16 * (2 * wave + tt) + 4 * quad);
    f32x4 acc[2][4];
#pragma unroll
    for (int tt = 0; tt < 2; ++tt) { const int et = 2 * wave + tt;
        const bf16_t* Rp = (const bf16_t*)(wsp + R_RT) + ub * 32768 + (size_t)(et * 4) * 512 + lane * 8;
        const bf16_t* Vp = (const bf16_t*)(wsp + R_VT) + ub * 16384 + (size_t)(et * 2) * 512 + lane * 8;
        bf16x8 rf[4], vf[2];
#pragma unroll
        for (int ks = 0; ks < 4; ++ks) rf[ks] = *(const bf16x8*)(Rp + ks * 512);
#pragma unroll
        for (int ks = 0; ks < 2; ++ks) vf[ks] = *(const bf16x8*)(Vp + ks * 512);
#pragma unroll
        for (int mi = 0; mi < 4; ++mi) { f32x4 a = {0.f, 0.f, 0.f, 0.f};
#pragma unroll
            for (int ks = 0; ks < 4; ++ks) a = mfma16(rf[ks], *(const bf16x8*)(Qp + (mi * 4 + ks) * 512), a);
#pragma unroll
            for (int ks = 0; ks < 2; ++ks) a = mfma16(vf[ks], *(const bf16x8*)(Sp + (mi * 2 + ks) * 512), a);
            acc[tt][mi] = a; } }
    LAS float* red = (LAS float*)lds;
#pragma unroll
    for (int mi = 0; mi < 4; ++mi) { float s = 0.f, q = 0.f;
#pragma unroll
        for (int tt = 0; tt < 2; ++tt) { const f32x4 a = acc[tt][mi]; s += (a[0] + a[1]) + (a[2] + a[3]); q += (a[0] * a[0] + a[1] * a[1]) + (a[2] * a[2] + a[3] * a[3]); }
        s += __shfl_xor(s, 16); s += __shfl_xor(s, 32); q += __shfl_xor(q, 16); q += __shfl_xor(q, 32);
        if (quad == 0) { red[(wave * 64 + 16 * mi + l15) * 2] = s; red[(wave * 64 + 16 * mi + l15) * 2 + 1] = q; } }
    lds_barrier();
    bf16_t* ACTB = (bf16_t*)(wsp + WS_ACT) + (size_t)T_ * 1024;
#pragma unroll
    for (int mi = 0; mi < 4; ++mi) { const int c = 16 * mi + l15; float S = 0.f, Q = 0.f;
#pragma unroll
        for (int w8 = 0; w8 < 8; ++w8) { S += red[(w8 * 64 + c) * 2]; Q += red[(w8 * 64 + c) * 2 + 1]; }
        const float mu = S * (1.0f / 256.0f), var = fmaxf(Q * (1.0f / 256.0f) - mu * mu, 0.f), rs = 1.0f / sqrtf(var + 1e-5f);
#pragma unroll
        for (int tt = 0; tt < 2; ++tt) { const f32x4 a = acc[tt][mi]; const u32x2 g = bgw[tt][mi];
            u32x2 o; o.x = pk2((a[0] - mu) * rs * siluf_(bf_lo(g.x)), (a[1] - mu) * rs * siluf_(bf_hi(g.x))); o.y = pk2((a[2] - mu) * rs * siluf_(bf_lo(g.y)), (a[3] - mu) * rs * siluf_(bf_hi(g.y)));
            *(u32x2*)(ACTB + (size_t)(64 * n + c) * 1024 + hr * 256 + 16 * (2 * wave + tt) + 4 * quad) = o; } }
    lds_barrier();
}

DI void sub_barrier(unsigned* cnt, unsigned target) {
    asm volatile("s_waitcnt vmcnt(0)" ::: "memory");
    __syncthreads();
    if (threadIdx.x == 0) {
        __builtin_amdgcn_fence(__ATOMIC_RELEASE, "agent");
        asm volatile("s_waitcnt vmcnt(0)" ::: "memory");
        (void)__hip_atomic_fetch_add(cnt, 1u, __ATOMIC_RELAXED, __HIP_MEMORY_SCOPE_AGENT);
        unsigned sp = 0;
        while (__hip_atomic_load(cnt, __ATOMIC_RELAXED, __HIP_MEMORY_SCOPE_AGENT) < target) { __builtin_amdgcn_s_sleep(24); if (++sp > (1u << 20)) break; }
        __builtin_amdgcn_fence(__ATOMIC_ACQUIRE, "agent");
        asm volatile("s_waitcnt vmcnt(0)" ::: "memory");
    }
    __syncthreads();
}

DI void conv_unit(const Params& p, unsigned char* wsp, int l, int u, LAS unsigned char* lds, int tid) {
    asm volatile("" : "+v"(tid));
    const int tt = u >> 2, cs = u & 3, t0 = 64 * tt;
    const bf16_t* PROJ = (const bf16_t*)(wsp + WS_PROJ);
    LAS float* Ug = (LAS float*)lds;
    {   const int c8 = tid & 31, rg = tid >> 5;
        u32x4 ga[6], gg[6];
#pragma unroll
        for (int i = 0; i < 6; ++i) { const int rr = rg + 16 * i, t = t0 - 30 + rr; ga[i] = (u32x4){0u, 0u, 0u, 0u}; gg[i] = (u32x4){0u, 0u, 0u, 0u};
            if (rr < 94 && t >= 0) { ga[i] = *(const u32x4*)(PROJ + (size_t)t * PROJ_LD + 7168 + 256 * cs + 8 * c8); gg[i] = *(const u32x4*)(PROJ + (size_t)t * PROJ_LD + 8192 + 256 * cs + 8 * c8); } }
#pragma unroll
        for (int i = 0; i < 6; ++i) { const int rr = rg + 16 * i;
            if (rr < 94) { float a[8], g[8], o[8]; unpack8(ga[i], a); unpack8(gg[i], g);
#pragma unroll
                for (int q = 0; q < 8; ++q) o[q] = a[q] * sigmoidf_(g[q]);
                *(LAS f32x4*)(Ug + rr * 256 + 8 * c8) = (f32x4){o[0], o[1], o[2], o[3]}; *(LAS f32x4*)(Ug + rr * 256 + 8 * c8 + 4) = (f32x4){o[4], o[5], o[6], o[7]}; } }
    }
    lds_barrier();
    {   const int ch = tid & 255, half = tid >> 8, cg_ = 256 * cs + ch;
        float w[31];
#pragma unroll
        for (int j = 0; j < 31; ++j) w[j] = p.conv_dw_w[((size_t)l * 31 + j) * 1024 + cg_];
        const float bias = p.conv_dw_b[l * 1024 + cg_];
        float* CV = (float*)(wsp + WS_CV);
        for (int tl = 32 * half; tl < 32 * half + 32; ++tl) { float a = bias;
#pragma unroll
            for (int j = 0; j < 31; ++j) a += w[j] * Ug[(tl + j) * 256 + ch];
            CV[(size_t)(t0 + tl) * 1024 + cg_] = a; }
    }
    lds_barrier();
}

DI void phase_post(const Params& p, unsigned char* wsp, int l, int tid, const int mask, const int b0, const int nblk) {
    const int lane = tid & 63, wave = tid >> 6, gw = ((int)blockIdx.x - b0) * 8 + wave, NGW = nblk * 8;
    const bf16_t* PROJ = (const bf16_t*)(wsp + WS_PROJ);
    const float* OA = (const float*)(wsp + WS_OA); const float* OB = (const float*)(wsp + WS_OB); const float* CV = (const float*)(wsp + WS_CV);
    bf16_t* ACTA = (bf16_t*)(wsp + WS_ACT); bf16_t* ACTB = ACTA + (size_t)T_ * 1024; bf16_t* ACTC = ACTB + (size_t)T_ * 1024;
    for (int t = gw; t < T_; t += NGW) {
        if (mask & 1)
#pragma unroll
        for (int hh = 0; hh < 8; ++hh) { const int cc = hh * 128 + 2 * lane;
            const float o0 = OA[(size_t)t * 1024 + cc], o1 = OA[(size_t)t * 1024 + cc + 1];
            const float ss = wave_sum(o0 * o0 + o1 * o1); const float rs = 1.0f / sqrtf(ss * (1.0f / 128.0f) + EPS);
            const unsigned zw = *(const unsigned*)(PROJ + (size_t)t * PROJ_LD + 3072 + cc);
            const float w0 = p.gdn_norm_w[l * 128 + 2 * lane], w1 = p.gdn_norm_w[l * 128 + 2 * lane + 1];
            *(unsigned*)(ACTA + (size_t)t * 1024 + cc) = pk2(o0 * rs * w0 * siluf_(bf_lo(zw)), o1 * rs * w1 * siluf_(bf_hi(zw))); }
        if (mask & 2)
#pragma unroll
        for (int hr = 0; hr < 4; ++hr) { const int cc = hr * 256 + 4 * lane;
            const f32x4 o = *(const f32x4*)(OB + (size_t)t * 1024 + cc);
            const float mu = wave_sum((o[0] + o[1]) + (o[2] + o[3])) * (1.0f / 256.0f);
            const f32x4 d = o - mu; const float var = wave_sum((d[0] * d[0] + d[1] * d[1]) + (d[2] * d[2] + d[3] * d[3])) * (1.0f / 256.0f);
            const float rs = 1.0f / sqrtf(var + 1e-5f);
            const u32x2 gwd = *(const u32x2*)(PROJ + (size_t)t * PROJ_LD + 6144 + cc);
            u32x2 w; w.x = pk2(d[0] * rs * siluf_(bf_lo(gwd.x)), d[1] * rs * siluf_(bf_hi(gwd.x))); w.y = pk2(d[2] * rs * siluf_(bf_lo(gwd.y)), d[3] * rs * siluf_(bf_hi(gwd.y)));
            *(u32x2*)(ACTB + (size_t)t * 1024 + cc) = w; }
        if (mask & 4)
        {   f32x4 v[4]; float s = 0.f;
#pragma unroll
            for (int j = 0; j < 4; ++j) { v[j] = *(const f32x4*)(CV + (size_t)t * 1024 + (j * 64 + lane) * 4); s += (v[j][0] + v[j][1]) + (v[j][2] + v[j][3]); }
            const float mu = wave_sum(s) * (1.0f / 1024.0f); float q = 0.f;
#pragma unroll
            for (int j = 0; j < 4; ++j) { v[j] = v[j] - mu; q += (v[j][0] * v[j][0] + v[j][1] * v[j][1]) + (v[j][2] * v[j][2] + v[j][3] * v[j][3]); }
            const float rs = 1.0f / sqrtf(wave_sum(q) * (1.0f / 1024.0f) + 1e-5f);
#pragma unroll
            for (int j = 0; j < 4; ++j) { const int cc = (j * 64 + lane) * 4; const f32x4 lw = *(const f32x4*)(p.conv_ln_w + l * 1024 + cc), lb = *(const f32x4*)(p.conv_ln_b + l * 1024 + cc);
                const f32x4 y = v[j] * rs * lw + lb;
                u32x2 w; w.x = pk2(siluf_(y[0]), siluf_(y[1])); w.y = pk2(siluf_(y[2]), siluf_(y[3]));
                *(u32x2*)(ACTC + (size_t)t * 1024 + cc) = w; }
        }
    }
}

template <class Epi> DI void run_gemm(LAS unsigned char* lds, const bf16_t* A, const bf16_t* Bt, int N, int K, const Epi& E) {
    Gemm g{A, Bt, T_, N, K}; StaticOrder S; S.init(T_, N, (int)gridDim.x, (int)blockIdx.x);
    gemm_phase<Epi, StaticOrder, false>(lds, g, S, E, nullptr);
}

DI void run_phase(const Params& p, unsigned char* wsp, int ph, LAS unsigned char* lds, int tid) {
    const int G = gridDim.x, b = blockIdx.x;
#ifndef SUBM
#define SUBM 3
#endif
#ifndef PHM
#define PHM 0xFFF
#endif
    if (ph == 0) { if (PHM & 0x400) phase_prep(p, wsp, lds, tid); return; }
    if (ph == 21) { if (PHM & 0x800) phase_norm((const float*)(wsp + WS_XC), p.final_w, nullptr, nullptr, nullptr, p.out, tid); return; }
    const int l = (ph - 1) / 10, sp = (ph - 1) % 10;
    const float* mod = (const float*)(wsp + WS_MOD) + l * 12288;
    const float* xin = (l == 0) ? p.x : (const float*)(wsp + WS_XC);
    float* XC = (float*)(wsp + WS_XC);
    bf16_t* H = (bf16_t*)(wsp + WS_H);
    bf16_t* PROJ = (bf16_t*)(wsp + WS_PROJ);
    const unsigned char* wl = wsp + WS_W + (size_t)l * SZ_WL;
    const bf16_t* WT_IN = (const bf16_t*)wl; const bf16_t* WT_BR = (const bf16_t*)(wl + SZ_WT_IN); const bf16_t* WT_O = (const bf16_t*)(wl + SZ_WT_IN + 3 * SZ_WT_BR);
    const bf16_t* WT_MI = (const bf16_t*)(wl + SZ_WT_IN + 3 * SZ_WT_BR + SZ_WT_O); const bf16_t* WT_MO = (const bf16_t*)(wl + SZ_WT_IN + 3 * SZ_WT_BR + SZ_WT_O + SZ_WT_M);
    switch (sp) {
    case 0: if (PHM & (1<<0)) phase_norm(xin, p.norm_mix_w + l * D_, mod + 2048, mod, H, nullptr, tid); break;
    case 1: if (PHM & (1<<1)) { EpiProj E{PROJ, (float*)(wsp + WS_BA)}; run_gemm(lds, H, WT_IN, NP1, 2048, E); } break;
    case 2: if (PHM & (1<<2)) for (int u = b; u < 1024; u += G) gdn_prep_unit(p, wsp, l, u >> 7, u & 127, lds, tid); break;
    case 3: if (PHM & (1<<3)) {
        if (b < 32) { gdn_chain(p, wsp, l, b >> 2, b & 3, lds, tid); lds_barrier(); }
        else {
            const int nb = b - 32, NB = G - 32; unsigned* cnt = (unsigned*)(wsp + WS_PROG) + 1024;
            for (int u = nb; u < 512; u += NB) ret_prep_unit(p, wsp, u >> 7, u & 127, lds, tid);
            if (NB == 224) { if (nb < 64) conv_unit(p, wsp, l, nb, lds, tid);
                else for (int v = nb; v < 512; v += NB - 64) conv_unit(p, wsp, l, v, lds, tid); }
            else for (int v = nb; v < 512; v += NB) conv_unit(p, wsp, l, v, lds, tid);
            sub_barrier(cnt, (unsigned)(NB * (l + 1)));
            if (nb < 64) ret_scan(wsp, nb, tid);
        }
    } break;
    case 4: if (PHM & (1<<4)) {
        for (int u = b; u < 1536; u += G) { if (u < 1024) gdn_out_unit(p, wsp, l, u >> 7, u & 127, lds, tid); else ret_out_unit(p, wsp, (u - 1024) >> 7, (u - 1024) & 127, lds, tid); }
        phase_post(p, wsp, l, tid, 4, 0, G);
    } break;
    case 5: if (PHM & (1<<5)) { const bf16_t* ACT = (const bf16_t*)(wsp + WS_ACT); float* MF = (float*)(wsp + WS_MF); bf16_t* MB = (bf16_t*)(wsp + WS_MB);
        { EpiBranch<0> E{PROJ, MF, MB}; run_gemm(lds, ACT, WT_BR, 2048, 1024, E); }
        { EpiBranch<1> E{PROJ, MF, MB}; run_gemm(lds, ACT + (size_t)T_ * 1024, WT_BR + (size_t)2048 * 1024, 2048, 1024, E); }
        { EpiBranch<2> E{PROJ, MF, MB}; run_gemm(lds, ACT + 2 * (size_t)T_ * 1024, WT_BR + 2 * (size_t)2048 * 1024, 2048, 1024, E); }
    } break;
    case 6: if (PHM & (1<<6)) { EpiResid E{xin, XC, mod + 4096}; run_gemm(lds, (const bf16_t*)(wsp + WS_MB), WT_O, 2048, 2048, E); } break;
    case 7: if (PHM & (1<<7)) phase_norm(XC, p.norm_mlp_w + l * D_, mod + 8192, mod + 6144, H, nullptr, tid); break;
    case 8: if (PHM & (1<<8)) { EpiRelu2 E{PROJ}; run_gemm(lds, H, WT_MI, 8192, 2048, E); } break;
    case 9: if (PHM & (1<<9)) { EpiResid E{XC, XC, mod + 10240}; run_gemm(lds, PROJ, WT_MO, 2048, 8192, E); } break;
    }
}

constexpr int NPHASE = 22;
__global__ void __launch_bounds__(NTHR, 2) mega_kernel(Params p) {
    extern __shared__ __attribute__((aligned(16))) unsigned char smem[];
    LAS unsigned char* lds = (LAS unsigned char*)smem;
    const int tid = threadIdx.x;
    volatile LAS unsigned* xbw = (volatile LAS unsigned*)(lds + LDS_BYTES - 16);
    if (tid == 0) { xbw[0] = 0u; xbw[1] = 0u; }
    __syncthreads();
    if (p.ph_hi - p.ph_lo > 1) (void)xcd_barrier_post((unsigned*)(p.ws + WS_BAR), xbw);
#ifndef PROBE_REP
#define PROBE_REP 0
#endif
    int ph = p.ph_lo, rep = 0, nbar = 0;
    while (ph < p.ph_hi) {
        if (nbar >= 1 && p.ph_hi - p.ph_lo == 2) { __threadfence(); cg::this_grid().sync(); }
        else if (nbar >= 1) { XcdBarrier xb; xb.bar = (unsigned*)(p.ws + WS_BAR); xb.x = xb_xcc_id(); xb.st = (volatile LAS unsigned*)(lds + LDS_BYTES - 16); xcd_barrier(xb); }
        ++nbar;
        int t2 = tid; asm volatile("" : "+v"(t2));
        unsigned char* wsp;
        {   int z; asm volatile("v_mov_b32 %0, 0" : "=v"(z)); z = __builtin_amdgcn_readfirstlane(z);
            wsp = p.ws + z; }
        run_phase(p, wsp, ph, lds, t2);
        const int sp_ = (ph == 0) ? 10 : (ph == 21) ? 11 : (ph - 1) % 10;
        if (rep == 0 && ((PROBE_REP >> sp_) & 1)) rep = 1; else { rep = 0; ++ph; }
    }
}

#ifndef ONE_LAUNCH
#define ONE_LAUNCH 1
#endif
extern "C" void kernel_launch(void* const* d_in, const int* in_sizes, int n_in, void* d_out, int out_size, void* d_ws, size_t ws_size, hipStream_t stream) {
    static int grid = 0;
    if (grid == 0) {
        if (n_in != 23 || ws_size < WS_END) { fprintf(stderr, "kernel_launch: bad inputs (n_in %d ws %zu need %zu)\n", n_in, ws_size, (size_t)WS_END); grid = -1; return; }
        int dev = 0, cus = 0, per_cu = 0;
        hipGetDevice(&dev); hipDeviceGetAttribute(&cus, hipDeviceAttributeMultiprocessorCount, dev);
        if (hipFuncSetAttribute((const void*)mega_kernel, hipFuncAttributeMaxDynamicSharedMemorySize, LDS_BYTES) != hipSuccess) { fprintf(stderr, "hipFuncSetAttribute failed\n"); grid = -1; return; }
        if (hipOccupancyMaxActiveBlocksPerMultiprocessor(&per_cu, (const void*)mega_kernel, NTHR, LDS_BYTES) != hipSuccess || per_cu < 1) per_cu = 1;
        (void)hipGetLastError();
        grid = cus * 1;
    }
    if (grid < 0) return;
    Params p{};
    p.x = (const float*)d_in[0]; p.c = (const float*)d_in[1]; p.pos = (const int*)d_in[2]; p.w_ada = (const float*)d_in[3]; p.b_ada = (const float*)d_in[4];
    p.norm_mix_w = (const float*)d_in[5]; p.norm_mlp_w = (const float*)d_in[6]; p.w_in = (const float*)d_in[7]; p.conv_qkv_w = (const float*)d_in[8];
    p.a_log = (const float*)d_in[9]; p.dt_bias = (const float*)d_in[10]; p.gdn_norm_w = (const float*)d_in[11]; p.conv_dw_w = (const float*)d_in[12]; p.conv_dw_b = (const float*)d_in[13];
    p.conv_ln_w = (const float*)d_in[14]; p.conv_ln_b = (const float*)d_in[15]; p.w_a = (const float*)d_in[16]; p.w_b = (const float*)d_in[17]; p.w_c = (const float*)d_in[18];
    p.w_out = (const float*)d_in[19]; p.w_mi = (const float*)d_in[20]; p.w_mo = (const float*)d_in[21]; p.final_w = (const float*)d_in[22];
    p.out = (float*)d_out; p.ws = (unsigned char*)d_ws;
#if ONE_LAUNCH
    p.ph_lo = 0; p.ph_hi = NPHASE;
    if (hipMemsetAsync((char*)d_ws + WS_BAR, 0, 32768, stream) != hipSuccess) { fprintf(stderr, "memset failed\n"); return; }
    void* args[] = {&p};
    hipError_t e = hipLaunchCooperativeKernel((const void*)mega_kernel, dim3(grid), dim3(NTHR), args, LDS_BYTES, stream);
    if (e != hipSuccess) fprintf(stderr, "cooperative launch failed: %s (grid %d)\n", hipGetErrorString(e), grid);
#else
    for (int ph = 0; ph < NPHASE; ++ph) { p.ph_lo = ph; p.ph_hi = ph + 1;
        hipLaunchKernelGGL(mega_kernel, dim3(grid), dim3(NTHR), LDS_BYTES, stream, p); }
#endif
}
```

```cpp
#include <hip/hip_runtime.h>
#include <hip/hip_cooperative_groups.h>
#include <cstdio>
namespace pg8 {
#define PG8_LAS __attribute__((address_space(3)))
typedef unsigned short bf16_t;
typedef short bf16x8 __attribute__((ext_vector_type(8)));
typedef float f32x4 __attribute__((ext_vector_type(4)));
typedef unsigned u32x4 __attribute__((ext_vector_type(4)));
constexpr int BM = 256, BK = 64, HALF = 128, HTB = HALF * BK * 2  , STAGE_BYTES = 8 * HTB, NXCD = 8, WGM = 8;

__host__ __device__ __forceinline__ int lds_byte(int r, int c) { const int st = (r >> 4) * 2 + (c >> 5), rr = r & 15, cc = c & 31, ob = rr * 64 + cc * 2; return st * 1024 + (ob ^ (((ob >> 9) & 1) << 5)); }
__host__ __device__ __forceinline__ void stage_rc(int b, int& R, int& C) { const int st = b / 1024, sb = b % 1024, swz = sb ^ (((sb >> 9) & 1) << 5); R = (st >> 1) * 16 + swz / 64; C = (st & 1) * 32 + (swz % 64) / 2; }
__host__ __device__ __forceinline__ int perm32(int rho) { const int n = rho >> 4, i = rho & 15; return 8 * (i >> 2) + 4 * n + (i & 3); }

struct Unit { int pm, pn; };
struct Gemm { const bf16_t* A; const bf16_t* Bt; int M, N, K; };

struct StaticOrder {
    int nM, nN, nwg, G, c;
    __host__ __device__ void init(int M, int N, int G_, int c_) { nM = M / BM; nN = N / BM; nwg = nM * nN; G = G_; c = c_; }
    __host__ __device__ bool next(int i, Unit& u) const {
        const long L = (long)i * G + c; if (L >= nwg) return false;
        int wgid = (int)L; { const int q = nwg / NXCD, r = nwg % NXCD, xcd = wgid % NXCD, off = wgid / NXCD; wgid = (xcd < r ? xcd * (q + 1) : r * (q + 1) + (xcd - r) * q) + off; }
        const int nig = WGM * nN, gid = wgid / nig, fm = gid * WGM, gsz = (nM - fm) < WGM ? (nM - fm) : WGM;
        u.pm = fm + ((wgid % nig) % gsz); u.pn = (wgid % nig) / gsz; return true;
    }
    __device__ __forceinline__ void a_ready(const Unit&) const {}
    __device__ __forceinline__ void done(const Unit&) const {}
};
typedef float f32x2c_ __attribute__((ext_vector_type(2)));
typedef __bf16 bf16x2c_ __attribute__((ext_vector_type(2)));
__device__ __forceinline__ unsigned cvt_pk_bf16(float lo, float hi) { const f32x2c_ v = {lo, hi}; const bf16x2c_ b = __builtin_convertvector(v, bf16x2c_); return __builtin_bit_cast(unsigned, b); }
typedef unsigned u32x2 __attribute__((ext_vector_type(2)));
__device__ __forceinline__ float bf_lo(unsigned w) { return __uint_as_float(w << 16); }
__device__ __forceinline__ float bf_hi(unsigned w) { return __uint_as_float(w & 0xffff0000u); }
__device__ __forceinline__ float sigmoidf_(float x) { return 1.0f / (1.0f + __expf(-x)); }

constexpr int PROJ_LD = 15360;

struct EpiProj {
    static constexpr bool PERM = true, AFTER_DRAIN = false;
    bf16_t* O; float* BA;
    __device__ __forceinline__ void operator()(const f32x4 (&acc)[2][2][4][2], const Unit& u, int wr, int wc, int fr, int fq) const {
        const int row0 = u.pm * BM + wr * 64 + fr;
        if (u.pn < 60) {
            const int col0 = u.pn * BM + wc * 32 + 8 * fq;
#pragma unroll
            for (int ai = 0; ai < 2; ++ai)
#pragma unroll
                for (int m = 0; m < 4; ++m) { bf16_t* rowp = O + (size_t)(row0 + ai * HALF + m * 16) * PROJ_LD + col0;
#pragma unroll
                    for (int bj = 0; bj < 2; ++bj) { const f32x4 v0 = acc[ai][bj][m][0], v1 = acc[ai][bj][m][1];
                        u32x4 w; w.x = cvt_pk_bf16(v0[0], v0[1]); w.y = cvt_pk_bf16(v0[2], v0[3]); w.z = cvt_pk_bf16(v1[0], v1[1]); w.w = cvt_pk_bf16(v1[2], v1[3]);
                        *(u32x4*)(rowp + bj * HALF) = w; } }
        } else {
            if (wc == 0 && fq < 2) {
#pragma unroll
                for (int ai = 0; ai < 2; ++ai)
#pragma unroll
                    for (int m = 0; m < 4; ++m) { float* rowp = BA + (size_t)(row0 + ai * HALF + m * 16) * 16 + 8 * fq;
#pragma unroll
                        for (int n = 0; n < 2; ++n) *(f32x4*)(rowp + 4 * n) = acc[ai][0][m][n]; }
            }
        }
    }
};
template <int PASS> struct EpiBranch {
    static constexpr bool PERM = true, AFTER_DRAIN = false;
    const bf16_t* PROJ; float* MF; bf16_t* MB;
    __device__ __forceinline__ void operator()(const f32x4 (&acc)[2][2][4][2], const Unit& u, int wr, int wc, int fr, int fq) const {
        const int row0 = u.pm * BM + wr * 64 + fr, col0 = u.pn * BM + wc * 32 + 8 * fq;
        float* mfb = MF + ((size_t)((u.pm * 8 + u.pn) * 8 + wr * 4 + wc) * 32) * 256 + (fq * 16 + fr) * 4;
#pragma unroll
        for (int ai = 0; ai < 2; ++ai)
#pragma unroll
            for (int mp = 0; mp < 2; ++mp) {
                u32x4 gw[2][2]; f32x4 mv[2][2][2];
#pragma unroll
                for (int mm = 0; mm < 2; ++mm) { const int m = 2 * mp + mm; const size_t row = (size_t)(row0 + ai * HALF + m * 16);
#pragma unroll
                    for (int bj = 0; bj < 2; ++bj) { gw[mm][bj] = *(const u32x4*)(PROJ + row * PROJ_LD + 9216 + PASS * 2048 + col0 + bj * HALF);
#pragma unroll
                        for (int n = 0; n < 2; ++n) if (PASS > 0) mv[mm][bj][n] = *(const f32x4*)(mfb + (((ai * 4 + m) * 2 + bj) * 2 + n) * 256); } }
#pragma unroll
                for (int mm = 0; mm < 2; ++mm) { const int m = 2 * mp + mm; const size_t row = (size_t)(row0 + ai * HALF + m * 16);
#pragma unroll
                    for (int bj = 0; bj < 2; ++bj) { const u32x4 g4 = gw[mm][bj];
                        f32x4 g0, g1; g0[0] = sigmoidf_(bf_lo(g4.x)); g0[1] = sigmoidf_(bf_hi(g4.x)); g0[2] = sigmoidf_(bf_lo(g4.y)); g0[3] = sigmoidf_(bf_hi(g4.y));
                        g1[0] = sigmoidf_(bf_lo(g4.z)); g1[1] = sigmoidf_(bf_hi(g4.z)); g1[2] = sigmoidf_(bf_lo(g4.w)); g1[3] = sigmoidf_(bf_hi(g4.w));
                        f32x4 v0 = g0 * acc[ai][bj][m][0], v1 = g1 * acc[ai][bj][m][1];
                        if (PASS > 0) { v0 += mv[mm][bj][0]; v1 += mv[mm][bj][1]; }
                        if (PASS < 2) { *(f32x4*)(mfb + (((ai * 4 + m) * 2 + bj) * 2 + 0) * 256) = v0; *(f32x4*)(mfb + (((ai * 4 + m) * 2 + bj) * 2 + 1) * 256) = v1; }
                        else { u32x4 w; w.x = cvt_pk_bf16(v0[0], v0[1]); w.y = cvt_pk_bf16(v0[2], v0[3]); w.z = cvt_pk_bf16(v1[0], v1[1]); w.w = cvt_pk_bf16(v1[2], v1[3]);
                            *(u32x4*)(MB + row * 2048 + col0 + bj * HALF) = w; } } }
                asm volatile("" ::: "memory"); }
    }
};
struct EpiResid {
    static constexpr bool PERM = false, AFTER_DRAIN = false;
    const float* xin; float* xout; const float* gate;
    __device__ __forceinline__ void operator()(const f32x4 (&acc)[2][2][4][2], const Unit& u, int wr, int wc, int fr, int fq) const {
        const int row0 = u.pm * BM + wr * 64 + fr, col0 = u.pn * BM + wc * 32 + 4 * fq;
        f32x4 gv[2][2];
#pragma unroll
        for (int bj = 0; bj < 2; ++bj)
#pragma unroll
            for (int n = 0; n < 2; ++n) gv[bj][n] = *(const f32x4*)(gate + col0 + bj * HALF + n * 16);
#pragma unroll
        for (int ai = 0; ai < 2; ++ai)
#pragma unroll
            for (int mp = 0; mp < 2; ++mp) { f32x4 bv[2][2][2];
#pragma unroll
                for (int mm = 0; mm < 2; ++mm) { const size_t off = (size_t)(row0 + ai * HALF + (2 * mp + mm) * 16) * 2048 + col0;
#pragma unroll
                    for (int bj = 0; bj < 2; ++bj)
#pragma unroll
                        for (int n = 0; n < 2; ++n) bv[mm][bj][n] = *(const f32x4*)(xin + off + bj * HALF + n * 16); }
#pragma unroll
                for (int mm = 0; mm < 2; ++mm) { const int m = 2 * mp + mm; const size_t off = (size_t)(row0 + ai * HALF + m * 16) * 2048 + col0;
#pragma unroll
                    for (int bj = 0; bj < 2; ++bj)
#pragma unroll
                        for (int n = 0; n < 2; ++n) *(f32x4*)(xout + off + bj * HALF + n * 16) = bv[mm][bj][n] + gv[bj][n] * acc[ai][bj][m][n]; }
                asm volatile("" ::: "memory"); }
    }
};
struct EpiRelu2 {
    static constexpr bool PERM = true, AFTER_DRAIN = false;
    bf16_t* O;
    __device__ __forceinline__ void operator()(const f32x4 (&acc)[2][2][4][2], const Unit& u, int wr, int wc, int fr, int fq) const {
        const int row0 = u.pm * BM + wr * 64 + fr, col0 = u.pn * BM + wc * 32 + 8 * fq;
#pragma unroll
        for (int ai = 0; ai < 2; ++ai)
#pragma unroll
            for (int m = 0; m < 4; ++m) { bf16_t* rowp = O + (size_t)(row0 + ai * HALF + m * 16) * 8192 + col0;
#pragma unroll
                for (int bj = 0; bj < 2; ++bj) { f32x4 v0 = acc[ai][bj][m][0], v1 = acc[ai][bj][m][1];
#pragma unroll
                    for (int j = 0; j < 4; ++j) { const float a = fmaxf(v0[j], 0.f), b = fmaxf(v1[j], 0.f); v0[j] = a * a; v1[j] = b * b; }
                    u32x4 w; w.x = cvt_pk_bf16(v0[0], v0[1]); w.y = cvt_pk_bf16(v0[2], v0[3]); w.z = cvt_pk_bf16(v1[0], v1[1]); w.w = cvt_pk_bf16(v1[2], v1[3]);
                    *(u32x4*)(rowp + bj * HALF) = w; } }
    }
};

template <class Epi, class Sched, bool STAMP = false>
__device__ __forceinline__ void gemm_phase(PG8_LAS unsigned char* lds, const Gemm g, const Sched& S, const Epi& E, unsigned long long* stamps) {
    int tid = threadIdx.x; asm volatile("" : "+v"(tid));
    const int wid = __builtin_amdgcn_readfirstlane(tid >> 6), lane = tid & 63, wr = wid >> 2, wc = wid & 3, fr = lane & 15, fq = lane >> 4;
    const int K = g.K, nt = K / BK;
    int ts_lo = 0, ts_hi = 0, nts = 0; const unsigned long long rt_entry = STAMP ? (unsigned long long)wall_clock64() : 0ull;
#define PG8_STAMP() do { if (STAMP && wid == 0 && nts < 64) { const unsigned long long _c = (unsigned long long)clock64(); \
        ts_lo = (lane == nts) ? (int)(unsigned)_c : ts_lo; ts_hi = (lane == nts) ? (int)(unsigned)(_c >> 32) : ts_hi; ++nts; } } while (0)
    PG8_STAMP();
    unsigned voffA[2], voffB[2];
#pragma unroll
    for (int i = 0; i < 2; ++i) { int R, C; stage_rc(tid * 16 + i * 8192, R, C); const int Rb = Epi::PERM ? ((R & ~31) + perm32(R & 31)) : R;
        voffA[i] = (unsigned)(R * K + C) * 2u; voffB[i] = (unsigned)(Rb * K + C) * 2u; }
    const size_t kstep = (size_t)(BK * 2);
    const size_t hstep = (size_t)HALF * K * 2;
    const size_t tstep = 2 * hstep;
    const unsigned ldsw = (unsigned)wid * 1024u;
    const int aoff = lds_byte(wr * 64 + fr, fq * 8), boff = lds_byte(wc * 32 + fr, fq * 8);
#define PG8_SA(b, h) (((b) * 2 + (h)) * HTB)
#define PG8_SB(b, h) ((4 + (b) * 2 + (h)) * HTB)
#define PG8_STAGE(bufoff, gbase, voff) do { _Pragma("unroll") for (int _i = 0; _i < 2; ++_i) \
        __builtin_amdgcn_global_load_lds((const unsigned*)((const char*)(gbase) + (voff)[_i]), (PG8_LAS unsigned*)(lds + (bufoff) + ldsw + _i * 8192), 16, 0, 0); } while (0)
#define PG8_LDA(dst, b, h) do { _Pragma("unroll") for (int m = 0; m < 4; ++m) _Pragma("unroll") for (int k = 0; k < 2; ++k) dst[m][k] = *(const PG8_LAS bf16x8*)(lds + PG8_SA(b, h) + aoff + m * 2048 + k * 1024); } while (0)
#define PG8_LDB(dst, b, h) do { _Pragma("unroll") for (int n = 0; n < 2; ++n) _Pragma("unroll") for (int k = 0; k < 2; ++k) dst[n][k] = *(const PG8_LAS bf16x8*)(lds + PG8_SB(b, h) + boff + n * 2048 + k * 1024); } while (0)
#define PG8_MMA(ai, bj, At, Bt) do { __builtin_amdgcn_s_setprio(1); _Pragma("unroll") for (int m = 0; m < 4; ++m) _Pragma("unroll") for (int n = 0; n < 2; ++n) _Pragma("unroll") for (int k = 0; k < 2; ++k) \
        acc[ai][bj][m][n] = __builtin_amdgcn_mfma_f32_16x16x32_bf16(Bt[n][k], At[m][k], acc[ai][bj][m][n], 0, 0, 0); __builtin_amdgcn_s_setprio(0); } while (0)
#define PG8_WAIT_V(n) asm volatile("s_waitcnt vmcnt(" #n ")" ::: "memory")
#define PG8_WAIT_L(n) asm volatile("s_waitcnt lgkmcnt(" #n ")" ::: "memory")
#define PG8_BAR __builtin_amdgcn_s_barrier()
#define PG8_SCHED __builtin_amdgcn_sched_barrier(0)
    Unit cur, nxt; int ui = 0;
    if (!S.next(0, cur)) return;
    f32x4 acc[2][2][4][2];
#pragma unroll
    for (int a = 0; a < 2; ++a)
#pragma unroll
        for (int b = 0; b < 2; ++b)
#pragma unroll
            for (int m = 0; m < 4; ++m)
#pragma unroll
                for (int n = 0; n < 2; ++n) acc[a][b][m][n] = (f32x4){0.f, 0.f, 0.f, 0.f};
    bf16x8 At[4][2], B0[2][2], B1[2][2];
    const char* cA = (const char*)g.A + (size_t)cur.pm * tstep; const char* cB = (const char*)g.Bt + (size_t)cur.pn * tstep;
    S.a_ready(cur);
    PG8_STAGE(PG8_SB(0, 0), cB, voffB); PG8_STAGE(PG8_SA(0, 0), cA, voffA); PG8_STAGE(PG8_SB(0, 1), cB + hstep, voffB); PG8_STAGE(PG8_SA(0, 1), cA + hstep, voffA);
    if (wr == 1) PG8_BAR;
    PG8_WAIT_V(4); PG8_BAR;
    PG8_STAGE(PG8_SB(1, 0), cB + kstep, voffB); PG8_STAGE(PG8_SA(1, 0), cA + kstep, voffA); PG8_STAGE(PG8_SB(1, 1), cB + hstep + kstep, voffB);
    PG8_WAIT_V(6); PG8_BAR;
    PG8_STAMP();
    for (;;) {
        const bool has_next = S.next(ui + 1, nxt);
        const char* nA = has_next ? (const char*)g.A + (size_t)nxt.pm * tstep : cA; const char* nB = has_next ? (const char*)g.Bt + (size_t)nxt.pn * tstep : cB;
        for (int t = 0; t < nt; t += 2) {
            const bool last = (t == nt - 2);
            const char* a1 = cA + (size_t)(t + 1) * kstep;
            const char* a2 = last ? nA : cA + (size_t)(t + 2) * kstep; const char* b2 = last ? nB : cB + (size_t)(t + 2) * kstep;
            const char* a3 = a2 + kstep; const char* b3 = b2 + kstep;
            if (last && has_next) S.a_ready(nxt);
            PG8_LDB(B0, 0, 0); PG8_SCHED; PG8_LDA(At, 0, 0); PG8_STAGE(PG8_SA(1, 1), a1 + hstep, voffA);
            PG8_WAIT_L(8); PG8_BAR; PG8_WAIT_L(0); PG8_MMA(0, 0, At, B0); PG8_BAR; PG8_SCHED;
            PG8_LDB(B1, 0, 1); PG8_STAGE(PG8_SB(0, 0), b2, voffB);
            PG8_BAR; PG8_WAIT_L(0); PG8_MMA(0, 1, At, B1); PG8_BAR;
            PG8_LDA(At, 0, 1); PG8_STAGE(PG8_SA(0, 0), a2, voffA);
            PG8_BAR; PG8_WAIT_L(0); PG8_MMA(1, 0, At, B0); PG8_BAR; PG8_SCHED;
            PG8_STAGE(PG8_SB(0, 1), b2 + hstep, voffB);
            PG8_WAIT_V(6); PG8_BAR; PG8_MMA(1, 1, At, B1); PG8_BAR;
            PG8_LDB(B0, 1, 0); PG8_SCHED; PG8_LDA(At, 1, 0); PG8_STAGE(PG8_SA(0, 1), a2 + hstep, voffA);
            PG8_WAIT_L(8); PG8_BAR; PG8_WAIT_L(0); PG8_MMA(0, 0, At, B0); PG8_BAR; PG8_SCHED;
            PG8_LDB(B1, 1, 1); PG8_STAGE(PG8_SB(1, 0), b3, voffB);
            PG8_BAR; PG8_WAIT_L(0); PG8_MMA(0, 1, At, B1); PG8_BAR;
            PG8_LDA(At, 1, 1); PG8_STAGE(PG8_SA(1, 0), a3, voffA);
            PG8_BAR; PG8_WAIT_L(0); PG8_MMA(1, 0, At, B0); PG8_BAR; PG8_SCHED;
            PG8_STAGE(PG8_SB(1, 1), b3 + hstep, voffB);
            PG8_WAIT_V(6); PG8_BAR; PG8_MMA(1, 1, At, B1); PG8_BAR;
        }
        PG8_STAMP();
        if constexpr (!Epi::AFTER_DRAIN) { E(acc, cur, wr, wc, fr, fq); S.done(cur); }
        PG8_STAMP();
        if (!has_next) break;
#pragma unroll
        for (int a = 0; a < 2; ++a)
#pragma unroll
            for (int b = 0; b < 2; ++b)
#pragma unroll
                for (int m = 0; m < 4; ++m)
#pragma unroll
                    for (int n = 0; n < 2; ++n) acc[a][b][m][n] = (f32x4){0.f, 0.f, 0.f, 0.f};
        cur = nxt; cA = nA; cB = nB; ++ui;
    }
    PG8_WAIT_V(0);
    if (wr == 0) PG8_BAR;
    PG8_BAR;
    if constexpr (Epi::AFTER_DRAIN) { E.fused(acc, cur, wr, wc, fr, fq, lds, wid, lane); S.done(cur); }
    PG8_STAMP();
    if (STAMP && wid == 0) { stamps[lane] = lane < nts ? (((unsigned long long)(unsigned)ts_hi << 32) | (unsigned)ts_lo) : 0ull;
        if (lane == 62) stamps[62] = rt_entry; if (lane == 63) stamps[63] = (unsigned long long)wall_clock64(); }
#undef PG8_STAMP
#undef PG8_SA
#undef PG8_SB
#undef PG8_STAGE
#undef PG8_LDA
#undef PG8_LDB
#undef PG8_MMA
#undef PG8_WAIT_V
#undef PG8_WAIT_L
#undef PG8_BAR
#undef PG8_SCHED
}
}
using namespace pg8;
namespace cg = cooperative_groups;
#define LAS PG8_LAS
#define DI __device__ __forceinline__

constexpr int T_ = 8192, D_ = 2048, INW = 15376, NP1 = 15616, DFF = 8192;
constexpr int LDS_BYTES = 147456;
constexpr int NTHR = 512;
constexpr float EPS = 1e-6f;

constexpr size_t SZ_WT_IN = (size_t)NP1 * 2048 * 2, SZ_WT_BR = (size_t)2048 * 1024 * 2, SZ_WT_O = (size_t)2048 * 2048 * 2, SZ_WT_M = (size_t)8192 * 2048 * 2;
constexpr size_t SZ_WL = SZ_WT_IN + 3 * SZ_WT_BR + SZ_WT_O + 2 * SZ_WT_M;
constexpr size_t WS_W = 0;
constexpr size_t WS_MOD = WS_W + 2 * SZ_WL;
constexpr size_t WS_XC = WS_MOD + 2 * 12288 * 4;
constexpr size_t WS_H = WS_XC + (size_t)T_ * D_ * 4;
constexpr size_t WS_PROJ = WS_H + (size_t)T_ * D_ * 2;
constexpr size_t WS_BA = WS_PROJ + (size_t)T_ * 15360 * 2;
constexpr size_t WS_R2 = WS_BA + (size_t)T_ * 16 * 4;
constexpr size_t G_A = WS_R2;
constexpr size_t G_BT = G_A + (size_t)T_ * 2048 * 2;
constexpr size_t G_C = G_BT + (size_t)T_ * 2048 * 2;
constexpr size_t G_D = G_C + (size_t)T_ * 1024 * 2;
constexpr size_t G_GL = G_D + (size_t)T_ * 1024 * 2;
constexpr size_t R_SC = G_GL + 4096;
constexpr size_t R_QI = R_SC + (size_t)T_ * 256 * 2;
constexpr size_t R_VT = R_QI + (size_t)T_ * 512 * 2;
constexpr size_t WS_R3 = R_VT + (size_t)T_ * 1024 * 2;
constexpr size_t WS_OA = WS_R3;
constexpr size_t WS_OB = WS_OA + (size_t)T_ * 1024 * 4;
constexpr size_t WS_CV = WS_OB + (size_t)T_ * 1024 * 4;
constexpr size_t WS_ACT = WS_CV + (size_t)T_ * 1024 * 4;
constexpr size_t WS_MB = WS_ACT + 3 * (size_t)T_ * 1024 * 2;
constexpr size_t WS_BAR = WS_MB + (size_t)T_ * D_ * 2;
constexpr size_t WS_PROG = WS_BAR + 16384;
constexpr size_t WS_END = WS_PROG + 16384;
constexpr size_t R_P = WS_OA;
constexpr size_t G_S = WS_H;
constexpr size_t R_RT = WS_MB;
constexpr size_t WS_MF = WS_R2;
static_assert(WS_MF + (size_t)T_ * D_ * 4 <= WS_R3, "merged f32 alias");

struct Params {
    const float* x; const float* c; const int* pos; const float* w_ada; const float* b_ada; const float* norm_mix_w; const float* norm_mlp_w; const float* w_in;
    const float* conv_qkv_w; const float* a_log; const float* dt_bias; const float* gdn_norm_w; const float* conv_dw_w; const float* conv_dw_b; const float* conv_ln_w; const float* conv_ln_b;
    const float* w_a; const float* w_b; const float* w_c; const float* w_out; const float* w_mi; const float* w_mo; const float* final_w;
    float* out; unsigned char* ws; int ph_lo, ph_hi;
};

DI unsigned pk2(float lo, float hi) { return cvt_pk_bf16(lo, hi); }
DI bf16_t f2bf(float f) { return (bf16_t)(cvt_pk_bf16(f, 0.f) & 0xffffu); }
DI float siluf_(float x) { return x / (1.0f + __expf(-x)); }
DI float ret_lg2(int hr) { return hr == 0 ? -0.04580368961312479f : hr == 1 ? -0.02272007650008353f : hr == 2 ? -0.011315313227834146f : -0.005646563141142063f; }
DI float wave_sum(float v) {
#pragma unroll
    for (int o = 1; o < 64; o <<= 1) v += __shfl_xor(v, o);
    return v;
}
DI void lds_barrier() { asm volatile("s_waitcnt lgkmcnt(0)" ::: "memory"); __builtin_amdgcn_s_barrier(); asm volatile("" ::: "memory"); }
DI void full_barrier() { asm volatile("s_waitcnt vmcnt(0) lgkmcnt(0)" ::: "memory"); __builtin_amdgcn_s_barrier(); asm volatile("" ::: "memory"); }
DI f32x4 mfma16(bf16x8 a, bf16x8 b, f32x4 c) { return __builtin_amdgcn_mfma_f32_16x16x32_bf16(a, b, c, 0, 0, 0); }
DI bf16x8 lds_frag(LAS unsigned char* base, int row, int stride_el, int k0) { return *(const LAS bf16x8*)(base + ((size_t)row * stride_el + k0) * 2); }
DI void unpack8(const u32x4 w, float (&f)[8]) { f[0] = bf_lo(w.x); f[1] = bf_hi(w.x); f[2] = bf_lo(w.y); f[3] = bf_hi(w.y); f[4] = bf_lo(w.z); f[5] = bf_hi(w.z); f[6] = bf_lo(w.w); f[7] = bf_hi(w.w); }
DI u32x4 pack8(const float* f) { u32x4 w; w.x = pk2(f[0], f[1]); w.y = pk2(f[2], f[3]); w.z = pk2(f[4], f[5]); w.w = pk2(f[6], f[7]); return w; }

#define XB_TMO      128
#define XB_XCNT(j)  (256  + 64 * (j))
#define XB_XSUB(j)  (1280 + 64 * (j))
#define XB_XGEN(j)  (2304 + 64 * (j))
#define XB_TOP      3328
#define XB_TOPGEN   3392
#define XCD_BAR_WORDS 3456
#define XB_SPIN_CAP (1u << 18)


__device__ __forceinline__ unsigned xb_ld(unsigned* p)              { return __hip_atomic_load(p, __ATOMIC_RELAXED, __HIP_MEMORY_SCOPE_AGENT); }
__device__ __forceinline__ unsigned xb_add(unsigned* p, unsigned v) { return __hip_atomic_fetch_add(p, v, __ATOMIC_RELAXED, __HIP_MEMORY_SCOPE_AGENT); }
__device__ __forceinline__ unsigned xb_xcc_id() { return (unsigned)__builtin_amdgcn_s_getreg((3 << 11) | 20) & 0xFu; }
#define XB_SPIN(cond, bar) do { unsigned _sp = 0; while (cond) { __builtin_amdgcn_s_sleep(1); \
    if ((++_sp & 255u) == 0u) { if (xb_ld(&(bar)[XB_TMO])) break; if (_sp > XB_SPIN_CAP) { atomicAdd(&(bar)[XB_TMO], 1u); break; } } } } while (0)

struct XcdBarrier {
    unsigned* bar; unsigned x;
    volatile LAS unsigned* st;
};

__device__ __forceinline__ XcdBarrier xcd_barrier_post(unsigned* bar, volatile LAS unsigned* st) {
    XcdBarrier b; b.bar = bar; b.x = xb_xcc_id(); b.st = st;
    if (threadIdx.x == 0) (void)xb_add(&bar[XB_XCNT(b.x)], 1u);
    return b;
}
__device__ __forceinline__ void xcd_barrier_complete(unsigned* bar, unsigned x, unsigned& nloc, unsigned& nx) {
    const unsigned G = gridDim.x * gridDim.y * gridDim.z;
    unsigned sum, cnt, mine, sp = 0u;
    for (;;) {
        sum = 0u; cnt = 0u; mine = 0u;
#pragma unroll
        for (unsigned j = 0; j < 16; ++j) { const unsigned c = xb_ld(&bar[XB_XCNT(j)]); sum += c; cnt += (c > 0u) ? 1u : 0u; mine = (j == x) ? c : mine; }
        if (sum == G) break;
        __builtin_amdgcn_s_sleep(1);
        if ((++sp & 255u) == 0u) { if (xb_ld(&bar[XB_TMO])) break; if (sp > XB_SPIN_CAP) { atomicAdd(&bar[XB_TMO], 1u); break; } }
    }
    nloc = mine > 0u ? mine : 1u; nx = cnt > 0u ? cnt : 1u;
}

__device__ __forceinline__ void xcd_barrier(const XcdBarrier& b) {
    asm volatile("s_waitcnt vmcnt(0)" ::: "memory");
    __syncthreads();
    if (threadIdx.x == 0) {
        unsigned* bar = b.bar;
        __builtin_amdgcn_s_waitcnt(0);
        unsigned nloc = b.st[0], nx = b.st[1];
        if (nloc == 0u) { xcd_barrier_complete(bar, b.x, nloc, nx); b.st[0] = nloc; b.st[1] = nx; }
        const unsigned old = xb_add(&bar[XB_XSUB(b.x)], 1u);
        const unsigned gen = old / nloc;
        if (old + 1u == (gen + 1u) * nloc) {
            __builtin_amdgcn_fence(__ATOMIC_RELEASE, "agent");
            asm volatile("s_waitcnt vmcnt(0)" ::: "memory");
            const unsigned og = xb_add(&bar[XB_TOP], 1u);
            const unsigned tg = og / nx;
            if (og + 1u == (tg + 1u) * nx) xb_add(&bar[XB_TOPGEN], 1u);
            else XB_SPIN(xb_ld(&bar[XB_TOPGEN]) == tg, bar);
            __builtin_amdgcn_fence(__ATOMIC_ACQUIRE, "agent");
            xb_add(&bar[XB_XGEN(b.x)], 1u);
            asm volatile("s_waitcnt vmcnt(0)" ::: "memory");
        } else {
            XB_SPIN(xb_ld(&bar[XB_XGEN(b.x)]) == gen, bar);
            __builtin_amdgcn_fence(__ATOMIC_ACQUIRE, "agent");
            asm volatile("s_waitcnt vmcnt(0)" ::: "memory");
        }
    }
    __syncthreads();
}


DI void transpose_item(const float* W, int ldw, int K, int src_col0, int valid, bf16_t* WT, int dst_row0, int k0, LAS float* scr, int lane) {
    const int nn = lane & 31;
    float tv[64];
#pragma unroll
    for (int i = 0; i < 64; ++i) { const int kk = 2 * i + (lane >> 5);
        tv[i] = 0.f; if (nn < valid) tv[i] = W[(size_t)(k0 + kk) * ldw + src_col0 + nn]; }
#pragma unroll
    for (int i = 0; i < 64; ++i) { const int kk = 2 * i + (lane >> 5); scr[kk * 33 + nn] = tv[i]; }
    asm volatile("s_waitcnt lgkmcnt(0)" ::: "memory");
    const int c = lane & 15;
#pragma unroll
    for (int j = 0; j < 8; ++j) { const int n = (lane >> 4) + 4 * j; const LAS float* s = scr + (8 * c) * 33 + n;
        u32x4 o; o.x = pk2(s[0 * 33], s[1 * 33]); o.y = pk2(s[2 * 33], s[3 * 33]); o.z = pk2(s[4 * 33], s[5 * 33]); o.w = pk2(s[6 * 33], s[7 * 33]);
        *(u32x4*)(WT + (size_t)(dst_row0 + n) * K + k0 + 8 * c) = o; }
    asm volatile("s_waitcnt lgkmcnt(0)" ::: "memory");
}

DI void phase_prep(const Params& p, unsigned char* wsp, LAS unsigned char* lds, int tid) {
    const int lane = tid & 63, wave = tid >> 6, G = gridDim.x, b = blockIdx.x;
    float* mod = (float*)(wsp + WS_MOD);
    for (int u = b; u < 192; u += G) {
        const int l = u / 96, strip = u % 96, kg = tid >> 5, cl = tid & 31, col = 128 * strip + 4 * cl;
        f32x4 acc = {0.f, 0.f, 0.f, 0.f};
        const float* wp = p.w_ada + (size_t)l * 2048 * 12288 + col;
#pragma unroll 16
        for (int k = kg; k < 2048; k += 16) { const float s = siluf_(p.c[k]); const f32x4 w = *(const f32x4*)(wp + (size_t)k * 12288); acc += s * w; }
        LAS f32x4* red = (LAS f32x4*)lds;
        red[kg * 32 + cl] = acc;
        lds_barrier();
        if (tid < 128) { float s = 0.f; const LAS float* rf = (const LAS float*)lds;
#pragma unroll
            for (int g = 0; g < 16; ++g) s += rf[g * 128 + tid];
            mod[l * 12288 + 128 * strip + tid] = s + p.b_ada[l * 12288 + 128 * strip + tid]; }
        lds_barrier();
    }
    LAS float* scr = (LAS float*)(lds + wave * 17408);
    const int gw = b * 8 + wave, NGW = G * 8;
    constexpr int I_IN = 488 * 16, I_BR = 64 * 8, I_O = 64 * 16, I_MI = 256 * 16, I_MO = 64 * 64, I_L = I_IN + 3 * I_BR + I_O + I_MI + I_MO;
    for (int it = gw; it < 2 * I_L; it += NGW) {
        const int l = it / I_L; int r = it % I_L;
        unsigned char* wl = wsp + WS_W + (size_t)l * SZ_WL;
        if (r < I_IN) { const int kb = r / 488, nb = r % 488, d0 = 32 * nb; int src, valid;
            if (d0 < 4096) { src = d0; valid = 32; } else if (d0 < 15360) { src = d0 + 16; valid = 32; } else if (d0 == 15360) { src = 4096; valid = 16; } else { src = 0; valid = 0; }
            transpose_item(p.w_in + (size_t)l * 2048 * INW, INW, 2048, src, valid, (bf16_t*)wl, d0, 128 * kb, scr, lane); continue; }
        r -= I_IN;
        if (r < 3 * I_BR) { const int which = r / I_BR, q = r % I_BR, kb = q / 64, nb = q % 64;
            const float* W = (which == 0 ? p.w_a : which == 1 ? p.w_b : p.w_c) + (size_t)l * 1024 * 2048;
            transpose_item(W, 2048, 1024, 32 * nb, 32, (bf16_t*)(wl + SZ_WT_IN + which * SZ_WT_BR), 32 * nb, 128 * kb, scr, lane); continue; }
        r -= 3 * I_BR;
        if (r < I_O) { const int kb = r / 64, nb = r % 64;
            transpose_item(p.w_out + (size_t)l * 2048 * 2048, 2048, 2048, 32 * nb, 32, (bf16_t*)(wl + SZ_WT_IN + 3 * SZ_WT_BR), 32 * nb, 128 * kb, scr, lane); continue; }
        r -= I_O;
        if (r < I_MI) { const int kb = r / 256, nb = r % 256;
            transpose_item(p.w_mi + (size_t)l * 2048 * 8192, 8192, 2048, 32 * nb, 32, (bf16_t*)(wl + SZ_WT_IN + 3 * SZ_WT_BR + SZ_WT_O), 32 * nb, 128 * kb, scr, lane); continue; }
        r -= I_MI;
        { const int kb = r / 64, nb = r % 64;
            transpose_item(p.w_mo + (size_t)l * 8192 * 2048, 2048, 8192, 32 * nb, 32, (bf16_t*)(wl + SZ_WT_IN + 3 * SZ_WT_BR + SZ_WT_O + SZ_WT_M), 32 * nb, 128 * kb, scr, lane); }
    }
}

DI void phase_norm(const float* xin, const float* nw, const float* scale, const float* shift, bf16_t* H, float* outf, int tid) {
    const int lane = tid & 63, wave = tid >> 6, gw = blockIdx.x * 8 + wave, NGW = gridDim.x * 8;
    for (int row0 = gw; row0 < T_; row0 += 2 * NGW) {
        const int row1 = (row0 + NGW < T_) ? row0 + NGW : row0;
        f32x4 v[2][8]; float ss[2] = {0.f, 0.f};
#pragma unroll
        for (int r = 0; r < 2; ++r) { const float* xr = xin + (size_t)(r ? row1 : row0) * D_;
#pragma unroll
            for (int j = 0; j < 8; ++j) v[r][j] = *(const f32x4*)(xr + (j * 64 + lane) * 4); }
#pragma unroll
        for (int r = 0; r < 2; ++r) {
#pragma unroll
            for (int j = 0; j < 8; ++j) ss[r] += (v[r][j][0] * v[r][j][0] + v[r][j][1] * v[r][j][1]) + (v[r][j][2] * v[r][j][2] + v[r][j][3] * v[r][j][3]);
            ss[r] = wave_sum(ss[r]); }
#pragma unroll
        for (int r = 0; r < 2; ++r) { const int row = r ? row1 : row0; if (r == 1 && row1 == row0) break;
            const float rstd = 1.0f / sqrtf(ss[r] * (1.0f / D_) + EPS);
#pragma unroll
            for (int j = 0; j < 8; ++j) { const int c = (j * 64 + lane) * 4; const f32x4 w = *(const f32x4*)(nw + c);
                f32x4 y = v[r][j] * rstd * w;
                if (H) { const f32x4 sc = *(const f32x4*)(scale + c), sh = *(const f32x4*)(shift + c); y = y * (1.0f + sc) + sh;
                    u32x2 o; o.x = pk2(y[0], y[1]); o.y = pk2(y[2], y[3]); *(u32x2*)(H + (size_t)row * D_ + c) = o; }
                else *(f32x4*)(outf + (size_t)row * D_ + c) = y; } }
    }
}

DI void gdn_prep_unit(const Params& p, unsigned char* wsp, int l, int hh, int n, LAS unsigned char* lds, int tid) {
    asm volatile("" : "+v"(tid));
    const int lane = tid & 63, wave = tid >> 6, quad = lane >> 4, l15 = lane & 15;
    const int r = tid >> 3, cgp = tid & 7, t = 64 * n + r;
    constexpr int K_OFF = 0, KB_OFF = 17408, Q_OFF = 34816, VBT_OFF = 52224, KBGT_OFF = 70656, KDT_OFF = 89088, T_OFF = 107520, L_OFF = 116736, SG_OFF = 134144, SB_OFF = SG_OFF + 256, GC_OFF = SB_OFF + 256;
    constexpr int ATTI_OFF = 135168, WT_OFF = K_OFF, UT_OFF = KB_OFF;
    static_assert(ATTI_OFF + 9216 <= LDS_BYTES - 16, "lds");
    const bf16_t* PROJ = (const bf16_t*)(wsp + WS_PROJ); const float* BA = (const float*)(wsp + WS_BA);
    const size_t ub = (size_t)hh * 128 + n;
    u32x4 pa[3][4][2];
#pragma unroll
    for (int X = 0; X < 3; ++X) { const int ch = X * 1024 + hh * 128 + 16 * cgp;
#pragma unroll
        for (int j = 0; j < 4; ++j) { const int tt = t - 3 + j; pa[X][j][0] = (u32x4){0u, 0u, 0u, 0u}; pa[X][j][1] = (u32x4){0u, 0u, 0u, 0u};
            if (tt >= 0) { pa[X][j][0] = *(const u32x4*)(PROJ + (size_t)tt * PROJ_LD + ch); pa[X][j][1] = *(const u32x4*)(PROJ + (size_t)tt * PROJ_LD + ch + 8); } } }
    float ba_b = 0.f, ba_a = 0.f;
    if (cgp == 0) { ba_b = BA[(size_t)t * 16 + hh]; ba_a = BA[(size_t)t * 16 + 8 + hh]; }
    {   LAS float* CW = (LAS float*)lds;
#pragma unroll
        for (int i = 0; i < 3; ++i) { const int f = tid + 512 * i, X = f >> 9, j = (f >> 7) & 3, c = f & 127;
            CW[f] = p.conv_qkv_w[((size_t)l * 4 + j) * 3072 + X * 1024 + hh * 128 + c]; } }
    lds_barrier();
    float val[3][16];
#pragma unroll
    for (int X = 0; X < 3; ++X) {
#pragma unroll
        for (int i = 0; i < 16; ++i) val[X][i] = 0.f;
#pragma unroll
        for (int j = 0; j < 4; ++j) { float xa[8], xb[8]; unpack8(pa[X][j][0], xa); unpack8(pa[X][j][1], xb);
            const LAS float* cw = (const LAS float*)lds + X * 512 + j * 128 + 16 * cgp;
#pragma unroll
            for (int q4 = 0; q4 < 4; ++q4) { const f32x4 w = *(const LAS f32x4*)(cw + 4 * q4);
#pragma unroll
                for (int e = 0; e < 4; ++e) { const int i = 4 * q4 + e; val[X][i] += w[e] * (i < 8 ? xa[i] : xb[i - 8]); } } }
#pragma unroll
        for (int i = 0; i < 16; ++i) val[X][i] = siluf_(val[X][i]);
    }
    {   float sq = 0.f, sk = 0.f;
#pragma unroll
        for (int i = 0; i < 16; ++i) { sq += val[0][i] * val[0][i]; sk += val[1][i] * val[1][i]; }
        sq += __shfl_xor(sq, 1); sq += __shfl_xor(sq, 2); sq += __shfl_xor(sq, 4);
        sk += __shfl_xor(sk, 1); sk += __shfl_xor(sk, 2); sk += __shfl_xor(sk, 4);
        const float rq = (1.0f / sqrtf(sq + 1e-6f)) * 0.08838834764831845f, rk = 1.0f / sqrtf(sk + 1e-6f);
#pragma unroll
        for (int i = 0; i < 16; ++i) { val[0][i] *= rq; val[1][i] *= rk; }
    }
    LAS float* SG = (LAS float*)(lds + SG_OFF); LAS float* SB = (LAS float*)(lds + SB_OFF); LAS float* GC = (LAS float*)(lds + GC_OFF);
    if (cgp == 0) { const float ab = ba_b, aa = ba_a;
        const float xx = aa + p.dt_bias[l * 8 + hh]; const float sp = xx > 20.f ? xx : __logf(1.0f + __expf(xx));
        SG[r] = -expf(p.a_log[l * 8 + hh]) * sp; SB[r] = 1.0f / (1.0f + expf(-ab)); }
    lds_barrier();
    if (wave == 0) { float xg = SG[lane];
#pragma unroll
        for (int o = 1; o < 64; o <<= 1) { const float y = __shfl_up(xg, o); if (lane >= o) xg += y; }
        GC[lane] = xg; }
    lds_barrier();
    {   const float bta = SB[r], gcr = GC[r], glast = GC[63], eg = expf(gcr), ekd = expf(glast - gcr);
        float tq[16], tk[16], tkb[16];
#pragma unroll
        for (int i = 0; i < 16; ++i) { tq[i] = val[0][i]; tk[i] = val[1][i]; tkb[i] = val[1][i] * bta; }
        *(LAS u32x4*)(lds + K_OFF + (r * 136 + 16 * cgp) * 2) = pack8(tk); *(LAS u32x4*)(lds + K_OFF + (r * 136 + 16 * cgp + 8) * 2) = pack8(tk + 8);
        *(LAS u32x4*)(lds + KB_OFF + (r * 136 + 16 * cgp) * 2) = pack8(tkb); *(LAS u32x4*)(lds + KB_OFF + (r * 136 + 16 * cgp + 8) * 2) = pack8(tkb + 8);
        *(LAS u32x4*)(lds + Q_OFF + (r * 136 + 16 * cgp) * 2) = pack8(tq); *(LAS u32x4*)(lds + Q_OFF + (r * 136 + 16 * cgp + 8) * 2) = pack8(tq + 8);
#pragma unroll
        for (int i = 0; i < 16; ++i) { const int e = 16 * cgp + i;
            const int rs = (((r >> 3) ^ cgp) << 3) + (r & 7);
            *(LAS bf16_t*)(lds + VBT_OFF + (e * 72 + rs) * 2) = f2bf(val[2][i] * bta);
            *(LAS bf16_t*)(lds + KBGT_OFF + (e * 72 + rs) * 2) = f2bf(tkb[i] * eg);
            *(LAS bf16_t*)(lds + KDT_OFF + (e * 72 + rs) * 2) = f2bf(tk[i] * ekd); }
        if (tid == 0) ((float*)(wsp + G_GL))[ub] = expf(glast);
    }
    lds_barrier();
    LAS float* Lm = (LAS float*)(lds + L_OFF);
#pragma unroll
    for (int tt = 0; tt < 2; ++tt) { const int id = 2 * wave + tt, mi = id >> 2, ni = id & 3;
        f32x4 aK = {0.f, 0.f, 0.f, 0.f}, aA = {0.f, 0.f, 0.f, 0.f};
#pragma unroll
        for (int ks = 0; ks < 4; ++ks) { const bf16x8 kf = lds_frag(lds + K_OFF, 16 * ni + l15, 136, 32 * ks + 8 * quad);
            const bf16x8 kbf = lds_frag(lds + KB_OFF, 16 * mi + l15, 136, 32 * ks + 8 * quad), qf = lds_frag(lds + Q_OFF, 16 * mi + l15, 136, 32 * ks + 8 * quad);
            aK = mfma16(kbf, kf, aK);
            aA = mfma16(kf, qf, aA); }
        { const int s = 16 * ni + l15; const float gs = GC[s];
#pragma unroll
            for (int j = 0; j < 4; ++j) { const int c = 16 * mi + 4 * quad + j; Lm[c * 68 + s] = (c > s) ? aK[j] * expf(GC[c] - gs) : 0.f; } }
        { const int c = 16 * mi + l15; const float gcc = GC[c]; float o[4];
#pragma unroll
            for (int j = 0; j < 4; ++j) { const int s = 16 * ni + 4 * quad + j; o[j] = (c >= s) ? aA[j] * expf(gcc - GC[s]) : 0.f; }
            u32x2 w; w.x = pk2(o[0], o[1]); w.y = pk2(o[2], o[3]);
            *(LAS u32x2*)(lds + ATTI_OFF + (c * 72 + 16 * ni + 4 * quad) * 2) = w; }
    }
    lds_barrier();
    if (wave == 0) {
        float Tc[64];
        int zoff; asm volatile("v_mov_b32 %0, 0" : "=v"(zoff));
        const LAS float* Lz = Lm + zoff;
#pragma unroll
        for (int i = 0; i < 64; ++i) { float a = (lane == i) ? 1.f : 0.f;
#pragma unroll
            for (int j4 = 0; j4 < (i + 3) / 4; ++j4) { const f32x4 lv = *(const LAS f32x4*)(Lz + i * 68 + 4 * j4);
#pragma unroll
                for (int jj = 0; jj < 4; ++jj) if (4 * j4 + jj < i) a -= lv[jj] * Tc[4 * j4 + jj]; }
            Tc[i] = a; if ((i & 3) == 3) asm volatile("" ::: "memory"); }
#pragma unroll
        for (int i = 0; i < 64; ++i) *(LAS bf16_t*)(lds + T_OFF + (i * 72 + lane) * 2) = f2bf(Tc[i]);
    }
    lds_barrier();
    {   bf16x8 vf[2], gf[2];
#pragma unroll
        for (int ks = 0; ks < 2; ++ks) { vf[ks] = lds_frag(lds + VBT_OFF, 16 * wave + l15, 72, 8 * ((4 * ks + quad) ^ wave)); gf[ks] = lds_frag(lds + KBGT_OFF, 16 * wave + l15, 72, 8 * ((4 * ks + quad) ^ wave)); }
#pragma unroll
        for (int mi = 0; mi < 4; ++mi) { f32x4 aU = {0.f, 0.f, 0.f, 0.f}, aW = {0.f, 0.f, 0.f, 0.f};
#pragma unroll
            for (int ks = 0; ks < 2; ++ks) { const bf16x8 tf = lds_frag(lds + T_OFF, 16 * mi + l15, 72, 32 * ks + 8 * quad);
                aU = mfma16(tf, vf[ks], aU); aW = mfma16(tf, gf[ks], aW); }
            u32x2 wu; wu.x = pk2(aU[0], aU[1]); wu.y = pk2(aU[2], aU[3]);
            u32x2 ww; ww.x = pk2(aW[0], aW[1]); ww.y = pk2(aW[2], aW[3]);
            *(LAS u32x2*)(lds + UT_OFF + ((16 * wave + l15) * 64 + 16 * mi + 4 * quad) * 2) = wu;
            *(LAS u32x2*)(lds + WT_OFF + ((16 * wave + l15) * 64 + 16 * mi + 4 * quad) * 2) = ww; }
    }
    lds_barrier();
    {   bf16x8 kdf[2], wtf[2], utf[2];
#pragma unroll
        for (int ks = 0; ks < 2; ++ks) { kdf[ks] = lds_frag(lds + KDT_OFF, 16 * wave + l15, 72, 8 * ((4 * ks + quad) ^ wave));
            wtf[ks] = lds_frag(lds + WT_OFF, 16 * wave + l15, 64, 32 * ks + 8 * quad); utf[ks] = lds_frag(lds + UT_OFF, 16 * wave + l15, 64, 32 * ks + 8 * quad); }
        bf16_t* GA = (bf16_t*)(wsp + G_A) + ub * 16384; bf16_t* GB = (bf16_t*)(wsp + G_BT) + ub * 16384;
        bf16_t* GCp = (bf16_t*)(wsp + G_C) + ub * 8192; bf16_t* GD = (bf16_t*)(wsp + G_D) + ub * 8192;
#pragma unroll
        for (int t2 = 0; t2 < 8; ++t2) {
            f32x4 aA = {0.f, 0.f, 0.f, 0.f}, aB = {0.f, 0.f, 0.f, 0.f};
#pragma unroll
            for (int ks = 0; ks < 2; ++ks) { const bf16x8 wx = lds_frag(lds + WT_OFF, 16 * t2 + l15, 64, 32 * ks + 8 * quad), kx = lds_frag(lds + KDT_OFF, 16 * t2 + l15, 72, 8 * ((4 * ks + quad) ^ t2));
                aA = mfma16(wx, kdf[ks], aA);
                aB = mfma16(kx, utf[ks], aB); }
            u32x2 wa; wa.x = pk2(-aA[0], -aA[1]); wa.y = pk2(-aA[2], -aA[3]);
            *(u32x2*)(GA + ((wave * 4 + (t2 >> 1)) * 64 + (2 * (t2 & 1) + (quad >> 1)) * 16 + l15) * 8 + 4 * (quad & 1)) = wa;
            u32x2 wb; wb.x = pk2(aB[0], aB[1]); wb.y = pk2(aB[2], aB[3]);
            *(u32x2*)(GB + ((((wave >> 1) * 8 + t2) * 64 + quad * 16 + l15) * 2 + (wave & 1)) * 4) = wb; }
#pragma unroll
        for (int mi = 0; mi < 4; ++mi) {
            f32x4 aC = {0.f, 0.f, 0.f, 0.f}, aD = {0.f, 0.f, 0.f, 0.f};
#pragma unroll
            for (int ks = 0; ks < 2; ++ks) { const bf16x8 af = lds_frag(lds + ATTI_OFF, 16 * mi + l15, 72, 32 * ks + 8 * quad);
                aC = mfma16(wtf[ks], af, aC);
                aD = mfma16(utf[ks], af, aD); }
            const int c = 16 * mi + l15; const float egc = expf(GC[c]);
            const u32x2 qw = *(const LAS u32x2*)(lds + Q_OFF + (c * 136 + 16 * wave + 4 * quad) * 2);
            u32x2 wc; wc.x = pk2(bf_lo(qw.x) * egc - aC[0], bf_hi(qw.x) * egc - aC[1]); wc.y = pk2(bf_lo(qw.y) * egc - aC[2], bf_hi(qw.y) * egc - aC[3]);
            *(u32x2*)(GCp + ((mi * 4 + (wave >> 1)) * 64 + (2 * (wave & 1) + (quad >> 1)) * 16 + l15) * 8 + 4 * (quad & 1)) = wc;
            u32x2 wd; wd.x = pk2(aD[0], aD[1]); wd.y = pk2(aD[2], aD[3]);
            *(u32x2*)(GD + ((wave * 4 + mi) * 64 + quad * 16 + l15) * 4) = wd; }
    }
    lds_barrier();
}

DI void ret_prep_unit(const Params& p, unsigned char* wsp, int hr, int n, LAS unsigned char* lds, int tid) {
    asm volatile("" : "+v"(tid));
    const int lane = tid & 63, wave = tid >> 6, quad = lane >> 4, l15 = lane & 15;
    const int r = tid >> 3, cgp = tid & 7, t = 64 * n + r;
    constexpr int RQ_OFF = 0, RK_OFF = 17408, KTT_OFF = 34816, VT_OFF = 53248;
    const bf16_t* PROJ = (const bf16_t*)(wsp + WS_PROJ);
    const size_t ub = (size_t)hr * 128 + n;
    const float lg2 = ret_lg2(hr);
    const float xi = exp2f((float)(r + 1) * lg2), zeta = exp2f((float)(63 - r) * lg2);
    const float posf = (float)p.pos[t];
    {   const bf16_t* pq = PROJ + (size_t)t * PROJ_LD + 4096 + hr * 128 + 8 * cgp; const bf16_t* pk = PROJ + (size_t)t * PROJ_LD + 4608 + hr * 128 + 8 * cgp;
        float q1[8], q2[8], k1[8], k2[8];
        unpack8(*(const u32x4*)pq, q1); unpack8(*(const u32x4*)(pq + 64), q2); unpack8(*(const u32x4*)pk, k1); unpack8(*(const u32x4*)(pk + 64), k2);
        float rq1[8], rq2[8], rk1[8], rk2[8];
#pragma unroll
        for (int ii = 0; ii < 8; ++ii) { const int i = 8 * cgp + ii;
            const float invf = expf(-(float)i * (9.210340371976184f / 64.0f)); const float ang = posf * invf; const float trev = ang * 0.15915494309189535f; const float fr = trev - rintf(trev);
            const float cs = __builtin_amdgcn_cosf(fr), sn = __builtin_amdgcn_sinf(fr);
            rq1[ii] = q1[ii] * cs - q2[ii] * sn; rq2[ii] = q1[ii] * sn + q2[ii] * cs;
            rk1[ii] = (k1[ii] * cs - k2[ii] * sn) * 0.08838834764831845f; rk2[ii] = (k1[ii] * sn + k2[ii] * cs) * 0.08838834764831845f; }
        *(LAS u32x4*)(lds + RQ_OFF + (r * 136 + 8 * cgp) * 2) = pack8(rq1); *(LAS u32x4*)(lds + RQ_OFF + (r * 136 + 64 + 8 * cgp) * 2) = pack8(rq2);
        *(LAS u32x4*)(lds + RK_OFF + (r * 136 + 8 * cgp) * 2) = pack8(rk1); *(LAS u32x4*)(lds + RK_OFF + (r * 136 + 64 + 8 * cgp) * 2) = pack8(rk2);
#pragma unroll
        for (int ii = 0; ii < 8; ++ii) { *(LAS bf16_t*)(lds + KTT_OFF + ((8 * cgp + ii) * 72 + r) * 2) = f2bf(rk1[ii] * zeta); *(LAS bf16_t*)(lds + KTT_OFF + ((64 + 8 * cgp + ii) * 72 + r) * 2) = f2bf(rk2[ii] * zeta);
            rq1[ii] *= xi; rq2[ii] *= xi; }
        bf16_t* QI = (bf16_t*)(wsp + R_QI) + ub * 8192 + (size_t)((((r >> 4) * 4 + (cgp >> 2)) * 64 + (cgp & 3) * 16 + (r & 15)) * 8);
        *(u32x4*)QI = pack8(rq1); *(u32x4*)(QI + 2 * 512) = pack8(rq2);
    }
    {   const bf16_t* pv = PROJ + (size_t)t * PROJ_LD + 5120 + hr * 256 + 32 * cgp;
#pragma unroll
        for (int q = 0; q < 4; ++q) { float vv[8]; unpack8(*(const u32x4*)(pv + 8 * q), vv);
#pragma unroll
            for (int i = 0; i < 8; ++i) *(LAS bf16_t*)(lds + VT_OFF + ((32 * cgp + 8 * q + i) * 72 + r) * 2) = f2bf(vv[i]); }
    }
    lds_barrier();
#pragma unroll
    for (int tt = 0; tt < 2; ++tt) { const int id = 2 * wave + tt, mi = id >> 2, ni = id & 3;
        f32x4 aA = {0.f, 0.f, 0.f, 0.f};
#pragma unroll
        for (int ks = 0; ks < 4; ++ks) { const bf16x8 kf = lds_frag(lds + RK_OFF, 16 * ni + l15, 136, 32 * ks + 8 * quad), qf = lds_frag(lds + RQ_OFF, 16 * mi + l15, 136, 32 * ks + 8 * quad);
            aA = mfma16(kf, qf, aA); }
        const int c = 16 * mi + l15; float o[4];
#pragma unroll
        for (int j = 0; j < 4; ++j) { const int s = 16 * ni + 4 * quad + j; o[j] = (c >= s) ? aA[j] * exp2f((float)(c - s) * lg2) : 0.f; }
        u32x2 w; w.x = pk2(o[0], o[1]); w.y = pk2(o[2], o[3]);
        *(u32x2*)((bf16_t*)(wsp + R_SC) + ub * 4096 + ((mi * 2 + (ni >> 1)) * 64 + (2 * (ni & 1) + (quad >> 1)) * 16 + l15) * 8 + 4 * (quad & 1)) = w; }
    {
        bf16x8 kf[2];
#pragma unroll
        for (int ks = 0; ks < 2; ++ks) kf[ks] = lds_frag(lds + KTT_OFF, 16 * wave + l15, 72, 32 * ks + 8 * quad);
        float* PT = (float*)(wsp + R_P) + ub * 32768;
#pragma unroll 4
        for (int et = 0; et < 16; ++et) { f32x4 a = {0.f, 0.f, 0.f, 0.f};
#pragma unroll
            for (int ks = 0; ks < 2; ++ks) a = mfma16(kf[ks], lds_frag(lds + VT_OFF, 16 * et + l15, 72, 32 * ks + 8 * quad), a);
            *(f32x4*)(PT + ((et * 4 + (wave >> 1)) * 64 + (2 * (wave & 1) + (quad >> 1)) * 16 + l15) * 8 + 4 * (quad & 1)) = a; }
    }
#pragma unroll
    for (int i = 0; i < 4; ++i) { const int id = tid + 512 * i, blk = id >> 6, row = 16 * (blk >> 1) + (id & 15), chn = 4 * (blk & 1) + ((id >> 4) & 3);
        *(u32x4*)((bf16_t*)(wsp + R_VT) + ub * 16384 + (size_t)id * 8) = *(const LAS u32x4*)(lds + VT_OFF + (row * 72 + 8 * chn) * 2); }
    lds_barrier();
}

struct SFrag { bf16x8 af[4]; u32x2 bt[2]; };
DI void sfrag_load(SFrag& f, const unsigned char* ws, int hh, int es, int n, int wave, int quad, int l15) {
    const size_t ub = (size_t)hh * 128 + n;
    const int lane = quad * 16 + l15;
    const bf16_t* Ap = (const bf16_t*)(ws + G_A) + ub * 16384 + (size_t)(wave * 4) * 512 + lane * 8;
    const bf16_t* Bp = (const bf16_t*)(ws + G_BT) + ub * 16384 + (size_t)((es * 8 + wave) * 64 + lane) * 8;
#pragma unroll
    for (int ks = 0; ks < 4; ++ks) f.af[ks] = *(const bf16x8*)(Ap + ks * 512);
    {   const u32x4 b4 = *(const u32x4*)Bp; f.bt[0] = (u32x2){b4.x, b4.y}; f.bt[1] = (u32x2){b4.z, b4.w}; }
}
DI void gdn_chain(const Params& p, unsigned char* wsp, int l, int hh, int es, LAS unsigned char* lds, int tid) {
    asm volatile("" : "+v"(tid));
    const int lane = tid & 63, wave = tid >> 6, quad = lane >> 4, l15 = lane & 15;
    constexpr int ST_BYTES = 8704;
    for (int i = tid; i < 2 * ST_BYTES / 4; i += NTHR) ((LAS unsigned*)lds)[i] = 0u;
    LAS float* GLs = (LAS float*)(lds + 2 * ST_BYTES);
    if (tid < 128) GLs[tid] = ((const float*)(wsp + G_GL))[hh * 128 + tid];
    f32x4 Sacc[2] = {{0.f, 0.f, 0.f, 0.f}, {0.f, 0.f, 0.f, 0.f}};
    bf16_t* SG = (bf16_t*)(wsp + G_S) + ((size_t)hh * 128) * 16384 + (size_t)(((2 * es + (wave >> 2)) * 4 + (wave & 3)) * 64 + lane) * 8;
    const int srd = ((16 * (wave >> 2) + l15) * 136 + 32 * (wave & 3) + 8 * quad) * 2;
    SFrag f0, f1, f2, f3, f4, f5, f6;
#define CFENCE() asm volatile("" ::: "memory")
    sfrag_load(f0, wsp, hh, es, 0, wave, quad, l15); CFENCE(); sfrag_load(f1, wsp, hh, es, 1, wave, quad, l15); CFENCE(); sfrag_load(f2, wsp, hh, es, 2, wave, quad, l15); CFENCE();
    sfrag_load(f3, wsp, hh, es, 3, wave, quad, l15); CFENCE(); sfrag_load(f4, wsp, hh, es, 4, wave, quad, l15); CFENCE(); sfrag_load(f5, wsp, hh, es, 5, wave, quad, l15); CFENCE();
#undef CFENCE
    lds_barrier();
#define S_STEP(cur, n) do { \
        LAS unsigned char* sc = lds + ((n) & 1) * ST_BYTES; LAS unsigned char* sn = lds + (((n) + 1) & 1) * ST_BYTES; \
        const float glv = GLs[(n)]; \
        bf16x8 sfr[2][4]; \
        _Pragma("unroll") for (int et = 0; et < 2; ++et) _Pragma("unroll") for (int ks = 0; ks < 4; ++ks) sfr[et][ks] = lds_frag(sc, 16 * et + l15, 136, 32 * ks + 8 * quad);     \
        *(u32x4*)(SG + (size_t)(n) * 16384) = *(const LAS u32x4*)(sc + srd);                  \
        _Pragma("unroll") for (int et = 0; et < 2; ++et) { \
            f32x4 a; a[0] = Sacc[et][0] * glv + bf_lo(cur.bt[et].x); a[1] = Sacc[et][1] * glv + bf_hi(cur.bt[et].x); a[2] = Sacc[et][2] * glv + bf_lo(cur.bt[et].y); a[3] = Sacc[et][3] * glv + bf_hi(cur.bt[et].y); \
            _Pragma("unroll") for (int ks = 0; ks < 4; ++ks) a = mfma16(cur.af[ks], sfr[et][ks], a);     \
            Sacc[et] = a; \
            u32x2 w; w.x = pk2(a[0], a[1]); w.y = pk2(a[2], a[3]); \
            *(LAS u32x2*)(sn + ((16 * et + l15) * 136 + 16 * wave + 4 * quad) * 2) = w; } \
        lds_barrier(); } while (0)
#define S_LOAD(f, n) sfrag_load(f, wsp, hh, es, (n) < 128 ? (n) : 127, wave, quad, l15)
    for (int n = 0; n < 126; n += 7) {
        S_LOAD(f6, n + 6);  S_STEP(f0, n);
        S_LOAD(f0, n + 7);  S_STEP(f1, n + 1);
        S_LOAD(f1, n + 8);  S_STEP(f2, n + 2);
        S_LOAD(f2, n + 9);  S_STEP(f3, n + 3);
        S_LOAD(f3, n + 10); S_STEP(f4, n + 4);
        S_LOAD(f4, n + 11); S_STEP(f5, n + 5);
        S_LOAD(f5, n + 12); S_STEP(f6, n + 6);
    }
    S_STEP(f0, 126); S_STEP(f1, 127);
#undef S_STEP
#undef S_LOAD
}

DI void ret_scan(unsigned char* wsp, int sb, int tid) {
    const int idx = sb * NTHR + tid;
    const int hr = idx >> 13, off = (idx & 8191) * 4;
    const float cd = exp2f(64.0f * ret_lg2(hr));
    const float* P = (const float*)(wsp + R_P) + (size_t)hr * 128 * 32768 + off;
    bf16_t* RT = (bf16_t*)(wsp + R_RT) + (size_t)hr * 128 * 32768 + off;
    f32x4 R = {0.f, 0.f, 0.f, 0.f};
    for (int n0 = 0; n0 < 128; n0 += 16) {
        f32x4 pv[16];
#pragma unroll
        for (int i = 0; i < 16; ++i) pv[i] = *(const f32x4*)(P + (size_t)(n0 + i) * 32768);
#pragma unroll
        for (int i = 0; i < 16; ++i) { u32x2 w; w.x = pk2(R[0], R[1]); w.y = pk2(R[2], R[3]); *(u32x2*)(RT + (size_t)(n0 + i) * 32768) = w; R = R * cd + pv[i]; }
    }
}

DI void gdn_out_unit(const Params& p, unsigned char* wsp, int l, int hh, int n, LAS unsigned char* lds, int tid) {
    asm volatile("" : "+v"(tid));
    const int lane = tid & 63, wave = tid >> 6, quad = lane >> 4, l15 = lane & 15;
    const size_t ub = (size_t)hh * 128 + n;
    const bf16_t* Sp = (const bf16_t*)(wsp + G_S) + ub * 16384 + (size_t)(wave * 4) * 512 + lane * 8;
    const bf16_t* Cp = (const bf16_t*)(wsp + G_C) + ub * 8192 + lane * 8;
    const bf16_t* Dp = (const bf16_t*)(wsp + G_D) + ub * 8192 + (size_t)((wave * 4) * 64 + lane) * 4;
    bf16x8 sf[4]; f32x4 acc[4];
    const int e0 = 16 * wave + 4 * quad;
    const bf16_t* PROJ = (const bf16_t*)(wsp + WS_PROJ);
    u32x2 zwv[4];
#pragma unroll
    for (int mi = 0; mi < 4; ++mi) zwv[mi] = *(const u32x2*)(PROJ + (size_t)(64 * n + 16 * mi + l15) * PROJ_LD + 3072 + hh * 128 + e0);
    const f32x4 nw = *(const f32x4*)(p.gdn_norm_w + l * 128 + e0);
#pragma unroll
    for (int ks = 0; ks < 4; ++ks) sf[ks] = *(const bf16x8*)(Sp + ks * 512);
#pragma unroll
    for (int mi = 0; mi < 4; ++mi) { const u32x2 dw = *(const u32x2*)(Dp + mi * 256);
        f32x4 a; a[0] = bf_lo(dw.x); a[1] = bf_hi(dw.x); a[2] = bf_lo(dw.y); a[3] = bf_hi(dw.y);
#pragma unroll
        for (int ks = 0; ks < 4; ++ks) a = mfma16(sf[ks], *(const bf16x8*)(Cp + (mi * 4 + ks) * 512), a);
        acc[mi] = a; }
    LAS float* red = (LAS float*)lds;
#pragma unroll
    for (int mi = 0; mi < 4; ++mi) { float s = (acc[mi][0] * acc[mi][0] + acc[mi][1] * acc[mi][1]) + (acc[mi][2] * acc[mi][2] + acc[mi][3] * acc[mi][3]);
        s += __shfl_xor(s, 16); s += __shfl_xor(s, 32);
        if (quad == 0) red[wave * 64 + 16 * mi + l15] = s; }
    lds_barrier();
    bf16_t* ACTA = (bf16_t*)(wsp + WS_ACT);
#pragma unroll
    for (int mi = 0; mi < 4; ++mi) { const int c = 16 * mi + l15; float tot = 0.f;
#pragma unroll
        for (int w8 = 0; w8 < 8; ++w8) tot += red[w8 * 64 + c];
        const float rs = 1.0f / sqrtf(tot * (1.0f / 128.0f) + EPS);
        const size_t t = (size_t)(64 * n + c);
        const u32x2 zw = zwv[mi];
        u32x2 o; o.x = pk2(acc[mi][0] * rs * nw[0] * siluf_(bf_lo(zw.x)), acc[mi][1] * rs * nw[1] * siluf_(bf_hi(zw.x)));
        o.y = pk2(acc[mi][2] * rs * nw[2] * siluf_(bf_lo(zw.y)), acc[mi][3] * rs * nw[3] * siluf_(bf_hi(zw.y)));
        *(u32x2*)(ACTA + t * 1024 + hh * 128 + e0) = o; }
    lds_barrier();
}
DI void ret_out_unit(const Params& p, unsigned char* wsp, int hr, int n, LAS unsigned char* lds, int tid) {
    asm volatile("" : "+v"(tid));
    const int lane = tid & 63, wave = tid >> 6, quad = lane >> 4, l15 = lane & 15;
    const size_t ub = (size_t)hr * 128 + n;
    const bf16_t* Qp = (const bf16_t*)(wsp + R_QI) + ub * 8192 + lane * 8;
    const bf16_t* Sp = (const bf16_t*)(wsp + R_SC) + ub * 4096 + lane * 8;
    const bf16_t* PROJ = (const bf16_t*)(wsp + WS_PROJ);
    u32x2 bgw[2][4];
#pragma unroll
    for (int tt = 0; tt < 2; ++tt)
#pragma unroll
        for (int mi = 0; mi < 4; ++mi) bgw[tt][mi] = *(const u32x2*)(PROJ + (size_t)(64 * n + 16 * mi + l15) * PROJ_LD + 6144 + hr * 256 + 16 * (2 * wave + tt) + 4 * quad);
    f32x4 acc[2][4];
#pragma unroll
    for (int tt = 0; tt < 2; ++tt) { const int et = 2 * wave + tt;
        const bf16_t* Rp = (const bf16_t*)(wsp + R_RT) + ub * 32768 + (size_t)(et * 4) * 512 + lane * 8;
        const bf16_t* Vp = (const bf16_t*)(wsp + R_VT) + ub * 16384 + (size_t)(et * 2) * 512 + lane * 8;
        bf16x8 rf[4], vf[2];
#pragma unroll
        for (int ks = 0; ks < 4; ++ks) rf[ks] = *(const bf16x8*)(Rp + ks * 512);
#pragma unroll
        for (int ks = 0; ks < 2; ++ks) vf[ks] = *(const bf16x8*)(Vp + ks * 512);
#pragma unroll
        for (int mi = 0; mi < 4; ++mi) { f32x4 a = {0.f, 0.f, 0.f, 0.f};
#pragma unroll
            for (int ks = 0; ks < 4; ++ks) a = mfma16(rf[ks], *(const bf16x8*)(Qp + (mi * 4 + ks) * 512), a);
#pragma unroll
            for (int ks = 0; ks < 2; ++ks) a = mfma16(vf[ks], *(const bf16x8*)(Sp + (mi * 2 + ks) * 512), a);
            acc[tt][mi] = a; } }
    LAS float* red = (LAS float*)lds;
#pragma unroll
    for (int mi = 0; mi < 4; ++mi) { float s = 0.f, q = 0.f;
#pragma unroll
        for (int tt = 0; tt < 2; ++tt) { const f32x4 a = acc[tt][mi]; s += (a[0] + a[1]) + (a[2] + a[3]); q += (a[0] * a[0] + a[1] * a[1]) + (a[2] * a[2] + a[3] * a[3]); }
        s += __shfl_xor(s, 16); s += __shfl_xor(s, 32); q += __shfl_xor(q, 16); q += __shfl_xor(q, 32);
        if (quad == 0) { red[(wave * 64 + 16 * mi + l15) * 2] = s; red[(wave * 64 + 16 * mi + l15) * 2 + 1] = q; } }
    lds_barrier();
    bf16_t* ACTB = (bf16_t*)(wsp + WS_ACT) + (size_t)T_ * 1024;
#pragma unroll
    for (int mi = 0; mi < 4; ++mi) { const int c = 16 * mi + l15; float S = 0.f, Q = 0.f;
#pragma unroll
        for (int w8 = 0; w8 < 8; ++w8) { S += red[(w8 * 64 + c) * 2]; Q += red[(w8 * 64 + c) * 2 + 1]; }
        const float mu = S * (1.0f / 256.0f), var = fmaxf(Q * (1.0f / 256.0f) - mu * mu, 0.f), rs = 1.0f / sqrtf(var + 1e-5f);
#pragma unroll
        for (int tt = 0; tt < 2; ++tt) { const f32x4 a = acc[tt][mi]; const u32x2 g = bgw[tt][mi];
            u32x2 o; o.x = pk2((a[0] - mu) * rs * siluf_(bf_lo(g.x)), (a[1] - mu) * rs * siluf_(bf_hi(g.x))); o.y = pk2((a[2] - mu) * rs * siluf_(bf_lo(g.y)), (a[3] - mu) * rs * siluf_(bf_hi(g.y)));
            *(u32x2*)(ACTB + (size_t)(64 * n + c) * 1024 + hr * 256 + 16 * (2 * wave + tt) + 4 * quad) = o; } }
    lds_barrier();
}

DI void sub_barrier(unsigned* cnt, unsigned target) {
    asm volatile("s_waitcnt vmcnt(0)" ::: "memory");
    __syncthreads();
    if (threadIdx.x == 0) {
        __builtin_amdgcn_fence(__ATOMIC_RELEASE, "agent");
        asm volatile("s_waitcnt vmcnt(0)" ::: "memory");
        (void)__hip_atomic_fetch_add(cnt, 1u, __ATOMIC_RELAXED, __HIP_MEMORY_SCOPE_AGENT);
        unsigned sp = 0;
        while (__hip_atomic_load(cnt, __ATOMIC_RELAXED, __HIP_MEMORY_SCOPE_AGENT) < target) { __builtin_amdgcn_s_sleep(24); if (++sp > (1u << 20)) break; }
        __builtin_amdgcn_fence(__ATOMIC_ACQUIRE, "agent");
        asm volatile("s_waitcnt vmcnt(0)" ::: "memory");
    }
    __syncthreads();
}

DI void conv_unit(const Params& p, unsigned char* wsp, int l, int u, LAS unsigned char* lds, int tid) {
    asm volatile("" : "+v"(tid));
    const int tt = u >> 2, cs = u & 3, t0 = 64 * tt;
    const bf16_t* PROJ = (const bf16_t*)(wsp + WS_PROJ);
    LAS float* Ug = (LAS float*)lds;
    {   const int c8 = tid & 31, rg = tid >> 5;
        u32x4 ga[6], gg[6];
#pragma unroll
        for (int i = 0; i < 6; ++i) { const int rr = rg + 16 * i, t = t0 - 30 + rr; ga[i] = (u32x4){0u, 0u, 0u, 0u}; gg[i] = (u32x4){0u, 0u, 0u, 0u};
            if (rr < 94 && t >= 0) { ga[i] = *(const u32x4*)(PROJ + (size_t)t * PROJ_LD + 7168 + 256 * cs + 8 * c8); gg[i] = *(const u32x4*)(PROJ + (size_t)t * PROJ_LD + 8192 + 256 * cs + 8 * c8); } }
#pragma unroll
        for (int i = 0; i < 6; ++i) { const int rr = rg + 16 * i;
            if (rr < 94) { float a[8], g[8], o[8]; unpack8(ga[i], a); unpack8(gg[i], g);
#pragma unroll
                for (int q = 0; q < 8; ++q) o[q] = a[q] * sigmoidf_(g[q]);
                *(LAS f32x4*)(Ug + rr * 256 + 8 * c8) = (f32x4){o[0], o[1], o[2], o[3]}; *(LAS f32x4*)(Ug + rr * 256 + 8 * c8 + 4) = (f32x4){o[4], o[5], o[6], o[7]}; } }
    }
    lds_barrier();
    {   const int ch = tid & 255, half = tid >> 8, cg_ = 256 * cs + ch;
        float w[31];
#pragma unroll
        for (int j = 0; j < 31; ++j) w[j] = p.conv_dw_w[((size_t)l * 31 + j) * 1024 + cg_];
        const float bias = p.conv_dw_b[l * 1024 + cg_];
        float* CV = (float*)(wsp + WS_CV);
        for (int tl = 32 * half; tl < 32 * half + 32; ++tl) { float a = bias;
#pragma unroll
            for (int j = 0; j < 31; ++j) a += w[j] * Ug[(tl + j) * 256 + ch];
            CV[(size_t)(t0 + tl) * 1024 + cg_] = a; }
    }
    lds_barrier();
}

DI void phase_post(const Params& p, unsigned char* wsp, int l, int tid, const int mask, const int b0, const int nblk) {
    const int lane = tid & 63, wave = tid >> 6, gw = ((int)blockIdx.x - b0) * 8 + wave, NGW = nblk * 8;
    const bf16_t* PROJ = (const bf16_t*)(wsp + WS_PROJ);
    const float* OA = (const float*)(wsp + WS_OA); const float* OB = (const float*)(wsp + WS_OB); const float* CV = (const float*)(wsp + WS_CV);
    bf16_t* ACTA = (bf16_t*)(wsp + WS_ACT); bf16_t* ACTB = ACTA + (size_t)T_ * 1024; bf16_t* ACTC = ACTB + (size_t)T_ * 1024;
    for (int t = gw; t < T_; t += NGW) {
        if (mask & 1)
#pragma unroll
        for (int hh = 0; hh < 8; ++hh) { const int cc = hh * 128 + 2 * lane;
            const float o0 = OA[(size_t)t * 1024 + cc], o1 = OA[(size_t)t * 1024 + cc + 1];
            const float ss = wave_sum(o0 * o0 + o1 * o1); const float rs = 1.0f / sqrtf(ss * (1.0f / 128.0f) + EPS);
            const unsigned zw = *(const unsigned*)(PROJ + (size_t)t * PROJ_LD + 3072 + cc);
            const float w0 = p.gdn_norm_w[l * 128 + 2 * lane], w1 = p.gdn_norm_w[l * 128 + 2 * lane + 1];
            *(unsigned*)(ACTA + (size_t)t * 1024 + cc) = pk2(o0 * rs * w0 * siluf_(bf_lo(zw)), o1 * rs * w1 * siluf_(bf_hi(zw))); }
        if (mask & 2)
#pragma unroll
        for (int hr = 0; hr < 4; ++hr) { const int cc = hr * 256 + 4 * lane;
            const f32x4 o = *(const f32x4*)(OB + (size_t)t * 1024 + cc);
            const float mu = wave_sum((o[0] + o[1]) + (o[2] + o[3])) * (1.0f / 256.0f);
            const f32x4 d = o - mu; const float var = wave_sum((d[0] * d[0] + d[1] * d[1]) + (d[2] * d[2] + d[3] * d[3])) * (1.0f / 256.0f);
            const float rs = 1.0f / sqrtf(var + 1e-5f);
            const u32x2 gwd = *(const u32x2*)(PROJ + (size_t)t * PROJ_LD + 6144 + cc);
            u32x2 w; w.x = pk2(d[0] * rs * siluf_(bf_lo(gwd.x)), d[1] * rs * siluf_(bf_hi(gwd.x))); w.y = pk2(d[2] * rs * siluf_(bf_lo(gwd.y)), d[3] * rs * siluf_(bf_hi(gwd.y)));
            *(u32x2*)(ACTB + (size_t)t * 1024 + cc) = w; }
        if (mask & 4)
        {   f32x4 v[4]; float s = 0.f;
#pragma unroll
            for (int j = 0; j < 4; ++j) { v[j] = *(const f32x4*)(CV + (size_t)t * 1024 + (j * 64 + lane) * 4); s += (v[j][0] + v[j][1]) + (v[j][2] + v[j][3]); }
            const float mu = wave_sum(s) * (1.0f / 1024.0f); float q = 0.f;
#pragma unroll
            for (int j = 0; j < 4; ++j) { v[j] = v[j] - mu; q += (v[j][0] * v[j][0] + v[j][1] * v[j][1]) + (v[j][2] * v[j][2] + v[j][3] * v[j][3]); }
            const float rs = 1.0f / sqrtf(wave_sum(q) * (1.0f / 1024.0f) + 1e-5f);
#pragma unroll
            for (int j = 0; j < 4; ++j) { const int cc = (j * 64 + lane) * 4; const f32x4 lw = *(const f32x4*)(p.conv_ln_w + l * 1024 + cc), lb = *(const f32x4*)(p.conv_ln_b + l * 1024 + cc);
                const f32x4 y = v[j] * rs * lw + lb;
                u32x2 w; w.x = pk2(siluf_(y[0]), siluf_(y[1])); w.y = pk2(siluf_(y[2]), siluf_(y[3]));
                *(u32x2*)(ACTC + (size_t)t * 1024 + cc) = w; }
        }
    }
}

template <class Epi> DI void run_gemm(LAS unsigned char* lds, const bf16_t* A, const bf16_t* Bt, int N, int K, const Epi& E) {
    Gemm g{A, Bt, T_, N, K}; StaticOrder S; S.init(T_, N, (int)gridDim.x, (int)blockIdx.x);
    gemm_phase<Epi, StaticOrder, false>(lds, g, S, E, nullptr);
}

DI void run_phase(const Params& p, unsigned char* wsp, int ph, LAS unsigned char* lds, int tid) {
    const int G = gridDim.x, b = blockIdx.x;
#ifndef SUBM
#define SUBM 3
#endif
#ifndef PHM
#define PHM 0xFFF
#endif
    if (ph == 0) { if (PHM & 0x400) phase_prep(p, wsp, lds, tid); return; }
    if (ph == 21) { if (PHM & 0x800) phase_norm((const float*)(wsp + WS_XC), p.final_w, nullptr, nullptr, nullptr, p.out, tid); return; }
    const int l = (ph - 1) / 10, sp = (ph - 1) % 10;
    const float* mod = (const float*)(wsp + WS_MOD) + l * 12288;
    const float* xin = (l == 0) ? p.x : (const float*)(wsp + WS_XC);
    float* XC = (float*)(wsp + WS_XC);
    bf16_t* H = (bf16_t*)(wsp + WS_H);
    bf16_t* PROJ = (bf16_t*)(wsp + WS_PROJ);
    const unsigned char* wl = wsp + WS_W + (size_t)l * SZ_WL;
    const bf16_t* WT_IN = (const bf16_t*)wl; const bf16_t* WT_BR = (const bf16_t*)(wl + SZ_WT_IN); const bf16_t* WT_O = (const bf16_t*)(wl + SZ_WT_IN + 3 * SZ_WT_BR);
    const bf16_t* WT_MI = (const bf16_t*)(wl + SZ_WT_IN + 3 * SZ_WT_BR + SZ_WT_O); const bf16_t* WT_MO = (const bf16_t*)(wl + SZ_WT_IN + 3 * SZ_WT_BR + SZ_WT_O + SZ_WT_M);
    switch (sp) {
    case 0: if (PHM & (1<<0)) phase_norm(xin, p.norm_mix_w + l * D_, mod + 2048, mod, H, nullptr, tid); break;
    case 1: if (PHM & (1<<1)) { EpiProj E{PROJ, (float*)(wsp + WS_BA)}; run_gemm(lds, H, WT_IN, NP1, 2048, E); } break;
    case 2: if (PHM & (1<<2)) for (int u = b; u < 1024; u += G) gdn_prep_unit(p, wsp, l, u >> 7, u & 127, lds, tid); break;
    case 3: if (PHM & (1<<3)) {
        if (b < 32) { gdn_chain(p, wsp, l, b >> 2, b & 3, lds, tid); lds_barrier(); }
        else {
            const int nb = b - 32, NB = G - 32; unsigned* cnt = (unsigned*)(wsp + WS_PROG) + 1024;
            for (int u = nb; u < 512; u += NB) ret_prep_unit(p, wsp, u >> 7, u & 127, lds, tid);
            if (NB == 224) { if (nb < 64) conv_unit(p, wsp, l, nb, lds, tid);
                else for (int v = nb; v < 512; v += NB - 64) conv_unit(p, wsp, l, v, lds, tid); }
            else for (int v = nb; v < 512; v += NB) conv_unit(p, wsp, l, v, lds, tid);
            sub_barrier(cnt, (unsigned)(NB * (l + 1)));
            if (nb < 64) ret_scan(wsp, nb, tid);
        }
    } break;
    case 4: if (PHM & (1<<4)) {
        for (int u = b; u < 1536; u += G) { if (u < 1024) gdn_out_unit(p, wsp, l, u >> 7, u & 127, lds, tid); else ret_out_unit(p, wsp, (u - 1024) >> 7, (u - 1024) & 127, lds, tid); }
        phase_post(p, wsp, l, tid, 4, 0, G);
    } break;
    case 5: if (PHM & (1<<5)) { const bf16_t* ACT = (const bf16_t*)(wsp + WS_ACT); float* MF = (float*)(wsp + WS_MF); bf16_t* MB = (bf16_t*)(wsp + WS_MB);
        { EpiBranch<0> E{PROJ, MF, MB}; run_gemm(lds, ACT, WT_BR, 2048, 1024, E); }
        { EpiBranch<1> E{PROJ, MF, MB}; run_gemm(lds, ACT + (size_t)T_ * 1024, WT_BR + (size_t)2048 * 1024, 2048, 1024, E); }
        { EpiBranch<2> E{PROJ, MF, MB}; run_gemm(lds, ACT + 2 * (size_t)T_ * 1024, WT_BR + 2 * (size_t)2048 * 1024, 2048, 1024, E); }
    } break;
    case 6: if (PHM & (1<<6)) { EpiResid E{xin, XC, mod + 4096}; run_gemm(lds, (const bf16_t*)(wsp + WS_MB), WT_O, 2048, 2048, E); } break;
    case 7: if (PHM & (1<<7)) phase_norm(XC, p.norm_mlp_w + l * D_, mod + 8192, mod + 6144, H, nullptr, tid); break;
    case 8: if (PHM & (1<<8)) { EpiRelu2 E{PROJ}; run_gemm(lds, H, WT_MI, 8192, 2048, E); } break;
    case 9: if (PHM & (1<<9)) { EpiResid E{XC, XC, mod + 10240}; run_gemm(lds, PROJ, WT_MO, 2048, 8192, E); } break;
    }
}

constexpr int NPHASE = 22;
__global__ void __launch_bounds__(NTHR, 2) mega_kernel(Params p) {
    extern __shared__ __attribute__((aligned(16))) unsigned char smem[];
    LAS unsigned char* lds = (LAS unsigned char*)smem;
    const int tid = threadIdx.x;
    volatile LAS unsigned* xbw = (volatile LAS unsigned*)(lds + LDS_BYTES - 16);
    if (tid == 0) { xbw[0] = 0u; xbw[1] = 0u; }
    __syncthreads();
    if (p.ph_hi - p.ph_lo > 1) (void)xcd_barrier_post((unsigned*)(p.ws + WS_BAR), xbw);
#ifndef PROBE_REP
#define PROBE_REP 0
#endif
    int ph = p.ph_lo, rep = 0, nbar = 0;
    while (ph < p.ph_hi) {
        if (nbar >= 1 && p.ph_hi - p.ph_lo == 2) { __threadfence(); cg::this_grid().sync(); }
        else if (nbar >= 1) { XcdBarrier xb; xb.bar = (unsigned*)(p.ws + WS_BAR); xb.x = xb_xcc_id(); xb.st = (volatile LAS unsigned*)(lds + LDS_BYTES - 16); xcd_barrier(xb); }
        ++nbar;
        int t2 = tid; asm volatile("" : "+v"(t2));
        unsigned char* wsp;
        {   int z; asm volatile("v_mov_b32 %0, 0" : "=v"(z)); z = __builtin_amdgcn_readfirstlane(z);
            wsp = p.ws + z; }
        run_phase(p, wsp, ph, lds, t2);
        const int sp_ = (ph == 0) ? 10 : (ph == 21) ? 11 : (ph - 1) % 10;
        if (rep == 0 && ((PROBE_REP >> sp_) & 1)) rep = 1; else { rep = 0; ++ph; }
    }
}

#ifndef ONE_LAUNCH
#define ONE_LAUNCH 1
#endif
extern "C" void kernel_launch(void* const* d_in, const int* in_sizes, int n_in, void* d_out, int out_size, void* d_ws, size_t ws_size, hipStream_t stream) {
    static int grid = 0;
    if (grid == 0) {
        if (n_in != 23 || ws_size < WS_END) { fprintf(stderr, "kernel_launch: bad inputs (n_in %d ws %zu need %zu)\n", n_in, ws_size, (size_t)WS_END); grid = -1; return; }
        int dev = 0, cus = 0, per_cu = 0;
        hipGetDevice(&dev); hipDeviceGetAttribute(&cus, hipDeviceAttributeMultiprocessorCount, dev);
        if (hipFuncSetAttribute((const void*)mega_kernel, hipFuncAttributeMaxDynamicSharedMemorySize, LDS_BYTES) != hipSuccess) { fprintf(stderr, "hipFuncSetAttribute failed\n"); grid = -1; return; }
        if (hipOccupancyMaxActiveBlocksPerMultiprocessor(&per_cu, (const void*)mega_kernel, NTHR, LDS_BYTES) != hipSuccess || per_cu < 1) per_cu = 1;
        (void)hipGetLastError();
        grid = cus * 1;
    }
    if (grid < 0) return;
    Params p{};
    p.x = (const float*)d_in[0]; p.c = (const float*)d_in[1]; p.pos = (const int*)d_in[2]; p.w_ada = (const float*)d_in[3]; p.b_ada = (const float*)d_in[4];
    p.norm_mix_w = (const float*)d_in[5]; p.norm_mlp_w = (const float*)d_in[6]; p.w_in = (const float*)d_in[7]; p.conv_qkv_w = (const float*)d_in[8];
    p.a_log = (const float*)d_in[9]; p.dt_bias = (const float*)d_in[10]; p.gdn_norm_w = (const float*)d_in[11]; p.conv_dw_w = (const float*)d_in[12]; p.conv_dw_b = (const float*)d_in[13];
    p.conv_ln_w = (const float*)d_in[14]; p.conv_ln_b = (const float*)d_in[15]; p.w_a = (const float*)d_in[16]; p.w_b = (const float*)d_in[17]; p.w_c = (const float*)d_in[18];
    p.w_out = (const float*)d_in[19]; p.w_mi = (const float*)d_in[20]; p.w_mo = (const float*)d_in[21]; p.final_w = (const float*)d_in[22];
    p.out = (float*)d_out; p.ws = (unsigned char*)d_ws;
#if ONE_LAUNCH
    p.ph_lo = 0; p.ph_hi = NPHASE;
    if (hipMemsetAsync((char*)d_ws + WS_BAR, 0, 32768, stream) != hipSuccess) { fprintf(stderr, "memset failed\n"); return; }
    void* args[] = {&p};
    hipError_t e = hipLaunchCooperativeKernel((const void*)mega_kernel, dim3(grid), dim3(NTHR), args, LDS_BYTES, stream);
    if (e != hipSuccess) fprintf(stderr, "cooperative launch failed: %s (grid %d)\n", hipGetErrorString(e), grid);
#else
    for (int ph = 0; ph < NPHASE; ++ph) { p.ph_lo = ph; p.ph_hi = ph + 1;
        hipLaunchKernelGGL(mega_kernel, dim3(grid), dim3(NTHR), LDS_BYTES, stream, p); }
#endif
}
```
